# Optimizing an MI355X kernel written in HIP

```python
import jax, jax.numpy as jnp
from jax import lax
import numpy as np

D_MODEL = 1024
BATCH = 8
SEQ = 4096
DEPTH = 2

A_GROUPS = ((128, 1), (512, 4), (2048, 16))
A_HEADS = 4
A_HEAD_DIM = 128
A_WIDTH = A_HEADS * A_HEAD_DIM
ROPE_THETA = 500000.0
ROPE_DIM = A_HEAD_DIM // 4

B_HEADS = 4
B_KEY_DIM = D_MODEL // 2 // B_HEADS
B_VAL_DIM = D_MODEL // B_HEADS
B_KEY_WIDTH = B_HEADS * B_KEY_DIM
B_VAL_WIDTH = B_HEADS * B_VAL_DIM
GATE_RANK = 16
GATE_NORMALIZER = 16.0
GLA_CHUNK = 64

N_BRANCHES = 2
NORM_EPS = 1e-6
NEG_BIG = -1e30

IN_WIDTHS = (
    3 * len(A_GROUPS) * A_WIDTH,
    A_WIDTH,
    B_KEY_WIDTH,
    B_KEY_WIDTH,
    B_VAL_WIDTH,
    B_VAL_WIDTH,
    N_BRANCHES * D_MODEL,
    GATE_RANK,
    GATE_RANK,
)
IN_DIM = sum(IN_WIDTHS)

kernel_name = "hybrid_dilated_swa_gla_gated_merge"


def rmsnorm(x, w):
    xf = x.astype(jnp.float32)
    y = xf * lax.rsqrt(jnp.mean(xf * xf, axis=-1, keepdims=True) + NORM_EPS)
    return (y * w.astype(jnp.float32)).astype(x.dtype)


def rope_partial(x, pos):
    inv_freq = ROPE_THETA ** (-jnp.arange(0, ROPE_DIM, 2, dtype=jnp.float32) / ROPE_DIM)
    ang = pos.astype(jnp.float32)[:, None] * inv_freq[None, :]
    cos = jnp.cos(ang)[None, :, None, :]
    sin = jnp.sin(ang)[None, :, None, :]
    xr = x[..., :ROPE_DIM].astype(jnp.float32)
    x1, x2 = jnp.split(xr, 2, axis=-1)
    rot = jnp.concatenate([x1 * cos - x2 * sin, x2 * cos + x1 * sin], axis=-1)
    return jnp.concatenate([rot.astype(x.dtype), x[..., ROPE_DIM:]], axis=-1)


def dilated_window_attention(q, k, v, dilation, half_span):
    B, S, H, Dh = q.shape
    L = S // dilation
    blk = half_span
    nb = -(-L // blk)
    Lp = nb * blk

    def to_classes(t):
        return t.reshape(B, L, dilation, H, Dh).transpose(0, 2, 3, 1, 4)

    qc = jnp.pad(to_classes(q), ((0, 0), (0, 0), (0, 0), (0, Lp - L), (0, 0)))
    qc = qc.reshape(B, dilation, H, nb, blk, Dh)

    def key_windows(t):
        tc = jnp.pad(to_classes(t), ((0, 0), (0, 0), (0, 0), (blk, Lp - L + blk), (0, 0)))
        tc = tc.reshape(B, dilation, H, nb + 2, blk, Dh)
        return jnp.concatenate([tc[:, :, :, :-2], tc[:, :, :, 1:-1], tc[:, :, :, 2:]], axis=4)

    kw = key_windows(k)
    vw = key_windows(v)

    s = jnp.einsum('bghnqe,bghnke->bghnqk', qc, kw).astype(jnp.float32) * (Dh ** -0.5)
    n_idx = jnp.arange(nb)[:, None, None]
    tq = n_idx * blk + jnp.arange(blk)[None, :, None]
    tk = (n_idx - 1) * blk + jnp.arange(3 * blk)[None, None, :]
    valid = (jnp.abs(tk - tq) <= half_span) & (tk >= 0) & (tk < L)
    s = jnp.where(valid, s, jnp.float32(NEG_BIG))
    lse = jax.nn.logsumexp(s, axis=-1)
    p = jnp.exp(s - lse[..., None])
    o = jnp.einsum('bghnqk,bghnke->bghnqe', p.astype(v.dtype), vw)

    o = o.reshape(B, dilation, H, Lp, Dh)[:, :, :, :L].transpose(0, 3, 1, 2, 4).reshape(B, S, H, Dh)
    lse = lse.reshape(B, dilation, H, Lp)[:, :, :, :L].transpose(0, 3, 1, 2).reshape(B, S, H)
    return o, lse


def gla_chunked(q, k, v, log_g, strict):
    B, H, S, dk = q.shape
    dv = v.shape[-1]
    C = GLA_CHUNK
    n = S // C
    q = q.reshape(B, H, n, C, dk)
    k = k.reshape(B, H, n, C, dk)
    v = v.reshape(B, H, n, C, dv)
    b = jnp.cumsum(log_g.reshape(B, H, n, C, dk), axis=3)
    q_dec = q * jnp.exp(b)
    k_inv = k * jnp.exp(-b)
    a = jnp.einsum('bhncd,bhnjd->bhncj', q_dec, k_inv)
    mask = jnp.tril(jnp.ones((C, C), dtype=bool), k=-1 if strict else 0)
    o_intra = jnp.einsum('bhncj,bhnje->bhnce', jnp.where(mask, a, 0.0), v)

    b_last = b[:, :, :, -1:, :]
    k_end = k * jnp.exp(b_last - b)
    chunk_decay = jnp.exp(b_last[:, :, :, 0, :])

    def step(state, xs):
        qd, ke, vv, dec = xs
        o = jnp.einsum('bhcd,bhde->bhce', qd, state)
        state = dec[..., None] * state + jnp.einsum('bhcd,bhce->bhde', ke, vv)
        return state, o

    xs = (jnp.moveaxis(q_dec, 2, 0), jnp.moveaxis(k_end, 2, 0),
          jnp.moveaxis(v, 2, 0), jnp.moveaxis(chunk_decay, 2, 0))
    _, o_inter = lax.scan(step, jnp.zeros((B, H, dk, dv), jnp.float32), xs)
    o = o_intra + jnp.moveaxis(o_inter, 0, 2)
    return o.reshape(B, H, S, dv)


def gla_gate(lr, w_up, b_up):
    logits = (jnp.einsum('bsr,rk->bsk', lr, w_up) + b_up).astype(jnp.float32)
    g = jax.nn.log_sigmoid(logits) / GATE_NORMALIZER
    Bsz, S, _ = g.shape
    return g.reshape(Bsz, S, B_HEADS, B_KEY_DIM).transpose(0, 2, 1, 3)


def hybrid_layer(x, pos, norm_pre, w_in, gate_up_fwd, gate_bias_fwd, gate_up_bwd, gate_bias_bwd,
                 gla_out_norm, w_branch_a, w_branch_b, w_out, norm_post):
    Bsz, S, _ = x.shape
    h = rmsnorm(x, norm_pre)
    proj = jnp.einsum('bsd,de->bse', h, w_in)
    splits = [int(c) for c in np.cumsum(IN_WIDTHS)[:-1]]
    a_qkv, z_a, qb, kb, vb, z_b, merge_logits, lr_f, lr_b = jnp.split(proj, splits, axis=-1)

    outs, lses = [], []
    a_qkv = a_qkv.reshape(Bsz, S, len(A_GROUPS), 3, A_HEADS, A_HEAD_DIM)
    for gi, (window, dilation) in enumerate(A_GROUPS):
        qg = rope_partial(a_qkv[:, :, gi, 0], pos)
        kg = rope_partial(a_qkv[:, :, gi, 1], pos)
        vg = a_qkv[:, :, gi, 2]
        o_g, lse_g = dilated_window_attention(qg, kg, vg, dilation, window // (2 * dilation))
        outs.append(o_g)
        lses.append(lse_g)
    w_groups = jax.nn.softmax(jnp.stack(lses, axis=0), axis=0)
    o_a = jnp.sum(w_groups[..., None] * jnp.stack(outs, axis=0).astype(jnp.float32), axis=0)
    y_a = o_a.reshape(Bsz, S, A_WIDTH).astype(x.dtype) * jax.nn.silu(z_a)

    def heads(t, d):
        return t.reshape(Bsz, S, B_HEADS, d).transpose(0, 2, 1, 3).astype(jnp.float32)
    q_gla = heads(qb, B_KEY_DIM) * (B_KEY_DIM ** -0.5)
    k_gla = heads(kb, B_KEY_DIM)
    v_gla = heads(vb, B_VAL_DIM)
    g_f = gla_gate(lr_f, gate_up_fwd, gate_bias_fwd)
    g_b = gla_gate(lr_b, gate_up_bwd, gate_bias_bwd)
    o_f = gla_chunked(q_gla, k_gla, v_gla, g_f, strict=False)
    flip = lambda t: jnp.flip(t, axis=2)
    o_bw = flip(gla_chunked(flip(q_gla), flip(k_gla), flip(v_gla), flip(g_b), strict=True))
    o_b = o_f + o_bw
    o_b = o_b * lax.rsqrt(jnp.mean(o_b * o_b, axis=-1, keepdims=True) + NORM_EPS) * gla_out_norm.astype(jnp.float32)
    y_b = o_b.transpose(0, 2, 1, 3).reshape(Bsz, S, B_VAL_WIDTH).astype(x.dtype) * jax.nn.silu(z_b)

    gate_a, gate_b = jnp.split(jax.nn.sigmoid(merge_logits), N_BRANCHES, axis=-1)
    merged = (gate_a * jnp.einsum('bse,ed->bsd', y_a, w_branch_a)
              + gate_b * jnp.einsum('bse,ed->bsd', y_b, w_branch_b))
    out = jnp.einsum('bsd,de->bse', merged, w_out)
    return x + rmsnorm(out, norm_post)


def setup_inputs(seed: int = 0) -> dict:
    key = jax.random.key(seed)
    ks = jax.random.split(key, 13)
    f32 = jnp.float32
    nrm = lambda k, shape, scale: jax.random.normal(k, shape, f32) * scale
    return {
        "x": nrm(ks[0], (BATCH, SEQ, D_MODEL), 1.0),
        "norm_pre": 1.0 + nrm(ks[1], (DEPTH, D_MODEL), 0.02),
        "w_in": nrm(ks[2], (DEPTH, D_MODEL, IN_DIM), D_MODEL ** -0.5),
        "gate_up_fwd": nrm(ks[3], (DEPTH, GATE_RANK, B_KEY_WIDTH), GATE_RANK ** -0.5),
        "gate_bias_fwd": nrm(ks[4], (DEPTH, B_KEY_WIDTH), 0.02),
        "gate_up_bwd": nrm(ks[5], (DEPTH, GATE_RANK, B_KEY_WIDTH), GATE_RANK ** -0.5),
        "gate_bias_bwd": nrm(ks[6], (DEPTH, B_KEY_WIDTH), 0.02),
        "gla_out_norm": 1.0 + nrm(ks[7], (DEPTH, B_VAL_DIM), 0.02),
        "w_branch_a": nrm(ks[8], (DEPTH, A_WIDTH, D_MODEL), A_WIDTH ** -0.5),
        "w_branch_b": nrm(ks[9], (DEPTH, B_VAL_WIDTH, D_MODEL), B_VAL_WIDTH ** -0.5),
        "w_out": nrm(ks[10], (DEPTH, D_MODEL, D_MODEL), D_MODEL ** -0.5),
        "norm_post": 1.0 + nrm(ks[11], (DEPTH, D_MODEL), 0.02),
    }


def reference(x, norm_pre, w_in, gate_up_fwd, gate_bias_fwd, gate_up_bwd, gate_bias_bwd,
              gla_out_norm, w_branch_a, w_branch_b, w_out, norm_post):
    pos = jnp.arange(x.shape[1], dtype=jnp.int32)
    for l in range(DEPTH):
        x = hybrid_layer(x, pos, norm_pre[l], w_in[l], gate_up_fwd[l], gate_bias_fwd[l],
                         gate_up_bwd[l], gate_bias_bwd[l], gla_out_norm[l], w_branch_a[l],
                         w_branch_b[l], w_out[l], norm_post[l])
    return x
```

```cpp
#include <hip/hip_runtime.h>
#include <cstdio>
#include <cstdint>
namespace pg8 {
#define PG8_LAS __attribute__((address_space(3)))
typedef unsigned short bf16_t;
typedef short bf16x8 __attribute__((ext_vector_type(8)));
typedef float f32x4 __attribute__((ext_vector_type(4)));
typedef unsigned u32x4 __attribute__((ext_vector_type(4)));
constexpr int BM = 256, BK = 64, HALF = 128, HTB = HALF * BK * 2  , STAGE_BYTES = 8 * HTB, NXCD = 8, WGM = 8;

__host__ __device__ __forceinline__ int lds_byte(int r, int c) { const int st = (r >> 4) * 2 + (c >> 5), rr = r & 15, cc = c & 31, ob = rr * 64 + cc * 2; return st * 1024 + (ob ^ (((ob >> 9) & 1) << 5)); }
__host__ __device__ __forceinline__ void stage_rc(int b, int& R, int& C) { const int st = b / 1024, sb = b % 1024, swz = sb ^ (((sb >> 9) & 1) << 5); R = (st >> 1) * 16 + swz / 64; C = (st & 1) * 32 + (swz % 64) / 2; }
__host__ __device__ __forceinline__ int perm32(int rho) { const int n = rho >> 4, i = rho & 15; return 8 * (i >> 2) + 4 * n + (i & 3); }

struct Unit { int pm, pn; };
struct Gemm { const bf16_t* A; const bf16_t* Bt; int M, N, K; };

struct StaticOrder {
    int nM, nN, nwg, G, c;
    __host__ __device__ void init(int M, int N, int G_, int c_) { nM = M / BM; nN = N / BM; nwg = nM * nN; G = G_; c = c_; }
    __host__ __device__ bool next(int i, Unit& u) const {
        const long L = (long)i * G + c; if (L >= nwg) return false;
        int wgid = (int)L; { const int q = nwg / NXCD, r = nwg % NXCD, xcd = wgid % NXCD, off = wgid / NXCD; wgid = (xcd < r ? xcd * (q + 1) : r * (q + 1) + (xcd - r) * q) + off; }
        const int nig = WGM * nN, gid = wgid / nig, fm = gid * WGM, gsz = (nM - fm) < WGM ? (nM - fm) : WGM;
        u.pm = fm + ((wgid % nig) % gsz); u.pn = (wgid % nig) / gsz; return true;
    }
    __device__ __forceinline__ void a_ready(const Unit&) const {}
    __device__ __forceinline__ void done(const Unit&) const {}
};


__device__ __forceinline__ unsigned cvt_pk_bf16(float lo, float hi) { unsigned r; asm volatile("v_cvt_pk_bf16_f32 %0, %1, %2" : "=v"(r) : "v"(lo), "v"(hi)); return r; }
template <class Epi, class Sched, bool ALIGN_EPI = false, bool SP2 = false>
__device__ __forceinline__ void gemm_phase(PG8_LAS unsigned char* lds, const Gemm g, const Sched& S, const Epi& E) {
    int tid_ = threadIdx.x; asm volatile("" : "+v"(tid_)); const int tid = tid_, wid = __builtin_amdgcn_readfirstlane(tid >> 6), lane = tid & 63, wr = wid >> 2, wc = wid & 3, fr = lane & 15, fq = lane >> 4;
    const int K = g.K, nt = K / BK;
    unsigned voffA[2], voffB[2];
#pragma unroll
    for (int i = 0; i < 2; ++i) { int R, C; stage_rc(tid * 16 + i * 8192, R, C); const int Rb = Epi::PERM ? ((R & ~31) + perm32(R & 31)) : R;
        voffA[i] = (unsigned)(R * K + C) * 2u; voffB[i] = (unsigned)(Rb * K + C) * 2u; }
    const size_t kstep = (size_t)(BK * 2);
    const size_t hstep = (size_t)HALF * K * 2;
    const size_t tstep = 2 * hstep;
    const unsigned ldsw = (unsigned)wid * 1024u;
    const int aoff = lds_byte(wr * 64 + fr, fq * 8), boff = lds_byte(wc * 32 + fr, fq * 8);
#define PG8_SA(b, h) (((b) * 2 + (h)) * HTB)
#define PG8_SB(b, h) ((4 + (b) * 2 + (h)) * HTB)
#define PG8_STAGE(bufoff, gbase, voff) do { _Pragma("unroll") for (int _i = 0; _i < 2; ++_i) \
        __builtin_amdgcn_global_load_lds((const unsigned*)((const char*)(gbase) + (voff)[_i]), (PG8_LAS unsigned*)(lds + (bufoff) + ldsw + _i * 8192), 16, 0, 0); } while (0)
#define PG8_LDA(dst, b, h) do { _Pragma("unroll") for (int m = 0; m < 4; ++m) _Pragma("unroll") for (int k = 0; k < 2; ++k) dst[m][k] = *(const PG8_LAS bf16x8*)(lds + PG8_SA(b, h) + aoff + m * 2048 + k * 1024); } while (0)
#define PG8_LDB(dst, b, h) do { _Pragma("unroll") for (int n = 0; n < 2; ++n) _Pragma("unroll") for (int k = 0; k < 2; ++k) dst[n][k] = *(const PG8_LAS bf16x8*)(lds + PG8_SB(b, h) + boff + n * 2048 + k * 1024); } while (0)
#define PG8_MMA(ai, bj, At, Bt) do { __builtin_amdgcn_s_setprio(1); _Pragma("unroll") for (int m = 0; m < 4; ++m) _Pragma("unroll") for (int n = 0; n < 2; ++n) _Pragma("unroll") for (int k = 0; k < 2; ++k) \
        acc[ai][bj][m][n] = __builtin_amdgcn_mfma_f32_16x16x32_bf16(Bt[n][k], At[m][k], acc[ai][bj][m][n], 0, 0, 0); __builtin_amdgcn_s_setprio(0); } while (0)
#define PG8_WAIT_V(n) asm volatile("s_waitcnt vmcnt(" #n ")" ::: "memory")
#define PG8_WAIT_L(n) asm volatile("s_waitcnt lgkmcnt(" #n ")" ::: "memory")
#define PG8_BAR __builtin_amdgcn_s_barrier()
#define PG8_SCHED __builtin_amdgcn_sched_barrier(0)
    Unit cur, nxt; int ui = 0;
    if (!S.next(0, cur)) return;
    f32x4 acc[2][2][4][2];
#pragma unroll
    for (int a = 0; a < 2; ++a)
#pragma unroll
        for (int b = 0; b < 2; ++b)
#pragma unroll
            for (int m = 0; m < 4; ++m)
#pragma unroll
                for (int n = 0; n < 2; ++n) acc[a][b][m][n] = (f32x4){0.f, 0.f, 0.f, 0.f};
    bf16x8 At[4][2], B0[2][2], B1[2][2];
    const char* cA = (const char*)g.A + (size_t)cur.pm * tstep; const char* cB = (const char*)g.Bt + (size_t)cur.pn * tstep;
    S.a_ready(cur);
    if constexpr (SP2) {
        PG8_STAGE(PG8_SB(0, 0), cB, voffB); PG8_STAGE(PG8_SB(0, 1), cB + hstep, voffB); PG8_STAGE(PG8_SA(0, 0), cA, voffA); PG8_STAGE(PG8_SA(0, 1), cA + hstep, voffA);
        if (wr == 1) PG8_BAR;
        PG8_WAIT_V(2); PG8_BAR;
        PG8_STAGE(PG8_SB(1, 0), cB + kstep, voffB); PG8_STAGE(PG8_SA(1, 0), cA + kstep, voffA); PG8_STAGE(PG8_SB(1, 1), cB + hstep + kstep, voffB);
        PG8_WAIT_V(6); PG8_BAR;
    } else {
        PG8_STAGE(PG8_SB(0, 0), cB, voffB); PG8_STAGE(PG8_SA(0, 0), cA, voffA); PG8_STAGE(PG8_SB(0, 1), cB + hstep, voffB); PG8_STAGE(PG8_SA(0, 1), cA + hstep, voffA);
        if (wr == 1) PG8_BAR;
        PG8_WAIT_V(4); PG8_BAR;
        PG8_STAGE(PG8_SB(1, 0), cB + kstep, voffB); PG8_STAGE(PG8_SA(1, 0), cA + kstep, voffA); PG8_STAGE(PG8_SB(1, 1), cB + hstep + kstep, voffB);
        PG8_WAIT_V(6); PG8_BAR;
    }
    for (;;) {
        const bool has_next = S.next(ui + 1, nxt);
        const char* nA = has_next ? (const char*)g.A + (size_t)nxt.pm * tstep : cA; const char* nB = has_next ? (const char*)g.Bt + (size_t)nxt.pn * tstep : cB;
        for (int t = 0; t < nt; t += 2) {
            const bool last = (t == nt - 2);
            const char* a1 = cA + (size_t)(t + 1) * kstep;
            const char* a2 = last ? nA : cA + (size_t)(t + 2) * kstep; const char* b2 = last ? nB : cB + (size_t)(t + 2) * kstep;
            const char* a3 = a2 + kstep; const char* b3 = b2 + kstep;
            if (last && has_next) S.a_ready(nxt);
            if constexpr (SP2) {
            PG8_LDB(B0, 0, 0); PG8_LDB(B1, 0, 1); PG8_SCHED; PG8_LDA(At, 0, 0); PG8_STAGE(PG8_SA(1, 1), a1 + hstep, voffA);
            PG8_WAIT_V(8); PG8_WAIT_L(0); PG8_BAR; PG8_MMA(0, 0, At, B0); PG8_MMA(0, 1, At, B1); PG8_BAR; PG8_SCHED;
            PG8_LDA(At, 0, 1); PG8_STAGE(PG8_SB(0, 0), b2, voffB); PG8_STAGE(PG8_SB(0, 1), b2 + hstep, voffB); PG8_STAGE(PG8_SA(0, 0), a2, voffA);
            PG8_WAIT_V(8); PG8_WAIT_L(0); PG8_BAR; PG8_MMA(1, 0, At, B0); PG8_MMA(1, 1, At, B1); PG8_BAR; PG8_SCHED;
            PG8_LDB(B0, 1, 0); PG8_LDB(B1, 1, 1); PG8_SCHED; PG8_LDA(At, 1, 0); PG8_STAGE(PG8_SA(0, 1), a2 + hstep, voffA);
            PG8_WAIT_V(8); PG8_WAIT_L(0); PG8_BAR; PG8_MMA(0, 0, At, B0); PG8_MMA(0, 1, At, B1); PG8_BAR; PG8_SCHED;
            PG8_LDA(At, 1, 1); PG8_STAGE(PG8_SB(1, 0), b3, voffB); PG8_STAGE(PG8_SB(1, 1), b3 + hstep, voffB); PG8_STAGE(PG8_SA(1, 0), a3, voffA);
            PG8_WAIT_V(8); PG8_WAIT_L(0); PG8_BAR; PG8_MMA(1, 0, At, B0); PG8_MMA(1, 1, At, B1); PG8_BAR; PG8_SCHED;
            } else {
            PG8_LDB(B0, 0, 0); PG8_SCHED; PG8_LDA(At, 0, 0); PG8_STAGE(PG8_SA(1, 1), a1 + hstep, voffA);
            PG8_WAIT_L(8); PG8_BAR; PG8_WAIT_L(0); PG8_MMA(0, 0, At, B0); PG8_BAR; PG8_SCHED;
            PG8_LDB(B1, 0, 1); PG8_STAGE(PG8_SB(0, 0), b2, voffB);
            PG8_BAR; PG8_WAIT_L(0); PG8_MMA(0, 1, At, B1); PG8_BAR;
            PG8_LDA(At, 0, 1); PG8_STAGE(PG8_SA(0, 0), a2, voffA);
            PG8_BAR; PG8_WAIT_L(0); PG8_MMA(1, 0, At, B0); PG8_BAR; PG8_SCHED;
            PG8_STAGE(PG8_SB(0, 1), b2 + hstep, voffB);
            PG8_WAIT_V(6); PG8_BAR; PG8_MMA(1, 1, At, B1); PG8_BAR;
            PG8_LDB(B0, 1, 0); PG8_SCHED; PG8_LDA(At, 1, 0); PG8_STAGE(PG8_SA(0, 1), a2 + hstep, voffA);
            PG8_WAIT_L(8); PG8_BAR; PG8_WAIT_L(0); PG8_MMA(0, 0, At, B0); PG8_BAR; PG8_SCHED;
            PG8_LDB(B1, 1, 1); PG8_STAGE(PG8_SB(1, 0), b3, voffB);
            PG8_BAR; PG8_WAIT_L(0); PG8_MMA(0, 1, At, B1); PG8_BAR;
            PG8_LDA(At, 1, 1); PG8_STAGE(PG8_SA(1, 0), a3, voffA);
            PG8_BAR; PG8_WAIT_L(0); PG8_MMA(1, 0, At, B0); PG8_BAR; PG8_SCHED;
            PG8_STAGE(PG8_SB(1, 1), b3 + hstep, voffB);
            PG8_WAIT_V(6); PG8_BAR; PG8_MMA(1, 1, At, B1); PG8_BAR;
            }
        }
        if constexpr (ALIGN_EPI) { if (wr == 0) PG8_BAR; }
        if constexpr (!Epi::AFTER_DRAIN) { E(acc, cur, wr, wc, fr, fq); S.done(cur); }
        if (!has_next) break;
#pragma unroll
        for (int a = 0; a < 2; ++a)
#pragma unroll
            for (int b = 0; b < 2; ++b)
#pragma unroll
                for (int m = 0; m < 4; ++m)
#pragma unroll
                    for (int n = 0; n < 2; ++n) acc[a][b][m][n] = (f32x4){0.f, 0.f, 0.f, 0.f};
        cur = nxt; cA = nA; cB = nB; ++ui;
        if constexpr (ALIGN_EPI) { if (wr == 1) PG8_BAR; }
    }
    PG8_WAIT_V(0);
    if constexpr (!ALIGN_EPI) { if (wr == 0) PG8_BAR; }
    PG8_BAR;
    if constexpr (Epi::AFTER_DRAIN) { E.fused(acc, cur, wr, wc, fr, fq, lds, wid, lane); S.done(cur); }
#undef PG8_SA
#undef PG8_SB
#undef PG8_STAGE
#undef PG8_LDA
#undef PG8_LDB
#undef PG8_MMA
#undef PG8_WAIT_V
#undef PG8_WAIT_L
#undef PG8_BAR
#undef PG8_SCHED
}
}

#define LAS __attribute__((address_space(3)))
typedef unsigned short bf16_t;
typedef short bf16x8 __attribute__((ext_vector_type(8)));
typedef short s16x4 __attribute__((ext_vector_type(4)));
typedef float f32x4 __attribute__((ext_vector_type(4)));
typedef float f32x2 __attribute__((ext_vector_type(2)));
typedef unsigned u32x4 __attribute__((ext_vector_type(4)));
typedef unsigned u32x2 __attribute__((ext_vector_type(2)));

constexpr int NWAVES = 8, NTHR = 512;
constexpr int T = 32768, DM = 1024, SEQ = 4096, NB = 8;
constexpr int IN_DIM = 10272;
constexpr int NWIN_TILES = 41, NWIN = NWIN_TILES * 256;
constexpr float NORM_EPS = 1e-6f;
constexpr float QSCALE = 0.08838834764831845f;

constexpr size_t MiB = 1u << 20;
constexpr size_t WS_CTL = 0;
constexpr size_t WS_WIN = 1 * MiB;
constexpr size_t WIN_BYTES = (size_t)NWIN * 1024 * 2;
constexpr size_t WS_WA = 42 * MiB;
constexpr size_t WS_WB = 44 * MiB;
constexpr size_t WS_WO = 48 * MiB;
constexpr size_t WS_ROPEC = 52 * MiB, WS_ROPES = WS_ROPEC + 256 * 1024;
constexpr size_t WS_LSE = 53 * MiB;
constexpr size_t WS_LR = 55 * MiB;
constexpr size_t WS_ROWSS = 59 * MiB;
constexpr size_t WS_H = 62 * MiB;
constexpr size_t WS_X = 126 * MiB;
constexpr size_t X_GQ = WS_X + 0 * MiB, X_GK = WS_X + 32 * MiB, X_GV = WS_X + 64 * MiB, X_BF = WS_X + 128 * MiB, X_BB = WS_X + 160 * MiB;
constexpr size_t X_OF = WS_X + 224 * MiB, X_OB = WS_X + 288 * MiB;
constexpr size_t X_ZB = WS_X + 0 * MiB, X_KA = WS_X + 64 * MiB, X_VA = WS_X + 96 * MiB, X_QO = WS_X + 128 * MiB;
constexpr size_t X_ZA = WS_X + 288 * MiB, X_YA = WS_X + 320 * MiB;
constexpr size_t X_GA = WS_X + 0 * MiB, X_GB = WS_X + 64 * MiB, X_TMP = WS_X + 128 * MiB, X_OUT = WS_X + 0 * MiB;
constexpr size_t WS_END = WS_X + 352 * MiB;

constexpr int LDS_BYTES = 147456;

__device__ __forceinline__ float bf2f(unsigned v) { return __uint_as_float(v << 16); }
__device__ __forceinline__ float bflo(unsigned w) { return __uint_as_float(w << 16); }
__device__ __forceinline__ float bfhi(unsigned w) { return __uint_as_float(w & 0xffff0000u); }
typedef __bf16 bf16x2_t __attribute__((ext_vector_type(2)));
__device__ __forceinline__ unsigned pk2(float lo, float hi) { f32x2 v = {lo, hi}; bf16x2_t b = __builtin_convertvector(v, bf16x2_t); return __builtin_bit_cast(unsigned, b); }
__device__ __forceinline__ float wave_sum(float v) {
#pragma unroll
    for (int o = 1; o < 64; o <<= 1) v += __shfl_xor(v, o);
    return v;
}
__device__ __forceinline__ float sigmoidf_(float x) { return 1.0f / (1.0f + __expf(-x)); }

struct EpiProj {
    static constexpr bool PERM = true, AFTER_DRAIN = false;
    int tau0; unsigned char* ws; const float* ropec; const float* ropes;
    __device__ __forceinline__ void operator()(const f32x4 (&acc)[2][2][4][2], const pg8::Unit& u, int wr, int wc, int fr, int fq) const {
        const int tau = tau0 + u.pn;
        int mode = 0, ldc = 512, colt = 0; bf16_t* base = nullptr;
        if (tau < 2) { base = (bf16_t*)(ws + X_GQ); colt = tau * 256; }
        else if (tau < 4) { base = (bf16_t*)(ws + X_GK); colt = (tau - 2) * 256; }
        else if (tau < 8) { base = (bf16_t*)(ws + X_GV); ldc = 1024; colt = (tau - 4) * 256; }
        else if (tau == 8) { mode = 4; }
        else if (tau < 13) { base = (bf16_t*)(ws + X_ZB); ldc = 1024; colt = (tau - 9) * 256; mode = 1; }
        else if (tau < 31) { const int q = tau - 13, g = q / 6, t = (q % 6) >> 1, half = q & 1; colt = half * 256;
                             base = t == 0 ? (bf16_t*)(ws + X_QO + (size_t)g * 32 * MiB) : (t == 1 ? (bf16_t*)(ws + X_KA) : (bf16_t*)(ws + X_VA)); mode = t < 2 ? 3 : 0; }
        else if (tau < 33) { base = (bf16_t*)(ws + X_ZA); colt = (tau - 31) * 256; mode = 1; }
        else if (tau < 37) { base = (bf16_t*)(ws + X_GA); ldc = 1024; colt = (tau - 33) * 256; mode = 2; }
        else { base = (bf16_t*)(ws + X_GB); ldc = 1024; colt = (tau - 37) * 256; mode = 2; }
        const int row0 = u.pm * 256 + wr * 64 + fr;
        if (mode == 4) {
            if (wc == 0) { float* LR = (float*)(ws + WS_LR);
#pragma unroll
                for (int ai = 0; ai < 2; ++ai)
#pragma unroll
                    for (int m = 0; m < 4; ++m) { float* rp = LR + (size_t)(row0 + ai * 128 + m * 16) * 32 + 8 * fq;
                        *(f32x4*)(rp) = acc[ai][0][m][0]; *(f32x4*)(rp + 4) = acc[ai][0][m][1]; } }
            return;
        }
        const int col0 = colt + wc * 32 + 8 * fq;
#pragma unroll
        for (int ai = 0; ai < 2; ++ai)
#pragma unroll
            for (int m = 0; m < 4; ++m) { const int row = row0 + ai * 128 + m * 16; bf16_t* rowp = base + (size_t)row * ldc + col0;
                f32x4 cs = {1.f, 1.f, 1.f, 1.f}, sn = {0.f, 0.f, 0.f, 0.f};
                if (mode == 3 && wc == 0) { const int pos = row & (SEQ - 1); cs = *(const f32x4*)(ropec + pos * 16 + 4 * fq); sn = *(const f32x4*)(ropes + pos * 16 + 4 * fq); }
#pragma unroll
                for (int bj = 0; bj < 2; ++bj) { f32x4 v0 = acc[ai][bj][m][0], v1 = acc[ai][bj][m][1];
                    if (mode == 1) {
#pragma unroll
                        for (int j = 0; j < 4; ++j) { v0[j] = v0[j] * sigmoidf_(v0[j]); v1[j] = v1[j] * sigmoidf_(v1[j]); } }
                    else if (mode == 2) {
#pragma unroll
                        for (int j = 0; j < 4; ++j) { v0[j] = sigmoidf_(v0[j]); v1[j] = sigmoidf_(v1[j]); } }
                    else if (mode == 3 && wc == 0) {
                        f32x4 a = v0, b = v1;
                        v0[0] = a[0] * cs[0] - a[1] * sn[0]; v0[1] = a[1] * cs[0] + a[0] * sn[0]; v0[2] = a[2] * cs[1] - a[3] * sn[1]; v0[3] = a[3] * cs[1] + a[2] * sn[1];
                        v1[0] = b[0] * cs[2] - b[1] * sn[2]; v1[1] = b[1] * cs[2] + b[0] * sn[2]; v1[2] = b[2] * cs[3] - b[3] * sn[3]; v1[3] = b[3] * cs[3] + b[2] * sn[3]; }
                    u32x4 w; w.x = pk2(v0[0], v0[1]); w.y = pk2(v0[2], v0[3]); w.z = pk2(v1[0], v1[1]); w.w = pk2(v1[2], v1[3]);
                    *(u32x4*)(rowp + bj * 128) = w; } }
    }
};
template <bool ADD> struct EpiGate {
    static constexpr bool PERM = true, AFTER_DRAIN = false;
    const bf16_t* G; const bf16_t* Tm; bf16_t* O;
    __device__ __forceinline__ void operator()(const f32x4 (&acc)[2][2][4][2], const pg8::Unit& u, int wr, int wc, int fr, int fq) const {
        const int row0 = u.pm * 256 + wr * 64 + fr, col0 = u.pn * 256 + wc * 32 + 8 * fq;
#pragma unroll
        for (int ai = 0; ai < 2; ++ai)
#pragma unroll
            for (int m = 0; m < 4; ++m) { const size_t off = (size_t)(row0 + ai * 128 + m * 16) * 1024 + col0;
#pragma unroll
                for (int bj = 0; bj < 2; ++bj) { const u32x4 g = *(const u32x4*)(G + off + bj * 128); f32x4 v0 = acc[ai][bj][m][0], v1 = acc[ai][bj][m][1];
                    v0[0] *= bflo(g.x); v0[1] *= bfhi(g.x); v0[2] *= bflo(g.y); v0[3] *= bfhi(g.y); v1[0] *= bflo(g.z); v1[1] *= bfhi(g.z); v1[2] *= bflo(g.w); v1[3] *= bfhi(g.w);
                    if (ADD) { const u32x4 t = *(const u32x4*)(Tm + off + bj * 128);
                        v0[0] += bflo(t.x); v0[1] += bfhi(t.x); v0[2] += bflo(t.y); v0[3] += bfhi(t.y); v1[0] += bflo(t.z); v1[1] += bfhi(t.z); v1[2] += bflo(t.w); v1[3] += bfhi(t.w); }
                    u32x4 w; w.x = pk2(v0[0], v0[1]); w.y = pk2(v0[2], v0[3]); w.z = pk2(v1[0], v1[1]); w.w = pk2(v1[2], v1[3]);
                    *(u32x4*)(O + off + bj * 128) = w; } }
    }
};
struct EpiOut {
    static constexpr bool PERM = true, AFTER_DRAIN = false;
    bf16_t* O; float* rowss;
    __device__ __forceinline__ void operator()(const f32x4 (&acc)[2][2][4][2], const pg8::Unit& u, int wr, int wc, int fr, int fq) const {
        const int row0 = u.pm * 256 + wr * 64 + fr, col0 = u.pn * 256 + wc * 32 + 8 * fq;
#pragma unroll
        for (int ai = 0; ai < 2; ++ai)
#pragma unroll
            for (int m = 0; m < 4; ++m) { const int row = row0 + ai * 128 + m * 16; const size_t off = (size_t)row * 1024 + col0; float s = 0.f;
#pragma unroll
                for (int bj = 0; bj < 2; ++bj) { const f32x4 v0 = acc[ai][bj][m][0], v1 = acc[ai][bj][m][1];
                    s += (v0[0] * v0[0] + v0[1] * v0[1]) + (v0[2] * v0[2] + v0[3] * v0[3]) + (v1[0] * v1[0] + v1[1] * v1[1]) + (v1[2] * v1[2] + v1[3] * v1[3]);
                    u32x4 w; w.x = pk2(v0[0], v0[1]); w.y = pk2(v0[2], v0[3]); w.z = pk2(v1[0], v1[1]); w.w = pk2(v1[2], v1[3]);
                    *(u32x4*)(O + off + bj * 128) = w; }
                s += __shfl_xor(s, 16); s += __shfl_xor(s, 32);
                if (fq == 0) rowss[(size_t)row * 16 + u.pn * 4 + wc] = s; }
    }
};

struct Args { const float* in[12]; float* out; unsigned char* ws; int ph_lo, ph_hi; };

struct Frame { LAS unsigned char* lds; int tid, lane, wave, G, bid; };

__device__ __forceinline__ int win_src(int np, float& sc) {
    sc = 1.f; const int tau = np >> 8, c = np & 255;
    if (tau < 2) { sc = QSCALE; return 5120 + np; }
    if (tau < 4) return 5632 + (np - 512);
    if (tau < 8) return 6144 + (np - 1024);
    if (tau == 8) return c < 32 ? 10240 + c : -1;
    if (tau < 13) return 7168 + (np - 9 * 256);
    if (tau < 31) { const int q = np - 13 * 256, g = q / 1536, rem = q % 1536, t = rem / 512, hc = rem % 512, h = hc >> 7, d = hc & 127;
        int ds = d; if (t < 2 && d < 32) ds = (d & 1) ? 16 + (d >> 1) : (d >> 1);
        if (t == 0) sc = QSCALE;
        return g * 1536 + t * 512 + h * 128 + ds; }
    if (tau < 33) return 4608 + (np - 31 * 256);
    return 8192 + (np - 33 * 256);
}
template <bool IS_WIN> __device__ __forceinline__ void transpose_item(const float* W, int K, int Nsrc, int Ndst, bf16_t* WT, LAS float* scr, int item, int lane) {
    const int nblk = Ndst / 32, kb = item / nblk, nb = item % nblk, k0 = 64 * kb, n0 = 32 * nb;
    const int np = n0 + (lane & 31); float sc = 1.f; int src = np; if (IS_WIN) src = win_src(np, sc);
#pragma unroll 8
    for (int i = 0; i < 32; ++i) { const int kk = 2 * i + (lane >> 5); float v = 0.f; if (src >= 0) v = W[(size_t)(k0 + kk) * Nsrc + src] * sc; scr[kk * 33 + (lane & 31)] = v; }
    asm volatile("s_waitcnt lgkmcnt(0)" ::: "memory");
    const int c = lane & 7;
#pragma unroll
    for (int j = 0; j < 4; ++j) { const int n = (lane >> 3) + 8 * j; const LAS float* s = scr + (8 * c) * 33 + n;
        u32x4 o; o.x = pk2(s[0 * 33], s[1 * 33]); o.y = pk2(s[2 * 33], s[3 * 33]); o.z = pk2(s[4 * 33], s[5 * 33]); o.w = pk2(s[6 * 33], s[7 * 33]);
        *(u32x4*)(WT + (size_t)(n0 + n) * K + k0 + 8 * c) = o; }
    asm volatile("s_waitcnt lgkmcnt(0)" ::: "memory");
}
__device__ __forceinline__ void phase_prologue(const Frame& F, const Args& a) {
    LAS float* scr = (LAS float*)(F.lds + F.wave * 16384);
    const int gw = F.bid * NWAVES + F.wave, NGW = F.G * NWAVES;
    constexpr int I_WIN = 16 * (NWIN / 32), I_WA = 8 * 32, I_WB = 16 * 32, I_WO = 16 * 32, I_L = I_WIN + I_WA + I_WB + I_WO;
    for (int it = gw; it < 2 * I_L; it += NGW) {
        const int l = it / I_L; int r = it % I_L;
        if (r < I_WIN) { transpose_item<true>(a.in[2] + (size_t)l * 1024 * IN_DIM, 1024, IN_DIM, NWIN, (bf16_t*)(a.ws + WS_WIN + l * WIN_BYTES), scr, r, F.lane); continue; } r -= I_WIN;
        if (r < I_WA) { transpose_item<false>(a.in[8] + (size_t)l * 512 * 1024, 512, 1024, 1024, (bf16_t*)(a.ws + WS_WA + l * MiB), scr, r, F.lane); continue; } r -= I_WA;
        if (r < I_WB) { transpose_item<false>(a.in[9] + (size_t)l * 1024 * 1024, 1024, 1024, 1024, (bf16_t*)(a.ws + WS_WB + l * 2 * MiB), scr, r, F.lane); continue; } r -= I_WB;
        transpose_item<false>(a.in[10] + (size_t)l * 1024 * 1024, 1024, 1024, 1024, (bf16_t*)(a.ws + WS_WO + l * 2 * MiB), scr, r, F.lane);
    }
    float* rc = (float*)(a.ws + WS_ROPEC); float* rs = (float*)(a.ws + WS_ROPES);
    for (int e = F.bid * NTHR + F.tid; e < SEQ * 16; e += F.G * NTHR) { const int pos = e >> 4, i = e & 15;
        const float inv = (float)pow(500000.0, -(double)(2 * i) / 32.0); const float ang = (float)pos * inv;
        rc[e] = (float)cos((double)ang); rs[e] = (float)sin((double)ang); }
}

__device__ __forceinline__ void phase_prep(const Frame& F, const Args& a, int mode, const float* xprev, float* xout, const float* wpost, const float* wpre) {
    const int gw = F.bid * NWAVES + F.wave, NGW = F.G * NWAVES;
    const bf16_t* OUT = (const bf16_t*)(a.ws + X_OUT); const float* rowss = (const float*)(a.ws + WS_ROWSS); bf16_t* H = (bf16_t*)(a.ws + WS_H);
    for (int row = gw; row < T; row += NGW) {
        const f32x4* xr = (const f32x4*)(xprev + (size_t)row * DM) + F.lane;
        f32x4 v[4];
#pragma unroll
        for (int j = 0; j < 4; ++j) v[j] = xr[64 * j];
        if (mode != 0) {
            float ss = rowss[(size_t)row * 16 + (F.lane & 15)];
            ss += __shfl_xor(ss, 1); ss += __shfl_xor(ss, 2); ss += __shfl_xor(ss, 4); ss += __shfl_xor(ss, 8);
            const float rstd = 1.0f / sqrtf(ss * (1.0f / DM) + NORM_EPS);
            const u32x2* orow = (const u32x2*)(OUT + (size_t)row * DM) + F.lane;
#pragma unroll
            for (int j = 0; j < 4; ++j) { const u32x2 o = orow[64 * j]; const f32x4 w = *((const f32x4*)wpost + F.lane + 64 * j);
                v[j][0] += bflo(o.x) * rstd * w[0]; v[j][1] += bfhi(o.x) * rstd * w[1]; v[j][2] += bflo(o.y) * rstd * w[2]; v[j][3] += bfhi(o.y) * rstd * w[3]; }
            f32x4* xo = (f32x4*)(xout + (size_t)row * DM) + F.lane;
#pragma unroll
            for (int j = 0; j < 4; ++j) xo[64 * j] = v[j];
        }
        if (mode != 2) {
            float s = 0.f;
#pragma unroll
            for (int j = 0; j < 4; ++j) s += (v[j][0] * v[j][0] + v[j][1] * v[j][1]) + (v[j][2] * v[j][2] + v[j][3] * v[j][3]);
            const float rstd = 1.0f / sqrtf(wave_sum(s) * (1.0f / DM) + NORM_EPS);
            u32x2* ho = (u32x2*)(H + (size_t)row * DM) + F.lane;
#pragma unroll
            for (int j = 0; j < 4; ++j) { const f32x4 w = *((const f32x4*)wpre + F.lane + 64 * j); u32x2 o;
                o.x = pk2(v[j][0] * rstd * w[0], v[j][1] * rstd * w[1]); o.y = pk2(v[j][2] * rstd * w[2], v[j][3] * rstd * w[3]); ho[64 * j] = o; }
        }
    }
}

__device__ __forceinline__ void phase_gla_pre(const Frame& F, const Args& a, int layer) {
    const float* LR = (const float*)(a.ws + WS_LR);
    const int col = F.tid;
    for (int item = F.bid; item < NB * 64 * 2; item += F.G) {
        const int dir = item & 1, chunk = (item >> 1) & 63, b = item >> 7;
        const float* Wup = (dir ? a.in[5] : a.in[3]) + (size_t)layer * 16 * 512; const float* bias = (dir ? a.in[6] : a.in[4]) + (size_t)layer * 512;
        float w[16];
#pragma unroll
        for (int i = 0; i < 16; ++i) w[i] = Wup[i * 512 + col];
        const float bz = bias[col];
        _Float16* Bo = (_Float16*)(a.ws + (dir ? X_BB : X_BF));
        float accum = 0.f;
        for (int s = 0; s < 64; ++s) { const int t = dir ? 63 - s : s; const size_t tok = (size_t)b * SEQ + chunk * 64 + t;
            const float* lr = LR + tok * 32 + dir * 16;
            float x = bz;
#pragma unroll
            for (int i = 0; i < 16; ++i) x += lr[i] * w[i];
            const float ls = fminf(x, 0.f) - log1pf(expf(-fabsf(x)));
            accum += ls * (1.0f / 16.0f);
            Bo[tok * 512 + col] = (_Float16)accum; }
    }
}

constexpr int GS_STR = 272, GS_VSTR = 144;
constexpr int GS_QD = 0, GS_KI = 64 * GS_STR, GS_KE = 2 * 64 * GS_STR, GS_V = 3 * 64 * GS_STR, GS_DEC = GS_V + 64 * GS_VSTR;
__device__ __forceinline__ s16x4 trread(const LAS unsigned char* p) { return __builtin_bit_cast(s16x4, __builtin_amdgcn_ds_read_tr16_b64_v4i16((LAS s16x4*)p)); }
__device__ __forceinline__ bf16x8 cat8(s16x4 lo, s16x4 hi) { return (bf16x8){lo[0], lo[1], lo[2], lo[3], hi[0], hi[1], hi[2], hi[3]}; }
__device__ __forceinline__ bf16x8 pack8(const f32x4& a, const f32x4& b) { u32x4 w; w.x = pk2(a[0], a[1]); w.y = pk2(a[2], a[3]); w.z = pk2(b[0], b[1]); w.w = pk2(b[2], b[3]); return __builtin_bit_cast(bf16x8, w); }

__device__ __forceinline__ void phase_gla_scan(const Frame& F, const Args& a) {
    const int tid = F.tid, lane = F.lane, wid = F.wave, fr = lane & 15, fq = lane >> 4, cb = wid & 3, dvh = wid >> 2;
    LAS unsigned char* lds = F.lds;
    const bf16_t* GQ = (const bf16_t*)(a.ws + X_GQ); const bf16_t* GK = (const bf16_t*)(a.ws + X_GK); const bf16_t* GV = (const bf16_t*)(a.ws + X_GV);
    for (int u = F.bid; u < 256; u += F.G) {
        const int dvq = u & 3, dir = (u >> 2) & 1, h = (u >> 3) & 3, b = u >> 5;
        const _Float16* Bc = (const _Float16*)(a.ws + (dir ? X_BB : X_BF));
        bf16_t* Od = (bf16_t*)(a.ws + (dir ? X_OB : X_OF));
        f32x4 S[8][2];
#pragma unroll
        for (int i = 0; i < 8; ++i) { S[i][0] = (f32x4){0.f, 0.f, 0.f, 0.f}; S[i][1] = (f32x4){0.f, 0.f, 0.f, 0.f}; }
        for (int step = 0; step < 64; ++step) {
            const int chunk = dir ? 63 - step : step; const size_t tok0 = (size_t)b * SEQ + chunk * 64;
            __syncthreads();
            {
                const int row = tid >> 3, cseg = (tid & 7) * 16; const size_t go = (tok0 + row) * 512 + h * 128 + cseg; const size_t gl = (tok0 + (dir ? 0 : 63)) * 512 + h * 128 + cseg;
                const u32x4 q0 = *(const u32x4*)(GQ + go), q1 = *(const u32x4*)(GQ + go + 8), k0 = *(const u32x4*)(GK + go), k1 = *(const u32x4*)(GK + go + 8);
                const u32x4 b0 = *(const u32x4*)(Bc + go), b1 = *(const u32x4*)(Bc + go + 8), l0 = *(const u32x4*)(Bc + gl), l1 = *(const u32x4*)(Bc + gl + 8);
                unsigned qw[8] = {q0.x, q0.y, q0.z, q0.w, q1.x, q1.y, q1.z, q1.w}, kw[8] = {k0.x, k0.y, k0.z, k0.w, k1.x, k1.y, k1.z, k1.w};
                unsigned bw[8] = {b0.x, b0.y, b0.z, b0.w, b1.x, b1.y, b1.z, b1.w}, lw[8] = {l0.x, l0.y, l0.z, l0.w, l1.x, l1.y, l1.z, l1.w};
                unsigned oqd[8], oki[8], oke[8];
#pragma unroll
                for (int i = 0; i < 8; ++i) {
                    typedef _Float16 h2 __attribute__((ext_vector_type(2)));
                    const h2 bb = __builtin_bit_cast(h2, bw[i]), ll = __builtin_bit_cast(h2, lw[i]);
                    const float bl = (float)bb[0], bh = (float)bb[1], ell = (float)ll[0], elh = (float)ll[1];
                    const float ql = bflo(qw[i]), qh = bfhi(qw[i]), kl = bflo(kw[i]), kh = bfhi(kw[i]);
                    oqd[i] = pk2(ql * __expf(bl), qh * __expf(bh)); oki[i] = pk2(kl * __expf(-bl), kh * __expf(-bh)); oke[i] = pk2(kl * __expf(ell - bl), kh * __expf(elh - bh));
                    if (row == 0) { *(LAS f32x2*)(lds + GS_DEC + (cseg + 2 * i) * 4) = (f32x2){__expf(ell), __expf(elh)}; }
                }
                LAS unsigned char* p = lds + row * GS_STR + cseg * 2;
                *(LAS u32x4*)(p + GS_QD) = (u32x4){oqd[0], oqd[1], oqd[2], oqd[3]}; *(LAS u32x4*)(p + GS_QD + 16) = (u32x4){oqd[4], oqd[5], oqd[6], oqd[7]};
                *(LAS u32x4*)(p + GS_KI) = (u32x4){oki[0], oki[1], oki[2], oki[3]}; *(LAS u32x4*)(p + GS_KI + 16) = (u32x4){oki[4], oki[5], oki[6], oki[7]};
                *(LAS u32x4*)(p + GS_KE) = (u32x4){oke[0], oke[1], oke[2], oke[3]}; *(LAS u32x4*)(p + GS_KE + 16) = (u32x4){oke[4], oke[5], oke[6], oke[7]};
                const int vch = tid & 7;
                const u32x4 vv = *(const u32x4*)(GV + (tok0 + row) * 1024 + h * 256 + dvq * 64 + vch * 8);
                *(LAS u32x4*)(lds + GS_V + row * GS_VSTR + vch * 16) = vv;
            }
            __syncthreads();
            f32x4 at[4];
#pragma unroll
            for (int jb = 0; jb < 4; ++jb) { at[jb] = (f32x4){0.f, 0.f, 0.f, 0.f};
#pragma unroll
                for (int ks = 0; ks < 4; ++ks) { const bf16x8 ka = *(const LAS bf16x8*)(lds + GS_KI + (16 * jb + fr) * GS_STR + (32 * ks + 8 * fq) * 2);
                    const bf16x8 qb = *(const LAS bf16x8*)(lds + GS_QD + (16 * cb + fr) * GS_STR + (32 * ks + 8 * fq) * 2);
                    at[jb] = __builtin_amdgcn_mfma_f32_16x16x32_bf16(ka, qb, at[jb], 0, 0, 0); }
                const int c = 16 * cb + fr;
#pragma unroll
                for (int r = 0; r < 4; ++r) { const int j = 16 * jb + 4 * fq + r; const bool keep = dir ? (j > c) : (j <= c); if (!keep) at[jb][r] = 0.f; } }
            const bf16x8 pf0 = pack8(at[0], at[1]), pf1 = pack8(at[2], at[3]);
            f32x4 oT[2];
#pragma unroll
            for (int t = 0; t < 2; ++t) { oT[t] = (f32x4){0.f, 0.f, 0.f, 0.f};
                const LAS unsigned char* vb = lds + GS_V + (4 * fq + (fr >> 2)) * GS_VSTR + (dvh * 32 + 16 * t + 4 * (fr & 3)) * 2;
                { const bf16x8 va = cat8(trread(vb), trread(vb + 16 * GS_VSTR)); oT[t] = __builtin_amdgcn_mfma_f32_16x16x32_bf16(va, pf0, oT[t], 0, 0, 0); }
                { const bf16x8 va = cat8(trread(vb + 32 * GS_VSTR), trread(vb + 48 * GS_VSTR)); oT[t] = __builtin_amdgcn_mfma_f32_16x16x32_bf16(va, pf1, oT[t], 0, 0, 0); }
#pragma unroll
                for (int ks = 0; ks < 4; ++ks) { const bf16x8 sa = pack8(S[2 * ks][t], S[2 * ks + 1][t]);
                    const LAS unsigned char* qp = lds + GS_QD + (16 * cb + fr) * GS_STR + (32 * ks + 4 * fq) * 2;
                    const s16x4 qlo = *(const LAS s16x4*)qp, qhi = *(const LAS s16x4*)(qp + 32);
                    oT[t] = __builtin_amdgcn_mfma_f32_16x16x32_bf16(sa, cat8(qlo, qhi), oT[t], 0, 0, 0); }
                u32x2 w; w.x = pk2(oT[t][0], oT[t][1]); w.y = pk2(oT[t][2], oT[t][3]);
                *(u32x2*)(Od + (tok0 + 16 * cb + fr) * 1024 + h * 256 + dvq * 64 + dvh * 32 + 16 * t + 4 * fq) = w; }
#pragma unroll
            for (int dkb = 0; dkb < 8; ++dkb) { const f32x4 dc = *(const LAS f32x4*)(lds + GS_DEC + (16 * dkb + 4 * fq) * 4);
                const LAS unsigned char* kb = lds + GS_KE + (8 * fq + (fr >> 2)) * GS_STR + (16 * dkb + 4 * (fr & 3)) * 2;
                const bf16x8 ke0 = cat8(trread(kb), trread(kb + 4 * GS_STR)), ke1 = cat8(trread(kb + 32 * GS_STR), trread(kb + 36 * GS_STR));
#pragma unroll
                for (int t = 0; t < 2; ++t) { const LAS unsigned char* vb = lds + GS_V + (8 * fq + (fr >> 2)) * GS_VSTR + (dvh * 32 + 16 * t + 4 * (fr & 3)) * 2;
                    const bf16x8 v0 = cat8(trread(vb), trread(vb + 4 * GS_VSTR)), v1 = cat8(trread(vb + 32 * GS_VSTR), trread(vb + 36 * GS_VSTR));
                    S[dkb][t] = S[dkb][t] * dc;
                    S[dkb][t] = __builtin_amdgcn_mfma_f32_16x16x32_bf16(ke0, v0, S[dkb][t], 0, 0, 0);
                    S[dkb][t] = __builtin_amdgcn_mfma_f32_16x16x32_bf16(ke1, v1, S[dkb][t], 0, 0, 0); } }
        }
    }
}

__device__ __forceinline__ void phase_comb_b(const Frame& F, const Args& a, int layer) {
    const int gw = F.bid * NWAVES + F.wave, NGW = F.G * NWAVES;
    bf16_t* OF = (bf16_t*)(a.ws + X_OF); const bf16_t* OB = (const bf16_t*)(a.ws + X_OB); const bf16_t* ZB = (const bf16_t*)(a.ws + X_ZB);
    const f32x4 w = *((const f32x4*)(a.in[7] + (size_t)layer * 256) + F.lane);
    for (int it = gw; it < T * 4; it += NGW) {
        const size_t off = (size_t)it * 256 + 4 * F.lane;
        const u32x2 f = *(const u32x2*)(OF + off), bq = *(const u32x2*)(OB + off), z = *(const u32x2*)(ZB + off);
        const float o0 = bflo(f.x) + bflo(bq.x), o1 = bfhi(f.x) + bfhi(bq.x), o2 = bflo(f.y) + bflo(bq.y), o3 = bfhi(f.y) + bfhi(bq.y);
        const float rstd = 1.0f / sqrtf(wave_sum((o0 * o0 + o1 * o1) + (o2 * o2 + o3 * o3)) * (1.0f / 256.0f) + NORM_EPS);
        u32x2 y; y.x = pk2(o0 * rstd * w[0] * bflo(z.x), o1 * rstd * w[1] * bfhi(z.x)); y.y = pk2(o2 * rstd * w[2] * bflo(z.y), o3 * rstd * w[3] * bfhi(z.y));
        *(u32x2*)(OF + off) = y;
    }
}
__device__ __forceinline__ void phase_comb_a(const Frame& F, const Args& a) {
    const int gw = F.bid * NWAVES + F.wave, NGW = F.G * NWAVES;
    const float* LSE = (const float*)(a.ws + WS_LSE); const bf16_t* ZA = (const bf16_t*)(a.ws + X_ZA); bf16_t* YA = (bf16_t*)(a.ws + X_YA);
    const int head = F.lane >> 4;
    for (int tok = gw; tok < T; tok += NGW) {
        const float l0 = LSE[(size_t)tok * 4 + head], l1 = LSE[(size_t)T * 4 + (size_t)tok * 4 + head], l2 = LSE[(size_t)2 * T * 4 + (size_t)tok * 4 + head];
        const float mx = fmaxf(l0, fmaxf(l1, l2)); float w0 = __expf(l0 - mx), w1 = __expf(l1 - mx), w2 = __expf(l2 - mx); const float inv = 1.0f / (w0 + w1 + w2); w0 *= inv; w1 *= inv; w2 *= inv;
        const size_t off = (size_t)tok * 512 + 8 * F.lane;
        const u32x4 a0 = *(const u32x4*)((const bf16_t*)(a.ws + X_QO) + off), a1 = *(const u32x4*)((const bf16_t*)(a.ws + X_QO + 32 * MiB) + off), a2 = *(const u32x4*)((const bf16_t*)(a.ws + X_QO + 64 * MiB) + off);
        const u32x4 z = *(const u32x4*)(ZA + off);
        u32x4 y;
        y.x = pk2((w0 * bflo(a0.x) + w1 * bflo(a1.x) + w2 * bflo(a2.x)) * bflo(z.x), (w0 * bfhi(a0.x) + w1 * bfhi(a1.x) + w2 * bfhi(a2.x)) * bfhi(z.x));
        y.y = pk2((w0 * bflo(a0.y) + w1 * bflo(a1.y) + w2 * bflo(a2.y)) * bflo(z.y), (w0 * bfhi(a0.y) + w1 * bfhi(a1.y) + w2 * bfhi(a2.y)) * bfhi(z.y));
        y.z = pk2((w0 * bflo(a0.z) + w1 * bflo(a1.z) + w2 * bflo(a2.z)) * bflo(z.z), (w0 * bfhi(a0.z) + w1 * bfhi(a1.z) + w2 * bfhi(a2.z)) * bfhi(z.z));
        y.w = pk2((w0 * bflo(a0.w) + w1 * bflo(a1.w) + w2 * bflo(a2.w)) * bflo(z.w), (w0 * bfhi(a0.w) + w1 * bfhi(a1.w) + w2 * bfhi(a2.w)) * bfhi(z.w));
        *(u32x4*)(YA + off) = y;
    }
}

constexpr int AT_STR = 272, AT_K = 0, AT_V = 256 * AT_STR;
__device__ __forceinline__ void phase_attn(const Frame& F, const Args& a, int g) {
    const int tid = F.tid, lane = F.lane, wid = F.wave, fr = lane & 15, fq = lane >> 4;
    LAS unsigned char* lds = F.lds;
    const int d = (g == 0) ? 1 : (g == 1 ? 4 : 16), L = SEQ / d, upc = L / 128;
    bf16_t* QO = (bf16_t*)(a.ws + X_QO + (size_t)g * 32 * MiB); const bf16_t* KA = (const bf16_t*)(a.ws + X_KA); const bf16_t* VA = (const bf16_t*)(a.ws + X_VA);
    float* LSEg = (float*)(a.ws + WS_LSE) + (size_t)g * T * 4;
    for (int u = F.bid; u < 1024; u += F.G) {
        const int cls = u & 31, r = cls / upc, jj = cls % upc, h = (u >> 5) & 3, b = u >> 7;
        const int t0 = 128 * jj, tk0 = t0 - 64;
        const size_t tokb = (size_t)b * SEQ + r;
        __syncthreads();
#pragma unroll
        for (int i = 0; i < 8; ++i) { const int c = tid + 512 * i, row = c >> 4, ch = c & 15, tk = tk0 + row;
            u32x4 kv = {0u, 0u, 0u, 0u}, vv = {0u, 0u, 0u, 0u};
            if (tk >= 0 && tk < L) { const size_t go = (tokb + (size_t)tk * d) * 512 + h * 128 + ch * 8; kv = *(const u32x4*)(KA + go); vv = *(const u32x4*)(VA + go); }
            *(LAS u32x4*)(lds + AT_K + row * AT_STR + ch * 16) = kv; *(LAS u32x4*)(lds + AT_V + row * AT_STR + ch * 16) = vv; }
        const int tq = t0 + 16 * wid + fr; const size_t qoff = (tokb + (size_t)tq * d) * 512 + h * 128;
        bf16x8 qf[4];
#pragma unroll
        for (int ks = 0; ks < 4; ++ks) qf[ks] = *(const bf16x8*)(QO + qoff + 32 * ks + 8 * fq);
        __syncthreads();
        f32x4 s[10]; float m = -1e30f;
#pragma unroll
        for (int kt = 0; kt < 9; ++kt) { s[kt] = (f32x4){0.f, 0.f, 0.f, 0.f};
#pragma unroll
            for (int ks = 0; ks < 4; ++ks) { const bf16x8 ka = *(const LAS bf16x8*)(lds + AT_K + (16 * wid + 16 * kt + fr) * AT_STR + (32 * ks + 8 * fq) * 2);
                s[kt] = __builtin_amdgcn_mfma_f32_16x16x32_bf16(ka, qf[ks], s[kt], 0, 0, 0); }
#pragma unroll
            for (int rg = 0; rg < 4; ++rg) { const int diff = 16 * kt + 4 * fq + rg - 64 - fr, tk = tk0 + 16 * wid + 16 * kt + 4 * fq + rg;
                const bool valid = (diff >= -64) && (diff <= 64) && (tk >= 0) && (tk < L);
                if (!valid) s[kt][rg] = -1e30f; m = fmaxf(m, s[kt][rg]); } }
        m = fmaxf(m, __shfl_xor(m, 16)); m = fmaxf(m, __shfl_xor(m, 32));
        float l = 0.f;
#pragma unroll
        for (int kt = 0; kt < 9; ++kt)
#pragma unroll
            for (int rg = 0; rg < 4; ++rg) { const float p = __expf(s[kt][rg] - m); s[kt][rg] = p; l += p; }
        s[9] = (f32x4){0.f, 0.f, 0.f, 0.f};
        l += __shfl_xor(l, 16); l += __shfl_xor(l, 32);
        bf16x8 pf[5];
#pragma unroll
        for (int sidx = 0; sidx < 5; ++sidx) pf[sidx] = pack8(s[2 * sidx], s[2 * sidx + 1]);
        const float invl = 1.0f / l;
#pragma unroll
        for (int t = 0; t < 8; ++t) { f32x4 o = {0.f, 0.f, 0.f, 0.f};
#pragma unroll
            for (int sidx = 0; sidx < 5; ++sidx) { int r1 = 16 * wid + 32 * sidx + 4 * fq + (fr >> 2), r2 = r1 + 16; r1 = r1 > 255 ? 255 : r1; r2 = r2 > 255 ? 255 : r2;
                const int cofs = (16 * t + 4 * (fr & 3)) * 2;
                const bf16x8 va = cat8(trread(lds + AT_V + r1 * AT_STR + cofs), trread(lds + AT_V + r2 * AT_STR + cofs));
                o = __builtin_amdgcn_mfma_f32_16x16x32_bf16(va, pf[sidx], o, 0, 0, 0); }
            u32x2 w; w.x = pk2(o[0] * invl, o[1] * invl); w.y = pk2(o[2] * invl, o[3] * invl);
            *(u32x2*)(QO + qoff + 16 * t + 4 * fq) = w; }
        if (fq == 0) LSEg[(tokb + (size_t)tq * d) * 4 + h] = m + __logf(l);
    }
}


__device__ __forceinline__ void run_proj(const Frame& F, unsigned char* ws, const bf16_t* WIN, const bf16_t* Hh, const float* ropec, const float* ropes, int tau0, int ntiles) {
    pg8::Gemm gm{Hh, WIN + (size_t)tau0 * 256 * 1024, T, ntiles * 256, 1024}; pg8::StaticOrder S; S.init(T, ntiles * 256, F.G, F.bid);
    EpiProj E{tau0, ws, ropec, ropes};
    pg8::gemm_phase<EpiProj, pg8::StaticOrder, true, true>(F.lds, gm, S, E);
}

constexpr int PH_PER_LAYER = 14, N_PHASES = 1 + 2 * PH_PER_LAYER + 1;
template <int P> __global__ void __launch_bounds__(NTHR, 2) hybrid_phase(Args args, int layer) {
    extern __shared__ __attribute__((aligned(16))) unsigned char lds_raw[];
    Frame F; F.lds = (LAS unsigned char*)lds_raw; F.tid = threadIdx.x; F.lane = F.tid & 63; F.wave = __builtin_amdgcn_readfirstlane(F.tid >> 6); F.G = gridDim.x; F.bid = blockIdx.x;
    unsigned char* ws = args.ws;
    const float* ropec = (const float*)(ws + WS_ROPEC); const float* ropes = (const float*)(ws + WS_ROPES);
    const bf16_t* WIN = (const bf16_t*)(ws + WS_WIN + layer * WIN_BYTES);
    const bf16_t* Hh = (const bf16_t*)(ws + WS_H);
    if constexpr (P == 14) phase_prologue(F, args);
    if constexpr (P == 15) phase_prep(F, args, 2, args.out, args.out, args.in[11] + 1024, nullptr);
    if constexpr (P == 0) { if (layer == 0) phase_prep(F, args, 0, args.in[0], nullptr, nullptr, args.in[1]); else phase_prep(F, args, 1, args.in[0], args.out, args.in[11], args.in[1] + 1024); }
    if constexpr (P == 1) run_proj(F, ws, WIN, Hh, ropec, ropes, 0, 9);
    if constexpr (P == 2) phase_gla_pre(F, args, layer);
    if constexpr (P == 3) phase_gla_scan(F, args);
    if constexpr (P == 4) run_proj(F, ws, WIN, Hh, ropec, ropes, 9, 10);
    if constexpr (P == 5) { phase_comb_b(F, args, layer); phase_attn(F, args, 0); }
    if constexpr (P == 6) run_proj(F, ws, WIN, Hh, ropec, ropes, 19, 6);
    if constexpr (P == 7) phase_attn(F, args, 1);
    if constexpr (P == 8) run_proj(F, ws, WIN, Hh, ropec, ropes, 25, 8);
    if constexpr (P == 9) phase_attn(F, args, 2);
    if constexpr (P == 10) { phase_comb_a(F, args); run_proj(F, ws, WIN, Hh, ropec, ropes, 33, 8); }
    if constexpr (P == 11) { pg8::Gemm gm{(const bf16_t*)(ws + X_YA), (const bf16_t*)(ws + WS_WA + layer * MiB), T, 1024, 512}; pg8::StaticOrder S; S.init(T, 1024, F.G, F.bid);
        EpiGate<false> E{(const bf16_t*)(ws + X_GA), nullptr, (bf16_t*)(ws + X_TMP)};
        pg8::gemm_phase<EpiGate<false>, pg8::StaticOrder, true, true>(F.lds, gm, S, E); }
    if constexpr (P == 12) { pg8::Gemm gm{(const bf16_t*)(ws + X_OF), (const bf16_t*)(ws + WS_WB + layer * 2 * MiB), T, 1024, 1024}; pg8::StaticOrder S; S.init(T, 1024, F.G, F.bid);
        EpiGate<true> E{(const bf16_t*)(ws + X_GB), (const bf16_t*)(ws + X_TMP), (bf16_t*)(ws + WS_H)};
        pg8::gemm_phase<EpiGate<true>, pg8::StaticOrder, true, true>(F.lds, gm, S, E); }
    if constexpr (P == 13) { pg8::Gemm gm{(const bf16_t*)(ws + WS_H), (const bf16_t*)(ws + WS_WO + layer * 2 * MiB), T, 1024, 1024}; pg8::StaticOrder S; S.init(T, 1024, F.G, F.bid);
        EpiOut E{(bf16_t*)(ws + X_OUT), (float*)(ws + WS_ROWSS)};
        pg8::gemm_phase<EpiOut, pg8::StaticOrder, true, true>(F.lds, gm, S, E); }
}

template <int P> static void launch_phase(int grid, hipStream_t stream, const Args& a, int layer) {
    static bool attr_set = false;
    if (!attr_set) { (void)hipFuncSetAttribute((const void*)hybrid_phase<P>, hipFuncAttributeMaxDynamicSharedMemorySize, LDS_BYTES); attr_set = true; }
    hipLaunchKernelGGL(hybrid_phase<P>, dim3(grid), dim3(NTHR), LDS_BYTES, stream, a, layer);
}

extern "C" void kernel_launch(void* const* d_in, const int* in_sizes, int n_in, void* d_out, int out_size, void* d_ws, size_t ws_size, hipStream_t stream) {
    static int grid = 0;
    if (grid == 0) {
        if (n_in != 12 || out_size != T * DM || ws_size < WS_END) { fprintf(stderr, "kernel_launch: unexpected shapes (n_in %d out %d ws %zu)\n", n_in, out_size, ws_size); grid = -1; return; }
        int dev = 0, cus = 0;
        if (hipGetDevice(&dev) != hipSuccess || hipDeviceGetAttribute(&cus, hipDeviceAttributeMultiprocessorCount, dev) != hipSuccess) { grid = -1; return; }
        grid = cus;
    }
    if (grid < 0) return;
    Args a{};
    for (int i = 0; i < 12; ++i) a.in[i] = (const float*)d_in[i];
    a.out = (float*)d_out; a.ws = (unsigned char*)d_ws;
    launch_phase<14>(grid, stream, a, 0);
    for (int l = 0; l < 2; ++l) {
        launch_phase<0>(grid, stream, a, l); launch_phase<1>(grid, stream, a, l); launch_phase<2>(grid, stream, a, l); launch_phase<3>(grid, stream, a, l);
        launch_phase<4>(grid, stream, a, l); launch_phase<5>(grid, stream, a, l); launch_phase<6>(grid, stream, a, l); launch_phase<7>(grid, stream, a, l);
        launch_phase<8>(grid, stream, a, l); launch_phase<9>(grid, stream, a, l); launch_phase<10>(grid, stream, a, l); launch_phase<11>(grid, stream, a, l);
        launch_phase<12>(grid, stream, a, l); launch_phase<13>(grid, stream, a, l);
    }
    launch_phase<15>(grid, stream, a, 0);
}
```

```cpp
#include <hip/hip_runtime.h>
#include <cstdio>
#include <cstdint>
__device__ __forceinline__ int fresh_lane() { int l; asm volatile("v_mbcnt_lo_u32_b32 %0, -1, 0\n\tv_mbcnt_hi_u32_b32 %0, -1, %0" : "=v"(l)); return l; }
namespace pg8 {
#define PG8_LAS __attribute__((address_space(3)))
typedef unsigned short bf16_t;
typedef short bf16x8 __attribute__((ext_vector_type(8)));
typedef float f32x4 __attribute__((ext_vector_type(4)));
typedef unsigned u32x4 __attribute__((ext_vector_type(4)));
constexpr int BM = 256, BK = 64, HALF = 128, HTB = HALF * BK * 2  , STAGE_BYTES = 8 * HTB, NXCD = 8, WGM = 8;

__host__ __device__ __forceinline__ int lds_byte(int r, int c) { const int st = (r >> 4) * 2 + (c >> 5), rr = r & 15, cc = c & 31, ob = rr * 64 + cc * 2; return st * 1024 + (ob ^ (((ob >> 9) & 1) << 5)); }
__host__ __device__ __forceinline__ void stage_rc(int b, int& R, int& C) { const int st = b / 1024, sb = b % 1024, swz = sb ^ (((sb >> 9) & 1) << 5); R = (st >> 1) * 16 + swz / 64; C = (st & 1) * 32 + (swz % 64) / 2; }
__host__ __device__ __forceinline__ int perm32(int rho) { const int n = rho >> 4, i = rho & 15; return 8 * (i >> 2) + 4 * n + (i & 3); }

struct Unit { int pm, pn; };
struct Gemm { const bf16_t* A; const bf16_t* Bt; int M, N, K; };

struct StaticOrder {
    int nM, nN, nwg, G, c;
    __host__ __device__ void init(int M, int N, int G_, int c_) { nM = M / BM; nN = N / BM; nwg = nM * nN; G = G_; c = c_; }
    __host__ __device__ bool next(int i, Unit& u) const {
        const long L = (long)i * G + c; if (L >= nwg) return false;
        int wgid = (int)L; { const int q = nwg / NXCD, r = nwg % NXCD, xcd = wgid % NXCD, off = wgid / NXCD; wgid = (xcd < r ? xcd * (q + 1) : r * (q + 1) + (xcd - r) * q) + off; }
        const int nig = WGM * nN, gid = wgid / nig, fm = gid * WGM, gsz = (nM - fm) < WGM ? (nM - fm) : WGM;
        u.pm = fm + ((wgid % nig) % gsz); u.pn = (wgid % nig) / gsz; return true;
    }
    __device__ __forceinline__ void a_ready(const Unit&) const {}
    __device__ __forceinline__ void done(const Unit&) const {}
};


__device__ __forceinline__ unsigned cvt_pk_bf16(float lo, float hi) { unsigned r; asm volatile("v_cvt_pk_bf16_f32 %0, %1, %2" : "=v"(r) : "v"(lo), "v"(hi)); return r; }
template <class Epi, class Sched, bool ALIGN_EPI = false, bool SP2 = false>
__device__ __forceinline__ void gemm_phase(PG8_LAS unsigned char* lds, const Gemm g, const Sched& S, const Epi& E, int wave_id) {
    const int lane = fresh_lane(), wid = wave_id, tid = wid * 64 + lane, wr = wid >> 2, wc = wid & 3, fr = lane & 15, fq = lane >> 4;
    const int K = g.K, nt = K / BK;
    unsigned voffA[2], voffB[2];
#pragma unroll
    for (int i = 0; i < 2; ++i) { int R, C; stage_rc(tid * 16 + i * 8192, R, C); const int Rb = Epi::PERM ? ((R & ~31) + perm32(R & 31)) : R;
        voffA[i] = (unsigned)(R * K + C) * 2u; voffB[i] = (unsigned)(Rb * K + C) * 2u; }
    const size_t kstep = (size_t)(BK * 2);
    const size_t hstep = (size_t)HALF * K * 2;
    const size_t tstep = 2 * hstep;
    const unsigned ldsw = (unsigned)wid * 1024u;
    const int aoff = lds_byte(wr * 64 + fr, fq * 8), boff = lds_byte(wc * 32 + fr, fq * 8);
#define PG8_SA(b, h) (((b) * 2 + (h)) * HTB)
#define PG8_SB(b, h) ((4 + (b) * 2 + (h)) * HTB)
#define PG8_STAGE(bufoff, gbase, voff) do { _Pragma("unroll") for (int _i = 0; _i < 2; ++_i) \
        __builtin_amdgcn_global_load_lds((const unsigned*)((const char*)(gbase) + (voff)[_i]), (PG8_LAS unsigned*)(lds + (bufoff) + ldsw + _i * 8192), 16, 0, 0); } while (0)
#define PG8_LDA(dst, b, h) do { _Pragma("unroll") for (int m = 0; m < 4; ++m) _Pragma("unroll") for (int k = 0; k < 2; ++k) dst[m][k] = *(const PG8_LAS bf16x8*)(lds + PG8_SA(b, h) + aoff + m * 2048 + k * 1024); } while (0)
#define PG8_LDB(dst, b, h) do { _Pragma("unroll") for (int n = 0; n < 2; ++n) _Pragma("unroll") for (int k = 0; k < 2; ++k) dst[n][k] = *(const PG8_LAS bf16x8*)(lds + PG8_SB(b, h) + boff + n * 2048 + k * 1024); } while (0)
#define PG8_MMA(ai, bj, At, Bt) do { __builtin_amdgcn_s_setprio(1); _Pragma("unroll") for (int m = 0; m < 4; ++m) _Pragma("unroll") for (int n = 0; n < 2; ++n) _Pragma("unroll") for (int k = 0; k < 2; ++k) \
        acc[ai][bj][m][n] = __builtin_amdgcn_mfma_f32_16x16x32_bf16(Bt[n][k], At[m][k], acc[ai][bj][m][n], 0, 0, 0); __builtin_amdgcn_s_setprio(0); } while (0)
#define PG8_WAIT_V(n) asm volatile("s_waitcnt vmcnt(" #n ")" ::: "memory")
#define PG8_WAIT_L(n) asm volatile("s_waitcnt lgkmcnt(" #n ")" ::: "memory")
#define PG8_BAR __builtin_amdgcn_s_barrier()
#define PG8_SCHED __builtin_amdgcn_sched_barrier(0)
    Unit cur, nxt; int ui = 0;
    if (!S.next(0, cur)) return;
    f32x4 acc[2][2][4][2];
#pragma unroll
    for (int a = 0; a < 2; ++a)
#pragma unroll
        for (int b = 0; b < 2; ++b)
#pragma unroll
            for (int m = 0; m < 4; ++m)
#pragma unroll
                for (int n = 0; n < 2; ++n) acc[a][b][m][n] = (f32x4){0.f, 0.f, 0.f, 0.f};
    bf16x8 At[4][2], B0[2][2], B1[2][2];
    const char* cA = (const char*)g.A + (size_t)cur.pm * tstep; const char* cB = (const char*)g.Bt + (size_t)cur.pn * tstep;
    S.a_ready(cur);
    if constexpr (SP2) {
        PG8_STAGE(PG8_SB(0, 0), cB, voffB); PG8_STAGE(PG8_SB(0, 1), cB + hstep, voffB); PG8_STAGE(PG8_SA(0, 0), cA, voffA); PG8_STAGE(PG8_SA(0, 1), cA + hstep, voffA);
        if (wr == 1) PG8_BAR;
        PG8_WAIT_V(2); PG8_BAR;
        PG8_STAGE(PG8_SB(1, 0), cB + kstep, voffB); PG8_STAGE(PG8_SA(1, 0), cA + kstep, voffA); PG8_STAGE(PG8_SB(1, 1), cB + hstep + kstep, voffB);
        PG8_WAIT_V(6); PG8_BAR;
    } else {
        PG8_STAGE(PG8_SB(0, 0), cB, voffB); PG8_STAGE(PG8_SA(0, 0), cA, voffA); PG8_STAGE(PG8_SB(0, 1), cB + hstep, voffB); PG8_STAGE(PG8_SA(0, 1), cA + hstep, voffA);
        if (wr == 1) PG8_BAR;
        PG8_WAIT_V(4); PG8_BAR;
        PG8_STAGE(PG8_SB(1, 0), cB + kstep, voffB); PG8_STAGE(PG8_SA(1, 0), cA + kstep, voffA); PG8_STAGE(PG8_SB(1, 1), cB + hstep + kstep, voffB);
        PG8_WAIT_V(6); PG8_BAR;
    }
    for (;;) {
        const bool has_next = S.next(ui + 1, nxt);
        const char* nA = has_next ? (const char*)g.A + (size_t)nxt.pm * tstep : cA; const char* nB = has_next ? (const char*)g.Bt + (size_t)nxt.pn * tstep : cB;
        for (int t = 0; t < nt; t += 2) {
            if constexpr (Epi::MIDT > 0) { if (t == Epi::MIDT) E.mid(acc, cur, wr, wc, fr, fq); }
            const bool last = (t == nt - 2);
            const char* a1 = cA + (size_t)(t + 1) * kstep;
            const char* a2 = last ? nA : cA + (size_t)(t + 2) * kstep; const char* b2 = last ? nB : cB + (size_t)(t + 2) * kstep;
            const char* a3 = a2 + kstep; const char* b3 = b2 + kstep;
            if (last && has_next) S.a_ready(nxt);
            if constexpr (SP2) {
            PG8_LDB(B0, 0, 0); PG8_LDB(B1, 0, 1); PG8_SCHED; PG8_LDA(At, 0, 0); PG8_STAGE(PG8_SA(1, 1), a1 + hstep, voffA);
            PG8_WAIT_V(8); PG8_WAIT_L(0); PG8_BAR; PG8_MMA(0, 0, At, B0); PG8_MMA(0, 1, At, B1); PG8_BAR; PG8_SCHED;
            PG8_LDA(At, 0, 1); PG8_STAGE(PG8_SB(0, 0), b2, voffB); PG8_STAGE(PG8_SB(0, 1), b2 + hstep, voffB); PG8_STAGE(PG8_SA(0, 0), a2, voffA);
            PG8_WAIT_V(8); PG8_WAIT_L(0); PG8_BAR; PG8_MMA(1, 0, At, B0); PG8_MMA(1, 1, At, B1); PG8_BAR; PG8_SCHED;
            PG8_LDB(B0, 1, 0); PG8_LDB(B1, 1, 1); PG8_SCHED; PG8_LDA(At, 1, 0); PG8_STAGE(PG8_SA(0, 1), a2 + hstep, voffA);
            PG8_WAIT_V(8); PG8_WAIT_L(0); PG8_BAR; PG8_MMA(0, 0, At, B0); PG8_MMA(0, 1, At, B1); PG8_BAR; PG8_SCHED;
            PG8_LDA(At, 1, 1); PG8_STAGE(PG8_SB(1, 0), b3, voffB); PG8_STAGE(PG8_SB(1, 1), b3 + hstep, voffB); PG8_STAGE(PG8_SA(1, 0), a3, voffA);
            PG8_WAIT_V(8); PG8_WAIT_L(0); PG8_BAR; PG8_MMA(1, 0, At, B0); PG8_MMA(1, 1, At, B1); PG8_BAR; PG8_SCHED;
            } else {
            PG8_LDB(B0, 0, 0); PG8_SCHED; PG8_LDA(At, 0, 0); PG8_STAGE(PG8_SA(1, 1), a1 + hstep, voffA);
            PG8_WAIT_L(8); PG8_BAR; PG8_WAIT_L(0); PG8_MMA(0, 0, At, B0); PG8_BAR; PG8_SCHED;
            PG8_LDB(B1, 0, 1); PG8_STAGE(PG8_SB(0, 0), b2, voffB);
            PG8_BAR; PG8_WAIT_L(0); PG8_MMA(0, 1, At, B1); PG8_BAR;
            PG8_LDA(At, 0, 1); PG8_STAGE(PG8_SA(0, 0), a2, voffA);
            PG8_BAR; PG8_WAIT_L(0); PG8_MMA(1, 0, At, B0); PG8_BAR; PG8_SCHED;
            PG8_STAGE(PG8_SB(0, 1), b2 + hstep, voffB);
            PG8_WAIT_V(6); PG8_BAR; PG8_MMA(1, 1, At, B1); PG8_BAR;
            PG8_LDB(B0, 1, 0); PG8_SCHED; PG8_LDA(At, 1, 0); PG8_STAGE(PG8_SA(0, 1), a2 + hstep, voffA);
            PG8_WAIT_L(8); PG8_BAR; PG8_WAIT_L(0); PG8_MMA(0, 0, At, B0); PG8_BAR; PG8_SCHED;
            PG8_LDB(B1, 1, 1); PG8_STAGE(PG8_SB(1, 0), b3, voffB);
            PG8_BAR; PG8_WAIT_L(0); PG8_MMA(0, 1, At, B1); PG8_BAR;
            PG8_LDA(At, 1, 1); PG8_STAGE(PG8_SA(1, 0), a3, voffA);
            PG8_BAR; PG8_WAIT_L(0); PG8_MMA(1, 0, At, B0); PG8_BAR; PG8_SCHED;
            PG8_STAGE(PG8_SB(1, 1), b3 + hstep, voffB);
            PG8_WAIT_V(6); PG8_BAR; PG8_MMA(1, 1, At, B1); PG8_BAR;
            }
        }
        if constexpr (ALIGN_EPI) { if (wr == 0) PG8_BAR; }
        if constexpr (!Epi::AFTER_DRAIN) { E(acc, cur, wr, wc, fr, fq); S.done(cur); }
        if (!has_next) break;
#pragma unroll
        for (int a = 0; a < 2; ++a)
#pragma unroll
            for (int b = 0; b < 2; ++b)
#pragma unroll
                for (int m = 0; m < 4; ++m)
#pragma unroll
                    for (int n = 0; n < 2; ++n) acc[a][b][m][n] = (f32x4){0.f, 0.f, 0.f, 0.f};
        cur = nxt; cA = nA; cB = nB; ++ui;
        if constexpr (ALIGN_EPI) { if (wr == 1) PG8_BAR; }
    }
    PG8_WAIT_V(0);
    if constexpr (!ALIGN_EPI) { if (wr == 0) PG8_BAR; }
    PG8_BAR;
    if constexpr (Epi::AFTER_DRAIN) { E.fused(acc, cur, wr, wc, fr, fq, lds, wid, lane); S.done(cur); }
#undef PG8_SA
#undef PG8_SB
#undef PG8_STAGE
#undef PG8_LDA
#undef PG8_LDB
#undef PG8_MMA
#undef PG8_WAIT_V
#undef PG8_WAIT_L
#undef PG8_BAR
#undef PG8_SCHED
}
}

#define LAS __attribute__((address_space(3)))
typedef unsigned short bf16_t;
typedef short bf16x8 __attribute__((ext_vector_type(8)));
typedef short s16x4 __attribute__((ext_vector_type(4)));
typedef float f32x4 __attribute__((ext_vector_type(4)));
typedef float f32x2 __attribute__((ext_vector_type(2)));
typedef unsigned u32x4 __attribute__((ext_vector_type(4)));
typedef unsigned u32x2 __attribute__((ext_vector_type(2)));

constexpr int NWAVES = 8, NTHR = 512;
constexpr int T = 32768, DM = 1024, SEQ = 4096, NB = 8;
constexpr int IN_DIM = 10272;
constexpr int NWIN_TILES = 41, NWIN = NWIN_TILES * 256;
constexpr float NORM_EPS = 1e-6f;
constexpr float QSCALE = 0.08838834764831845f;

constexpr size_t MiB = 1u << 20;
constexpr size_t WS_CTL = 0;
constexpr size_t WS_WIN = 1 * MiB;
constexpr size_t WIN_BYTES = (size_t)NWIN * 1024 * 2;
constexpr size_t WS_WA = 42 * MiB;
constexpr size_t WS_WB = 44 * MiB;
constexpr size_t WS_WO = 48 * MiB;
constexpr size_t WS_ROPEC = 52 * MiB, WS_ROPES = WS_ROPEC + 256 * 1024;
constexpr size_t WS_LSE = 53 * MiB;
constexpr size_t WS_LR = 55 * MiB;
constexpr size_t WS_ROWSS = 59 * MiB;
constexpr size_t WS_H = 62 * MiB;
constexpr size_t WS_X = 126 * MiB;
constexpr size_t X_QO = WS_X + 0 * MiB, X_KA = WS_X + 96 * MiB, X_VA = WS_X + 192 * MiB, X_ZA = WS_X + 288 * MiB;
constexpr size_t X_GQ = WS_X + 96 * MiB, X_GK = WS_X + 128 * MiB, X_GVL = WS_X + 160 * MiB, X_GVH = WS_X + 352 * MiB, X_BF = WS_X + 0 * MiB, X_BB = WS_X + 32 * MiB;
constexpr size_t X_OF = WS_X + 192 * MiB, X_OB = WS_X + 288 * MiB;
constexpr int OF_LD = 1536, OF_C0 = 512;
constexpr size_t X_ZB = WS_X + 0 * MiB, X_GA = WS_X + 64 * MiB, X_GB = WS_X + 128 * MiB, X_OUT = WS_X + 0 * MiB;
constexpr size_t WS_END = WS_X + 384 * MiB;

constexpr int LDS_BYTES = 147456;

__device__ __forceinline__ float bf2f(unsigned v) { return __uint_as_float(v << 16); }
__device__ __forceinline__ float bflo(unsigned w) { return __uint_as_float(w << 16); }
__device__ __forceinline__ float bfhi(unsigned w) { return __uint_as_float(w & 0xffff0000u); }
typedef __bf16 bf16x2_t __attribute__((ext_vector_type(2)));
__device__ __forceinline__ unsigned pk2(float lo, float hi) { f32x2 v = {lo, hi}; bf16x2_t b = __builtin_convertvector(v, bf16x2_t); return __builtin_bit_cast(unsigned, b); }
template <int M> __device__ __forceinline__ float xsum(float v) {
    if constexpr (M < 32) return v + __builtin_bit_cast(float, __builtin_amdgcn_ds_swizzle(__builtin_bit_cast(int, v), (M << 10) | 0x1F));
    else { const unsigned u = __builtin_bit_cast(unsigned, v); auto r = __builtin_amdgcn_permlane32_swap(u, u, false, false); return __builtin_bit_cast(float, r[0]) + __builtin_bit_cast(float, r[1]); }
}
template <int M> __device__ __forceinline__ float xmax(float v) {
    if constexpr (M < 32) return fmaxf(v, __builtin_bit_cast(float, __builtin_amdgcn_ds_swizzle(__builtin_bit_cast(int, v), (M << 10) | 0x1F)));
    else { const unsigned u = __builtin_bit_cast(unsigned, v); auto r = __builtin_amdgcn_permlane32_swap(u, u, false, false); return fmaxf(__builtin_bit_cast(float, r[0]), __builtin_bit_cast(float, r[1])); }
}
__device__ __forceinline__ float wave_sum(float v) { v += __shfl_xor(v, 1); v += __shfl_xor(v, 2); v += __shfl_xor(v, 4); v += __shfl_xor(v, 8); v += __shfl_xor(v, 16); v += __shfl_xor(v, 32); return v; }
__device__ __forceinline__ float sigmoidf_(float x) { return __builtin_amdgcn_rcpf(1.0f + __builtin_amdgcn_exp2f(-1.4426950408889634f * x)); }

struct EpiProj {
    static constexpr bool PERM = true, AFTER_DRAIN = false; static constexpr int MIDT = 0;
    int tau0; unsigned char* ws; const float* ropec; const float* ropes;
    __device__ __forceinline__ void operator()(const f32x4 (&acc)[2][2][4][2], const pg8::Unit& u, int wr, int wc, int fr, int fq) const {
        const int tau = tau0 + u.pn;
        int mode = 0, ldc = 512, colt = 0, dsh = 0; bf16_t* base = nullptr;
        if (tau < 18) { const int g = tau / 6, t = (tau % 6) >> 1, half = tau & 1; colt = half * 256; dsh = 2 * g;
                        base = (bf16_t*)(ws + (t == 0 ? X_QO : (t == 1 ? X_KA : X_VA)) + (size_t)g * 32 * MiB); mode = t < 2 ? 3 : 0; }
        else if (tau < 20) { base = (bf16_t*)(ws + X_ZA); colt = (tau - 18) * 256; mode = 1; }
        else if (tau < 22) { base = (bf16_t*)(ws + X_GQ); colt = (tau - 20) * 256; }
        else if (tau < 24) { base = (bf16_t*)(ws + X_GK); colt = (tau - 22) * 256; }
        else if (tau < 28) { base = (bf16_t*)(ws + (tau < 26 ? X_GVL : X_GVH)); colt = ((tau - 24) & 1) * 256; }
        else if (tau == 28) { mode = 4; }
        else if (tau < 33) { base = (bf16_t*)(ws + X_ZB); ldc = 1024; colt = (tau - 29) * 256; mode = 1; }
        else if (tau < 37) { base = (bf16_t*)(ws + X_GA); ldc = 1024; colt = (tau - 33) * 256; mode = 2; }
        else { base = (bf16_t*)(ws + X_GB); ldc = 1024; colt = (tau - 37) * 256; mode = 2; }
        const int row0 = u.pm * 256 + wr * 64 + fr;
        if (mode == 4) {
            if (wc == 0) { float* LR = (float*)(ws + WS_LR);
#pragma unroll
                for (int ai = 0; ai < 2; ++ai)
#pragma unroll
                    for (int m = 0; m < 4; ++m) { float* rp = LR + (size_t)(row0 + ai * 128 + m * 16) * 32 + 8 * fq;
                        *(f32x4*)(rp) = acc[ai][0][m][0]; *(f32x4*)(rp + 4) = acc[ai][0][m][1]; } }
            return;
        }
        const int col0 = colt + wc * 32 + 8 * fq;
#pragma unroll
        for (int ai = 0; ai < 2; ++ai) {
            f32x4 csv[4], snv[4];
            if (mode == 3 && wc == 0) {
#pragma unroll
                for (int m = 0; m < 4; ++m) { const int pos = (row0 + ai * 128 + m * 16) & (SEQ - 1); csv[m] = *(const f32x4*)(ropec + pos * 16 + 4 * fq); snv[m] = *(const f32x4*)(ropes + pos * 16 + 4 * fq); } }
#pragma unroll
            for (int m = 0; m < 4; ++m) { const int row = row0 + ai * 128 + m * 16;
                const int srow = (row & ~(SEQ - 1)) | (((row & ((1 << dsh) - 1)) << (12 - dsh)) | ((row & (SEQ - 1)) >> dsh));
                bf16_t* rowp = base + (size_t)srow * ldc + col0;
                const f32x4 cs = csv[m], sn = snv[m];
#pragma unroll
                for (int bj = 0; bj < 2; ++bj) { f32x4 v0 = acc[ai][bj][m][0], v1 = acc[ai][bj][m][1];
                    if (mode == 1) {
#pragma unroll
                        for (int j = 0; j < 4; ++j) { v0[j] = v0[j] * sigmoidf_(v0[j]); v1[j] = v1[j] * sigmoidf_(v1[j]); } }
                    else if (mode == 2) {
#pragma unroll
                        for (int j = 0; j < 4; ++j) { v0[j] = sigmoidf_(v0[j]); v1[j] = sigmoidf_(v1[j]); } }
                    else if (mode == 3 && wc == 0) {
                        f32x4 a = v0, b = v1;
                        v0[0] = a[0] * cs[0] - a[1] * sn[0]; v0[1] = a[1] * cs[0] + a[0] * sn[0]; v0[2] = a[2] * cs[1] - a[3] * sn[1]; v0[3] = a[3] * cs[1] + a[2] * sn[1];
                        v1[0] = b[0] * cs[2] - b[1] * sn[2]; v1[1] = b[1] * cs[2] + b[0] * sn[2]; v1[2] = b[2] * cs[3] - b[3] * sn[3]; v1[3] = b[3] * cs[3] + b[2] * sn[3]; }
                    u32x4 w; w.x = pk2(v0[0], v0[1]); w.y = pk2(v0[2], v0[3]); w.z = pk2(v1[0], v1[1]); w.w = pk2(v1[2], v1[3]);
                    *(u32x4*)(rowp + bj * 128) = w; } } }
    }
};
struct EpiMerge {
    static constexpr bool PERM = true, AFTER_DRAIN = false; static constexpr int MIDT = 8;
    const bf16_t* GA; const bf16_t* GB; bf16_t* O;
    __device__ __forceinline__ void mid(f32x4 (&acc)[2][2][4][2], const pg8::Unit& u, int wr, int wc, int fr, int fq) const {
        int row0 = u.pm * 256 + wr * 64 + fr; const int col0 = u.pn * 256 + wc * 32 + 8 * fq;
#pragma unroll
        for (int ai = 0; ai < 2; ++ai)
#pragma unroll
            for (int mh = 0; mh < 2; ++mh) {
                asm volatile("" : "+v"(row0));
                u32x4 ga[2][2], gb[2][2];
#pragma unroll
                for (int m2 = 0; m2 < 2; ++m2) { const size_t off = (size_t)(row0 + ai * 128 + (2 * mh + m2) * 16) * 1024 + col0;
#pragma unroll
                    for (int bj = 0; bj < 2; ++bj) { ga[m2][bj] = *(const u32x4*)(GA + off + bj * 128); gb[m2][bj] = *(const u32x4*)(GB + off + bj * 128); } }
#pragma unroll
                for (int m2 = 0; m2 < 2; ++m2)
#pragma unroll
                    for (int bj = 0; bj < 2; ++bj) { const u32x4 a = ga[m2][bj], b = gb[m2][bj]; f32x4& v0 = acc[ai][bj][2 * mh + m2][0]; f32x4& v1 = acc[ai][bj][2 * mh + m2][1];
                        v0[0] *= bflo(a.x) * __builtin_amdgcn_rcpf(bflo(b.x)); v0[1] *= bfhi(a.x) * __builtin_amdgcn_rcpf(bfhi(b.x));
                        v0[2] *= bflo(a.y) * __builtin_amdgcn_rcpf(bflo(b.y)); v0[3] *= bfhi(a.y) * __builtin_amdgcn_rcpf(bfhi(b.y));
                        v1[0] *= bflo(a.z) * __builtin_amdgcn_rcpf(bflo(b.z)); v1[1] *= bfhi(a.z) * __builtin_amdgcn_rcpf(bfhi(b.z));
                        v1[2] *= bflo(a.w) * __builtin_amdgcn_rcpf(bflo(b.w)); v1[3] *= bfhi(a.w) * __builtin_amdgcn_rcpf(bfhi(b.w)); }
                asm volatile("" ::: "memory"); }
    }
    __device__ __forceinline__ void operator()(const f32x4 (&acc)[2][2][4][2], const pg8::Unit& u, int wr, int wc, int fr, int fq) const {
        int row0 = u.pm * 256 + wr * 64 + fr; const int col0 = u.pn * 256 + wc * 32 + 8 * fq;
#pragma unroll
        for (int ai = 0; ai < 2; ++ai) {
            asm volatile("" : "+v"(row0));
            u32x4 g[4][2];
#pragma unroll
            for (int m = 0; m < 4; ++m) { const size_t off = (size_t)(row0 + ai * 128 + m * 16) * 1024 + col0;
#pragma unroll
                for (int bj = 0; bj < 2; ++bj) g[m][bj] = *(const u32x4*)(GB + off + bj * 128); }
#pragma unroll
            for (int m = 0; m < 4; ++m) { const size_t off = (size_t)(row0 + ai * 128 + m * 16) * 1024 + col0;
#pragma unroll
                for (int bj = 0; bj < 2; ++bj) { const u32x4 gg = g[m][bj]; const f32x4 v0 = acc[ai][bj][m][0], v1 = acc[ai][bj][m][1];
                    u32x4 w; w.x = pk2(v0[0] * bflo(gg.x), v0[1] * bfhi(gg.x)); w.y = pk2(v0[2] * bflo(gg.y), v0[3] * bfhi(gg.y)); w.z = pk2(v1[0] * bflo(gg.z), v1[1] * bfhi(gg.z)); w.w = pk2(v1[2] * bflo(gg.w), v1[3] * bfhi(gg.w));
                    *(u32x4*)(O + off + bj * 128) = w; } }
            asm volatile("" ::: "memory"); }
    }
};
struct EpiOut {
    static constexpr bool PERM = true, AFTER_DRAIN = false; static constexpr int MIDT = 0;
    bf16_t* O; float* rowss;
    __device__ __forceinline__ void operator()(const f32x4 (&acc)[2][2][4][2], const pg8::Unit& u, int wr, int wc, int fr, int fq) const {
        const int row0 = u.pm * 256 + wr * 64 + fr, col0 = u.pn * 256 + wc * 32 + 8 * fq;
#pragma unroll
        for (int ai = 0; ai < 2; ++ai)
#pragma unroll
            for (int m = 0; m < 4; ++m) { const int row = row0 + ai * 128 + m * 16; const size_t off = (size_t)row * 1024 + col0; float s = 0.f;
#pragma unroll
                for (int bj = 0; bj < 2; ++bj) { const f32x4 v0 = acc[ai][bj][m][0], v1 = acc[ai][bj][m][1];
                    s += (v0[0] * v0[0] + v0[1] * v0[1]) + (v0[2] * v0[2] + v0[3] * v0[3]) + (v1[0] * v1[0] + v1[1] * v1[1]) + (v1[2] * v1[2] + v1[3] * v1[3]);
                    u32x4 w; w.x = pk2(v0[0], v0[1]); w.y = pk2(v0[2], v0[3]); w.z = pk2(v1[0], v1[1]); w.w = pk2(v1[2], v1[3]);
                    *(u32x4*)(O + off + bj * 128) = w; }
                s += __shfl_xor(s, 16); s += __shfl_xor(s, 32);
                if (fq == 0) rowss[(size_t)row * 16 + u.pn * 4 + wc] = s; }
    }
};

struct Args { const float* in[12]; float* out; unsigned char* ws; int ph_lo, ph_hi; };

struct Frame { LAS unsigned char* lds; int tid, lane, wave, G, bid; };

__device__ __forceinline__ int win_src(int np, float& sc) {
    sc = 1.f; const int tau = np >> 8, c = np & 255;
    if (tau < 18) { const int g = np / 1536, rem = np % 1536, t = rem / 512, hc = rem % 512, h = hc >> 7, d = hc & 127;
        int ds = d; if (t < 2 && d < 32) ds = (d & 1) ? 16 + (d >> 1) : (d >> 1);
        if (t == 0) sc = QSCALE;
        return g * 1536 + t * 512 + h * 128 + ds; }
    if (tau < 20) return 4608 + (np - 18 * 256);
    if (tau < 22) { sc = QSCALE; return 5120 + (np - 20 * 256); }
    if (tau < 24) return 5632 + (np - 22 * 256);
    if (tau < 28) return 6144 + (np - 24 * 256);
    if (tau == 28) return c < 32 ? 10240 + c : -1;
    if (tau < 33) return 7168 + (np - 29 * 256);
    return 8192 + (np - 33 * 256);
}
template <bool IS_WIN> __device__ __forceinline__ void transpose_item(const float* W, int K, int Nsrc, int Ndst, bf16_t* WT, LAS float* scr, int item, int lane, int ldd = 0, int koff = 0) {
    if (ldd == 0) ldd = K;
    const int nblk = Ndst / 32, kb = item / nblk, nb = item % nblk, k0 = 64 * kb, n0 = 32 * nb;
    const int np = n0 + (lane & 31); float sc = 1.f; int src = np; if (IS_WIN) src = win_src(np, sc);
#pragma unroll 8
    for (int i = 0; i < 32; ++i) { const int kk = 2 * i + (lane >> 5); float v = 0.f; if (src >= 0) v = W[(size_t)(k0 + kk) * Nsrc + src] * sc; scr[kk * 33 + (lane & 31)] = v; }
    asm volatile("s_waitcnt lgkmcnt(0)" ::: "memory");
    const int c = lane & 7;
#pragma unroll
    for (int j = 0; j < 4; ++j) { const int n = (lane >> 3) + 8 * j; const LAS float* s = scr + (8 * c) * 33 + n;
        u32x4 o; o.x = pk2(s[0 * 33], s[1 * 33]); o.y = pk2(s[2 * 33], s[3 * 33]); o.z = pk2(s[4 * 33], s[5 * 33]); o.w = pk2(s[6 * 33], s[7 * 33]);
        *(u32x4*)(WT + (size_t)(n0 + n) * ldd + koff + k0 + 8 * c) = o; }
    asm volatile("s_waitcnt lgkmcnt(0)" ::: "memory");
}
__device__ __forceinline__ void phase_prologue(const Frame& F, const Args& a) {
    LAS float* scr = (LAS float*)(F.lds + F.wave * 16384);
    const int gw = F.bid * NWAVES + F.wave, NGW = F.G * NWAVES;
    constexpr int I_WIN = 16 * (NWIN / 32), I_WA = 8 * 32, I_WB = 16 * 32, I_WO = 16 * 32, I_L = I_WIN + I_WA + I_WB + I_WO;
    for (int it = gw; it < 2 * I_L; it += NGW) {
        const int l = it / I_L; int r = it % I_L;
        if (r < I_WIN) { transpose_item<true>(a.in[2] + (size_t)l * 1024 * IN_DIM, 1024, IN_DIM, NWIN, (bf16_t*)(a.ws + WS_WIN + l * WIN_BYTES), scr, r, F.lane); continue; } r -= I_WIN;
        if (r < I_WA) { transpose_item<false>(a.in[8] + (size_t)l * 512 * 1024, 512, 1024, 1024, (bf16_t*)(a.ws + WS_WA + l * 3 * MiB), scr, r, F.lane, 1536, 0); continue; } r -= I_WA;
        if (r < I_WB) { transpose_item<false>(a.in[9] + (size_t)l * 1024 * 1024, 1024, 1024, 1024, (bf16_t*)(a.ws + WS_WA + l * 3 * MiB), scr, r, F.lane, 1536, 512); continue; } r -= I_WB;
        transpose_item<false>(a.in[10] + (size_t)l * 1024 * 1024, 1024, 1024, 1024, (bf16_t*)(a.ws + WS_WO + l * 2 * MiB), scr, r, F.lane);
    }
    float* rc = (float*)(a.ws + WS_ROPEC); float* rs = (float*)(a.ws + WS_ROPES);
    for (int e = F.bid * NTHR + F.tid; e < SEQ * 16; e += F.G * NTHR) { const int pos = e >> 4, i = e & 15;
        const float inv = (float)pow(500000.0, -(double)(2 * i) / 32.0); const float ang = (float)pos * inv;
        rc[e] = (float)cos((double)ang); rs[e] = (float)sin((double)ang); }
}

__device__ __forceinline__ void phase_prep(const Frame& F, const Args& a, int mode, const float* xprev, float* xout, const float* wpost, const float* wpre) {
    const int gw = F.bid * NWAVES + F.wave, NGW = F.G * NWAVES;
    const bf16_t* OUT = (const bf16_t*)(a.ws + X_OUT); const float* rowss = (const float*)(a.ws + WS_ROWSS); bf16_t* H = (bf16_t*)(a.ws + WS_H);
    f32x4 wpo[4], wpr[4];
#pragma unroll
    for (int j = 0; j < 4; ++j) { wpo[j] = (mode != 0) ? *((const f32x4*)wpost + F.lane + 64 * j) : (f32x4){0.f, 0.f, 0.f, 0.f}; wpr[j] = (mode != 2) ? *((const f32x4*)wpre + F.lane + 64 * j) : (f32x4){0.f, 0.f, 0.f, 0.f}; }
    for (int row0 = gw; row0 < T; row0 += 2 * NGW) {
        f32x4 v[2][4]; u32x2 ov[2][4]; float ssv[2];
#pragma unroll
        for (int rr = 0; rr < 2; ++rr) { const int row = row0 + rr * NGW; const f32x4* xr = (const f32x4*)(xprev + (size_t)row * DM) + F.lane;
#pragma unroll
            for (int j = 0; j < 4; ++j) v[rr][j] = __builtin_nontemporal_load(xr + 64 * j);
            if (mode != 0) { ssv[rr] = rowss[(size_t)row * 16 + (F.lane & 15)]; const u32x2* orow = (const u32x2*)(OUT + (size_t)row * DM) + F.lane;
#pragma unroll
                for (int j = 0; j < 4; ++j) ov[rr][j] = __builtin_nontemporal_load(orow + 64 * j); } }
#pragma unroll
        for (int rr = 0; rr < 2; ++rr) { const int row = row0 + rr * NGW;
            if (mode != 0) {
                float ss = ssv[rr];
                ss += __shfl_xor(ss, 1); ss += __shfl_xor(ss, 2); ss += __shfl_xor(ss, 4); ss += __shfl_xor(ss, 8);
                const float rstd = __builtin_amdgcn_rsqf(ss * (1.0f / DM) + NORM_EPS);
#pragma unroll
                for (int j = 0; j < 4; ++j) { const u32x2 o = ov[rr][j]; const f32x4 w = wpo[j];
                    v[rr][j][0] += bflo(o.x) * rstd * w[0]; v[rr][j][1] += bfhi(o.x) * rstd * w[1]; v[rr][j][2] += bflo(o.y) * rstd * w[2]; v[rr][j][3] += bfhi(o.y) * rstd * w[3]; }
                f32x4* xo = (f32x4*)(xout + (size_t)row * DM) + F.lane;
#pragma unroll
                for (int j = 0; j < 4; ++j) __builtin_nontemporal_store(v[rr][j], xo + 64 * j);
            }
            if (mode != 2) {
                float s = 0.f;
#pragma unroll
                for (int j = 0; j < 4; ++j) s += (v[rr][j][0] * v[rr][j][0] + v[rr][j][1] * v[rr][j][1]) + (v[rr][j][2] * v[rr][j][2] + v[rr][j][3] * v[rr][j][3]);
                const float rstd = __builtin_amdgcn_rsqf(wave_sum(s) * (1.0f / DM) + NORM_EPS);
                u32x2* ho = (u32x2*)(H + (size_t)row * DM) + F.lane;
#pragma unroll
                for (int j = 0; j < 4; ++j) { const f32x4 w = wpr[j]; u32x2 o;
                    o.x = pk2(v[rr][j][0] * rstd * w[0], v[rr][j][1] * rstd * w[1]); o.y = pk2(v[rr][j][2] * rstd * w[2], v[rr][j][3] * rstd * w[3]); ho[64 * j] = o; }
            }
        }
    }
}

#define LDS_BARRIER() do { asm volatile("s_waitcnt lgkmcnt(0)" ::: "memory"); __builtin_amdgcn_s_barrier(); asm volatile("" ::: "memory"); } while (0)
constexpr int GP_Q = 0, GP_K = 65536, GP_LR = 131072;
__device__ __forceinline__ void phase_gla_pre(const Frame& F, const Args& a, int layer) {
    const int tid = F.tid, dir = tid >> 8, c2 = (tid & 255) * 2;
    LAS unsigned char* lds = F.lds;
    const float* LR = (const float*)(a.ws + WS_LR);
    bf16_t* GQ = (bf16_t*)(a.ws + X_GQ); bf16_t* GK = (bf16_t*)(a.ws + X_GK);
    bf16_t* QDo = dir ? GQ : (bf16_t*)(a.ws + X_BF); bf16_t* KIo = dir ? GK : (bf16_t*)(a.ws + X_BB);
    float* DEC = (float*)(a.ws + WS_ROWSS);
    const float* Wup = (dir ? a.in[5] : a.in[3]) + (size_t)layer * 16 * 512; const float* bias = (dir ? a.in[6] : a.in[4]) + (size_t)layer * 512;
    f32x2 w[16];
#pragma unroll
    for (int i = 0; i < 16; ++i) w[i] = *(const f32x2*)(Wup + i * 512 + c2);
    const f32x2 bz = *(const f32x2*)(bias + c2);
    for (int item = F.bid; item < NB * 64; item += F.G) {
        const size_t tok0 = (size_t)item * 64;
        __syncthreads();
#pragma unroll
        for (int i = 0; i < 8; ++i) { const int c = tid + 512 * i, r = c >> 6, ch = c & 63;
            *(LAS u32x4*)(lds + GP_Q + r * 1024 + ch * 16) = __builtin_nontemporal_load((const u32x4*)(GQ + (tok0 + r) * 512 + ch * 8));
            *(LAS u32x4*)(lds + GP_K + r * 1024 + ch * 16) = __builtin_nontemporal_load((const u32x4*)(GK + (tok0 + r) * 512 + ch * 8)); }
        *(LAS f32x4*)(lds + GP_LR + 16 * tid) = *(const f32x4*)(LR + tok0 * 32 + 4 * tid);
        __syncthreads();
        f32x2 accum = {0.f, 0.f};
#pragma unroll 4
        for (int s0 = 0; s0 < 64; ++s0) { const int t = dir ? 63 - s0 : s0;
            const LAS f32x4* lr4 = (const LAS f32x4*)(lds + GP_LR + t * 128 + dir * 64);
            f32x2 xa = bz, xb = {0.f, 0.f}, xc = {0.f, 0.f}, xd = {0.f, 0.f};
            { const f32x4 l0 = lr4[0], l1 = lr4[1], l2 = lr4[2], l3 = lr4[3];
              xa += w[0] * l0[0]; xb += w[4] * l1[0]; xc += w[8] * l2[0]; xd += w[12] * l3[0];
              xa += w[1] * l0[1]; xb += w[5] * l1[1]; xc += w[9] * l2[1]; xd += w[13] * l3[1];
              xa += w[2] * l0[2]; xb += w[6] * l1[2]; xc += w[10] * l2[2]; xd += w[14] * l3[2];
              xa += w[3] * l0[3]; xb += w[7] * l1[3]; xc += w[11] * l2[3]; xd += w[15] * l3[3]; }
            const f32x2 x = (xa + xb) + (xc + xd);
            const float ls0 = fminf(x[0], 0.f) - 0.6931471805599453f * __builtin_amdgcn_logf(1.0f + __builtin_amdgcn_exp2f(-1.4426950408889634f * fabsf(x[0])));
            const float ls1 = fminf(x[1], 0.f) - 0.6931471805599453f * __builtin_amdgcn_logf(1.0f + __builtin_amdgcn_exp2f(-1.4426950408889634f * fabsf(x[1])));
            accum[0] += ls0 * (1.0f / 16.0f); accum[1] += ls1 * (1.0f / 16.0f);
            const float e0 = __builtin_amdgcn_exp2f(1.4426950408889634f * accum[0]), e1 = __builtin_amdgcn_exp2f(1.4426950408889634f * accum[1]);
            const float i0 = __builtin_amdgcn_rcpf(e0), i1 = __builtin_amdgcn_rcpf(e1);
            const unsigned qw = *(const LAS unsigned*)(lds + GP_Q + t * 1024 + c2 * 2), kw = *(const LAS unsigned*)(lds + GP_K + t * 1024 + c2 * 2);
            *(unsigned*)(QDo + (tok0 + t) * 512 + c2) = pk2(bflo(qw) * e0, bfhi(qw) * e1);
            *(unsigned*)(KIo + (tok0 + t) * 512 + c2) = pk2(bflo(kw) * i0, bfhi(kw) * i1);
        }
        *(f32x2*)(DEC + ((size_t)dir * NB * 64 + item) * 512 + c2) = (f32x2){__builtin_amdgcn_exp2f(1.4426950408889634f * accum[0]), __builtin_amdgcn_exp2f(1.4426950408889634f * accum[1])};
    }
}

constexpr int GS_STR = 272, GS_KSTR = 288, GS_VSTR = 160;
constexpr int GS_QD = 0, GS_KI = 64 * GS_STR, GS_V = GS_KI + 64 * GS_KSTR, GS_DEC = GS_V + 64 * GS_VSTR, GS_BUF = GS_DEC + 512;
constexpr int GS_ST = 2 * GS_BUF, GS_STB = 64 * GS_STR;
__device__ __forceinline__ s16x4 trread(const LAS unsigned char* p) { return __builtin_bit_cast(s16x4, __builtin_amdgcn_ds_read_tr16_b64_v4i16((LAS s16x4*)p)); }
__device__ __forceinline__ bf16x8 cat8(s16x4 lo, s16x4 hi) { return (bf16x8){lo[0], lo[1], lo[2], lo[3], hi[0], hi[1], hi[2], hi[3]}; }
__device__ __forceinline__ bf16x8 pack8(const f32x4& a, const f32x4& b) { u32x4 w; w.x = pk2(a[0], a[1]); w.y = pk2(a[2], a[3]); w.z = pk2(b[0], b[1]); w.w = pk2(b[2], b[3]); return __builtin_bit_cast(bf16x8, w); }

#define GS_LANE_VARS() const int lane = lane0, fr = lane & 15, fq = lane >> 4; (void)fr; (void)fq
#define GS_LOAD_CHUNK(ch) do { const int ch_ = (ch); const unsigned char* q_ = qdb + (size_t)ch_ * 65536 + lqk; const unsigned char* k_ = kib + (size_t)ch_ * 65536 + lqk; const unsigned char* v_ = gvb + (size_t)ch_ * 65536 + lv; \
        pq[0] = *(const u32x4*)(q_); pq[1] = *(const u32x4*)(q_ + 128); pq[2] = *(const u32x4*)(q_ + 8192); pq[3] = *(const u32x4*)(q_ + 8192 + 128); \
        pk[0] = *(const u32x4*)(k_); pk[1] = *(const u32x4*)(k_ + 128); pk[2] = *(const u32x4*)(k_ + 8192); pk[3] = *(const u32x4*)(k_ + 8192 + 128); \
        pv[0] = __builtin_nontemporal_load((const u32x4*)(v_)); pv[1] = __builtin_nontemporal_load((const u32x4*)(v_ + 8192)); \
        if (lane < 32) pdec = *(const float*)(decb + (size_t)ch_ * 2048 + (32 * sw + lane) * 4); } while (0)
#define GS_STAGE(bufi) do { LAS unsigned char* nl_ = F.lds + (bufi) * GS_BUF; LAS unsigned char* p_ = nl_ + GS_QD + ra * GS_STR + ci; LAS unsigned char* k2_ = nl_ + GS_KI + ra * GS_KSTR + ci; LAS unsigned char* v2_ = nl_ + GS_V + ra * GS_VSTR + ci; \
        *(LAS u32x4*)(p_) = pq[0]; *(LAS u32x4*)(p_ + 128) = pq[1]; *(LAS u32x4*)(p_ + 8 * GS_STR) = pq[2]; *(LAS u32x4*)(p_ + 8 * GS_STR + 128) = pq[3]; \
        *(LAS u32x4*)(k2_) = pk[0]; *(LAS u32x4*)(k2_ + 128) = pk[1]; *(LAS u32x4*)(k2_ + 8 * GS_KSTR) = pk[2]; *(LAS u32x4*)(k2_ + 8 * GS_KSTR + 128) = pk[3]; \
        *(LAS u32x4*)(v2_) = pv[0]; *(LAS u32x4*)(v2_ + 8 * GS_VSTR) = pv[1]; if (lane < 32) *(LAS float*)(nl_ + GS_DEC + (32 * sw + lane) * 4) = pdec; } while (0)
#define GS_STAGE_VARS() const int ra = 16 * sw + (lane >> 3), ci = (lane & 7) * 16; const unsigned lqk = (unsigned)(ra * 1024 + ci), lv = lqk

template <bool HEAVY>
__device__ __forceinline__ void gs_out_loop(const Frame& F, const int lane0, const int cb, const int dir, const int sA, const int sB, unsigned char* ob, const int OLD) {
            float mk[2][4];
            {   GS_LANE_VARS(); const int sD = HEAVY ? sB : sA, c = 16 * cb + fr;
#pragma unroll
                for (int jj = 0; jj < 2; ++jj)
#pragma unroll
                    for (int r = 0; r < 4; ++r) { const int j = 32 * sD + 16 * jj + 4 * fq + r; mk[jj][r] = (dir ? (j > c) : (j <= c)) ? 1.f : 0.f; } }
            u32x2 ow[4] = {{0u, 0u}, {0u, 0u}, {0u, 0u}, {0u, 0u}}; unsigned char* oc = ob;
            __syncthreads();
            for (int step = 0; step < 64; ++step) {
                GS_LANE_VARS();
                const int chunk = dir ? 63 - step : step;
                const LAS unsigned char* lds = F.lds + (step & 1) * GS_BUF;
                const LAS unsigned char* stR = F.lds + GS_ST + (step & 1) * GS_STB;
                bf16x8 qb[4], stf[4][4], kaA[2][4], kaB[2][4], viA[4], viB[4];
#pragma unroll
                for (int ks = 0; ks < 4; ++ks) qb[ks] = *(const LAS bf16x8*)(lds + GS_QD + (16 * cb + fr) * GS_STR + (32 * ks + 8 * fq) * 2);
#pragma unroll
                for (int jj = 0; jj < 2; ++jj)
#pragma unroll
                    for (int ks = 0; ks < 4; ++ks) kaA[jj][ks] = *(const LAS bf16x8*)(lds + GS_KI + (32 * sA + 16 * jj + fr) * GS_KSTR + (32 * ks + 8 * fq) * 2);
                if constexpr (HEAVY) {
#pragma unroll
                    for (int jj = 0; jj < 2; ++jj)
#pragma unroll
                        for (int ks = 0; ks < 4; ++ks) kaB[jj][ks] = *(const LAS bf16x8*)(lds + GS_KI + (32 * sB + 16 * jj + fr) * GS_KSTR + (32 * ks + 8 * fq) * 2);
                }
#pragma unroll
                for (int t = 0; t < 4; ++t)
#pragma unroll
                    for (int ks = 0; ks < 4; ++ks) stf[t][ks] = *(const LAS bf16x8*)(stR + (16 * t + fr) * GS_STR + (32 * ks + 8 * fq) * 2);
                const LAS unsigned char* vb = lds + GS_V + (4 * fq + (fr >> 2)) * GS_VSTR + (4 * (fr & 3)) * 2;
#pragma unroll
                for (int t = 0; t < 4; ++t) viA[t] = cat8(trread(vb + (32 * sA) * GS_VSTR + 32 * t), trread(vb + (32 * sA + 16) * GS_VSTR + 32 * t));
                if constexpr (HEAVY) {
#pragma unroll
                    for (int t = 0; t < 4; ++t) viB[t] = cat8(trread(vb + (32 * sB) * GS_VSTR + 32 * t), trread(vb + (32 * sB + 16) * GS_VSTR + 32 * t));
                }
                if (step > 0) { const unsigned lo = (unsigned)((16 * cb + fr) * OLD + 4 * fq) * 2u;
#pragma unroll
                    for (int t = 0; t < 4; ++t) __builtin_nontemporal_store(ow[t], (u32x2*)(oc + lo + 32 * t)); }
                f32x4 atA[2] = {(f32x4){0.f, 0.f, 0.f, 0.f}, (f32x4){0.f, 0.f, 0.f, 0.f}}, atB[2] = {(f32x4){0.f, 0.f, 0.f, 0.f}, (f32x4){0.f, 0.f, 0.f, 0.f}};
#pragma unroll
                for (int ks = 0; ks < 4; ++ks)
#pragma unroll
                    for (int jj = 0; jj < 2; ++jj) atA[jj] = __builtin_amdgcn_mfma_f32_16x16x32_bf16(kaA[jj][ks], qb[ks], atA[jj], 0, 0, 0);
                if constexpr (HEAVY) {
#pragma unroll
                    for (int ks = 0; ks < 4; ++ks)
#pragma unroll
                        for (int jj = 0; jj < 2; ++jj) atB[jj] = __builtin_amdgcn_mfma_f32_16x16x32_bf16(kaB[jj][ks], qb[ks], atB[jj], 0, 0, 0);
                }
                f32x4 oT[4];
#pragma unroll
                for (int t = 0; t < 4; ++t) oT[t] = (f32x4){0.f, 0.f, 0.f, 0.f};
#pragma unroll
                for (int ks = 0; ks < 4; ++ks)
#pragma unroll
                    for (int t = 0; t < 4; ++t) oT[t] = __builtin_amdgcn_mfma_f32_16x16x32_bf16(stf[t][ks], qb[ks], oT[t], 0, 0, 0);
                if constexpr (HEAVY) {
#pragma unroll
                    for (int jj = 0; jj < 2; ++jj)
#pragma unroll
                        for (int r = 0; r < 4; ++r) atB[jj][r] *= mk[jj][r];
                    const bf16x8 pfA = pack8(atA[0], atA[1]), pfB = pack8(atB[0], atB[1]);
#pragma unroll
                    for (int t = 0; t < 4; ++t) oT[t] = __builtin_amdgcn_mfma_f32_16x16x32_bf16(viA[t], pfA, oT[t], 0, 0, 0);
#pragma unroll
                    for (int t = 0; t < 4; ++t) oT[t] = __builtin_amdgcn_mfma_f32_16x16x32_bf16(viB[t], pfB, oT[t], 0, 0, 0);
                } else {
#pragma unroll
                    for (int jj = 0; jj < 2; ++jj)
#pragma unroll
                        for (int r = 0; r < 4; ++r) atA[jj][r] *= mk[jj][r];
                    const bf16x8 pfA = pack8(atA[0], atA[1]);
#pragma unroll
                    for (int t = 0; t < 4; ++t) oT[t] = __builtin_amdgcn_mfma_f32_16x16x32_bf16(viA[t], pfA, oT[t], 0, 0, 0);
                }
#pragma unroll
                for (int t = 0; t < 4; ++t) { ow[t].x = pk2(oT[t][0], oT[t][1]); ow[t].y = pk2(oT[t][2], oT[t][3]); }
                oc = ob + (size_t)chunk * 64 * OLD * 2;
                LDS_BARRIER();
            }
            {   GS_LANE_VARS(); const unsigned lo = (unsigned)((16 * cb + fr) * OLD + 4 * fq) * 2u;
#pragma unroll
                for (int t = 0; t < 4; ++t) *(u32x2*)(oc + lo + 32 * t) = ow[t]; }
}

__device__ __forceinline__ void phase_gla_scan(const Frame& F, const Args& a) {
    const int lane0 = F.lane, wid = F.wave;
    for (int u = F.bid; u < 256; u += F.G) {
        const int slot = u >> 3, dvq = slot & 3, grp = (u & 7) * 8 + (slot >> 2), dir = grp & 1, h = (grp >> 1) & 3, b = grp >> 3;
        const unsigned char* qdb = a.ws + (dir ? X_GQ : X_BF) + ((size_t)b * SEQ * 512 + h * 128) * 2; const unsigned char* kib = a.ws + (dir ? X_GK : X_BB) + ((size_t)b * SEQ * 512 + h * 128) * 2;
        const unsigned char* gvb = a.ws + (h < 2 ? X_GVL : X_GVH) + ((size_t)b * SEQ * 512 + (h & 1) * 256 + dvq * 64) * 2;
        const unsigned char* decb = a.ws + WS_ROWSS + (((size_t)dir * NB * 64 + (size_t)b * 64) * 512 + h * 128) * 4;
        const int OLD = dir ? 1024 : OF_LD;
        unsigned char* ob = a.ws + (dir ? X_OB : X_OF) + ((size_t)b * SEQ * OLD + (dir ? 0 : OF_C0) + h * 256 + dvq * 64) * 2;
        __syncthreads();
        {   GS_LANE_VARS(); const int tid = wid * 64 + lane;
            LAS unsigned char* p = F.lds + GS_ST + (tid >> 3) * GS_STR + (tid & 7) * 16; *(LAS u32x4*)p = (u32x4){0u, 0u, 0u, 0u}; *(LAS u32x4*)(p + 128) = (u32x4){0u, 0u, 0u, 0u}; }
        if (wid < 4) {
            const int cb = wid;
            const int sA = dir ? 1 : 0, sB = 1 - sA;
            const bool both = dir ? (cb <= 1) : (cb >= 2);
            if (both) { __builtin_amdgcn_s_setprio(2); gs_out_loop<true>(F, lane0, cb, dir, sA, sB, ob, OLD); __builtin_amdgcn_s_setprio(0); } else gs_out_loop<false>(F, lane0, cb, dir, sA, sB, ob, OLD);
        } else {
            const int sw = wid - 4;
            u32x4 pq[4], pk[4], pv[2]; float pdec = 0.f;
            {   GS_LANE_VARS(); GS_STAGE_VARS(); GS_LOAD_CHUNK(dir ? 63 : 0); GS_STAGE(0); GS_LOAD_CHUNK(dir ? 62 : 1); }
            f32x4 S[2][4];
#pragma unroll
            for (int d = 0; d < 2; ++d)
#pragma unroll
                for (int t = 0; t < 4; ++t) S[d][t] = (f32x4){0.f, 0.f, 0.f, 0.f};
            __syncthreads();
            for (int step = 0; step < 64; ++step) {
                GS_LANE_VARS();
                const LAS unsigned char* lds = F.lds + (step & 1) * GS_BUF;
                LAS unsigned char* stW = F.lds + GS_ST + ((step + 1) & 1) * GS_STB;
                bf16x8 kef[2][2], vi[4][2];
                const LAS unsigned char* vb = lds + GS_V + (4 * fq + (fr >> 2)) * GS_VSTR + (4 * (fr & 3)) * 2;
#pragma unroll
                for (int t = 0; t < 4; ++t) { vi[t][0] = cat8(trread(vb + 32 * t), trread(vb + 16 * GS_VSTR + 32 * t)); vi[t][1] = cat8(trread(vb + 32 * GS_VSTR + 32 * t), trread(vb + 48 * GS_VSTR + 32 * t)); }
#pragma unroll
                for (int d = 0; d < 2; ++d) { const LAS unsigned char* kb = lds + GS_KI + (4 * fq + (fr >> 2)) * GS_KSTR + (32 * sw + 16 * d + 4 * (fr & 3)) * 2;
                    kef[d][0] = cat8(trread(kb), trread(kb + 16 * GS_KSTR)); kef[d][1] = cat8(trread(kb + 32 * GS_KSTR), trread(kb + 48 * GS_KSTR)); }
                f32x4 dcv[2];
#pragma unroll
                for (int d = 0; d < 2; ++d) dcv[d] = *(const LAS f32x4*)(lds + GS_DEC + (32 * sw + 16 * d + 4 * fq) * 4);
#pragma unroll
                for (int sidx = 0; sidx < 2; ++sidx)
#pragma unroll
                    for (int d = 0; d < 2; ++d)
#pragma unroll
                        for (int t = 0; t < 4; ++t) S[d][t] = __builtin_amdgcn_mfma_f32_16x16x32_bf16(kef[d][sidx], vi[t][sidx], S[d][t], 0, 0, 0);
#pragma unroll
                for (int d = 0; d < 2; ++d)
#pragma unroll
                    for (int t = 0; t < 4; ++t) { S[d][t] = S[d][t] * dcv[d]; u32x2 w; w.x = pk2(S[d][t][0], S[d][t][1]); w.y = pk2(S[d][t][2], S[d][t][3]);
                        *(LAS u32x2*)(stW + (16 * t + fr) * GS_STR + (32 * sw + 16 * d + 4 * fq) * 2) = w; }
                {   GS_STAGE_VARS();
                    if (step < 63) GS_STAGE((step + 1) & 1);
                    if (step < 62) GS_LOAD_CHUNK(dir ? 61 - step : step + 2); }
                LDS_BARRIER();
            }
        }
    }
}

__device__ __forceinline__ void phase_comb_b(const Frame& F, const Args& a, int layer) {
    const int gw = F.bid * NWAVES + F.wave, NGW = F.G * NWAVES;
    bf16_t* OF = (bf16_t*)(a.ws + X_OF); const bf16_t* OB = (const bf16_t*)(a.ws + X_OB); const bf16_t* ZB = (const bf16_t*)(a.ws + X_ZB);
    const float* wn = a.in[7] + (size_t)layer * 256 + 8 * (F.lane & 31);
    const f32x4 w0 = *(const f32x4*)wn, w1 = *(const f32x4*)(wn + 4);
    for (int tok0 = gw; tok0 < T; tok0 += 2 * NGW) {
        u32x4 f[4], bq[4], z[4];
#pragma unroll
        for (int q = 0; q < 4; ++q) { const int tok = tok0 + (q >> 1) * NGW, hh = q & 1; const size_t off = (size_t)tok * 1024 + hh * 512 + 8 * F.lane, offf = (size_t)tok * OF_LD + OF_C0 + hh * 512 + 8 * F.lane;
            f[q] = __builtin_nontemporal_load((const u32x4*)(OF + offf)); bq[q] = __builtin_nontemporal_load((const u32x4*)(OB + off)); z[q] = __builtin_nontemporal_load((const u32x4*)(ZB + off)); }
#pragma unroll
        for (int q = 0; q < 4; ++q) { const int tok = tok0 + (q >> 1) * NGW, hh = q & 1; const size_t offf = (size_t)tok * OF_LD + OF_C0 + hh * 512 + 8 * F.lane;
            float o[8];
            o[0] = bflo(f[q].x) + bflo(bq[q].x); o[1] = bfhi(f[q].x) + bfhi(bq[q].x); o[2] = bflo(f[q].y) + bflo(bq[q].y); o[3] = bfhi(f[q].y) + bfhi(bq[q].y);
            o[4] = bflo(f[q].z) + bflo(bq[q].z); o[5] = bfhi(f[q].z) + bfhi(bq[q].z); o[6] = bflo(f[q].w) + bflo(bq[q].w); o[7] = bfhi(f[q].w) + bfhi(bq[q].w);
            float ss = (o[0] * o[0] + o[1] * o[1]) + (o[2] * o[2] + o[3] * o[3]) + (o[4] * o[4] + o[5] * o[5]) + (o[6] * o[6] + o[7] * o[7]);
            ss += __shfl_xor(ss, 1); ss += __shfl_xor(ss, 2); ss += __shfl_xor(ss, 4); ss += __shfl_xor(ss, 8); ss += __shfl_xor(ss, 16);
            const float rstd = __builtin_amdgcn_rsqf(ss * (1.0f / 256.0f) + NORM_EPS);
            u32x4 y;
            y.x = pk2(o[0] * rstd * w0[0] * bflo(z[q].x), o[1] * rstd * w0[1] * bfhi(z[q].x)); y.y = pk2(o[2] * rstd * w0[2] * bflo(z[q].y), o[3] * rstd * w0[3] * bfhi(z[q].y));
            y.z = pk2(o[4] * rstd * w1[0] * bflo(z[q].z), o[5] * rstd * w1[1] * bfhi(z[q].z)); y.w = pk2(o[6] * rstd * w1[2] * bflo(z[q].w), o[7] * rstd * w1[3] * bfhi(z[q].w));
            *(u32x4*)(OF + offf) = y; }
    }
}

__device__ __forceinline__ void phase_comb_a(const Frame& F, const Args& a, int ch0, int nch) {
    const float* LSE = (const float*)(a.ws + WS_LSE); const bf16_t* ZA = (const bf16_t*)(a.ws + X_ZA); bf16_t* YA = (bf16_t*)(a.ws + X_OF);
    const int head = F.lane >> 4;
    for (int ch = ch0; ch < ch0 + nch; ++ch) {
#pragma unroll 1
        for (int trip = 0; trip < 2; ++trip) {
            const int tokb = ch * 32 + F.wave + 16 * trip;
            float l0[2], l1[2], l2[2]; u32x4 a0[2], a1[2], a2[2], z[2];
#pragma unroll
            for (int rr = 0; rr < 2; ++rr) { const int tok = tokb + 8 * rr; const size_t off = (size_t)tok * 512 + 8 * F.lane;
                const int sq = tok & (SEQ - 1), bb = tok & ~(SEQ - 1); const int t1 = bb | ((sq & 3) << 10) | (sq >> 2), t2 = bb | ((sq & 15) << 8) | (sq >> 4);
                const size_t off1 = (size_t)t1 * 512 + 8 * F.lane, off2 = (size_t)t2 * 512 + 8 * F.lane;
                l0[rr] = LSE[(size_t)tok * 4 + head]; l1[rr] = LSE[(size_t)T * 4 + (size_t)t1 * 4 + head]; l2[rr] = LSE[(size_t)2 * T * 4 + (size_t)t2 * 4 + head];
                a0[rr] = __builtin_nontemporal_load((const u32x4*)((const bf16_t*)(a.ws + X_QO) + off)); a1[rr] = __builtin_nontemporal_load((const u32x4*)((const bf16_t*)(a.ws + X_QO + 32 * MiB) + off1)); a2[rr] = __builtin_nontemporal_load((const u32x4*)((const bf16_t*)(a.ws + X_QO + 64 * MiB) + off2));
                z[rr] = __builtin_nontemporal_load((const u32x4*)(ZA + off)); }
#pragma unroll
            for (int rr = 0; rr < 2; ++rr) { const int tok = tokb + 8 * rr;
                const float mx = fmaxf(l0[rr], fmaxf(l1[rr], l2[rr]));
                float w0 = __builtin_amdgcn_exp2f(1.4426950408889634f * (l0[rr] - mx)), w1 = __builtin_amdgcn_exp2f(1.4426950408889634f * (l1[rr] - mx)), w2 = __builtin_amdgcn_exp2f(1.4426950408889634f * (l2[rr] - mx));
                const float inv = __builtin_amdgcn_rcpf(w0 + w1 + w2); w0 *= inv; w1 *= inv; w2 *= inv;
                const u32x4 p = a0[rr], q = a1[rr], r = a2[rr], zz = z[rr];
                u32x4 y;
                y.x = pk2((w0 * bflo(p.x) + w1 * bflo(q.x) + w2 * bflo(r.x)) * bflo(zz.x), (w0 * bfhi(p.x) + w1 * bfhi(q.x) + w2 * bfhi(r.x)) * bfhi(zz.x));
                y.y = pk2((w0 * bflo(p.y) + w1 * bflo(q.y) + w2 * bflo(r.y)) * bflo(zz.y), (w0 * bfhi(p.y) + w1 * bfhi(q.y) + w2 * bfhi(r.y)) * bfhi(zz.y));
                y.z = pk2((w0 * bflo(p.z) + w1 * bflo(q.z) + w2 * bflo(r.z)) * bflo(zz.z), (w0 * bfhi(p.z) + w1 * bfhi(q.z) + w2 * bfhi(r.z)) * bfhi(zz.z));
                y.w = pk2((w0 * bflo(p.w) + w1 * bflo(q.w) + w2 * bflo(r.w)) * bflo(zz.w), (w0 * bfhi(p.w) + w1 * bfhi(q.w) + w2 * bfhi(r.w)) * bfhi(zz.w));
                *(u32x4*)(YA + (size_t)tok * OF_LD + 8 * F.lane) = y; }
        }
    }
}

constexpr int AT_STR = 272, AT_VSTR = 288, AT_K = 0, AT_V = 256 * AT_STR;
__device__ __forceinline__ void phase_attn(const Frame& F, const Args& a, unsigned* qctr) {
    const int tid = F.tid, lane = F.lane, wid = F.wave, fr = lane & 15, fq = lane >> 4;
    LAS unsigned char* lds = F.lds;
    constexpr int NU = 3072, NRUN = NU / 4;
    u32x4 pk[8], pv[8];
    auto geom = [&](int ug, int& g, int& d, int& L, int& r, int& jj, int& h, int& b) { g = ug >> 10; const int u = ug & 1023; d = (g == 0) ? 1 : (g == 1 ? 4 : 16); L = SEQ / d; const int upc = L / 128;
        const int cls = u & 31; r = cls / upc; jj = cls % upc; h = (u >> 5) & 3; b = u >> 7; };
    auto prefetch = [&](int ug, bool reuse) {
        int g, d, L, r, jj, h, b; geom(ug, g, d, L, r, jj, h, b);
        const bf16_t* KA = (const bf16_t*)(a.ws + X_KA + (size_t)g * 32 * MiB); const bf16_t* VA = (const bf16_t*)(a.ws + X_VA + (size_t)g * 32 * MiB);
        const int tk0 = 128 * jj - 64; const size_t tokb = (size_t)b * SEQ + (size_t)r * L;
        if (!reuse) {
#pragma unroll
            for (int i = 0; i < 4; ++i) { const int c = tid + 512 * i, row = c >> 4, ch = c & 15, tk = tk0 + row; const int tkc = tk < 0 ? 0 : (tk >= L ? L - 1 : tk);
                const size_t go = (tokb + (size_t)tkc) * 512 + h * 128 + ch * 8; pk[i] = *(const u32x4*)(KA + go); pv[i] = *(const u32x4*)(VA + go); } }
#pragma unroll
        for (int i = 4; i < 8; ++i) { const int c = tid + 512 * i, row = c >> 4, ch = c & 15, tk = tk0 + row; const int tkc = tk < 0 ? 0 : (tk >= L ? L - 1 : tk);
            const size_t go = (tokb + (size_t)tkc) * 512 + h * 128 + ch * 8; pk[i] = *(const u32x4*)(KA + go); pv[i] = *(const u32x4*)(VA + go); }
    };
    volatile LAS unsigned* qslot = (volatile LAS unsigned*)(F.lds + LDS_BYTES - 256 + 64);
    int R = F.bid;
    if (R < NRUN) prefetch(4 * R, false);
    while (R < NRUN) {
      int Rn = NRUN;
#pragma unroll 1
      for (int k = 0; k < 4; ++k) {
        const int ug = 4 * R + k;
        int g, d, L, r, jj, h, b; geom(ug, g, d, L, r, jj, h, b);
        const bool reuse = (k > 0) && (jj > 0);
        bf16_t* QO = (bf16_t*)(a.ws + X_QO + (size_t)g * 32 * MiB); float* LSEg = (float*)(a.ws + WS_LSE) + (size_t)g * T * 4;
        const int t0 = 128 * jj, tk0 = t0 - 64;
        const size_t tokb = (size_t)b * SEQ + (size_t)r * L;
        LDS_BARRIER();
        if (k == 3) Rn = (int)*qslot;
        if (!reuse) {
#pragma unroll
            for (int i = 0; i < 4; ++i) { const int c = tid + 512 * i, slot = (tk0 + (c >> 4)) & 255, ch = c & 15;
                *(LAS u32x4*)(lds + AT_K + slot * AT_STR + ch * 16) = pk[i]; *(LAS u32x4*)(lds + AT_V + slot * AT_VSTR + ch * 16) = pv[i]; } }
#pragma unroll
        for (int i = 4; i < 8; ++i) { const int c = tid + 512 * i, slot = (tk0 + (c >> 4)) & 255, ch = c & 15;
            *(LAS u32x4*)(lds + AT_K + slot * AT_STR + ch * 16) = pk[i]; *(LAS u32x4*)(lds + AT_V + slot * AT_VSTR + ch * 16) = pv[i]; }
        const int tq = t0 + 16 * wid + fr; const size_t qoff = (tokb + (size_t)tq) * 512 + h * 128;
        bf16x8 qf[4];
#pragma unroll
        for (int ks = 0; ks < 4; ++ks) qf[ks] = *(const bf16x8*)(QO + qoff + 32 * ks + 8 * fq);
        if (k < 3) { int g2, d2, L2, r2, jj2, h2, b2; geom(ug + 1, g2, d2, L2, r2, jj2, h2, b2); prefetch(ug + 1, jj2 > 0); }
        else if (Rn < NRUN) prefetch(4 * Rn, false);
        LDS_BARRIER();
        unsigned pulled = (unsigned)NRUN; if (k == 0 && tid == 0) pulled = (unsigned)F.G + __hip_atomic_fetch_add(qctr, 1u, __ATOMIC_RELAXED, __HIP_MEMORY_SCOPE_AGENT);
        f32x4 s[10]; float m = -1e30f;
        const LAS unsigned char* kbase = lds + AT_K + fr * AT_STR + (8 * fq) * 2;
        const int ktile0 = tk0 + 16 * wid;
        bf16x8 kfa[8], kfb[8];
#define LOADK(dst, kt0) do { _Pragma("unroll") for (int q_ = 0; q_ < 8; ++q_) { const int kt_ = (kt0) + (q_ >> 2); if (kt_ < 9) dst[q_] = *(const LAS bf16x8*)(kbase + ((ktile0 + 16 * kt_) & 255) * AT_STR + (q_ & 3) * 64); } } while (0)
#define MMAK(src, kt0) do { _Pragma("unroll") for (int q_ = 0; q_ < 8; ++q_) { const int kt_ = (kt0) + (q_ >> 2); if (kt_ < 9) s[kt_] = __builtin_amdgcn_mfma_f32_16x16x32_bf16(src[q_], qf[q_ & 3], s[kt_], 0, 0, 0); } } while (0)
#pragma unroll
        for (int kt = 0; kt < 10; ++kt) s[kt] = (f32x4){0.f, 0.f, 0.f, 0.f};
        LOADK(kfa, 0); __builtin_amdgcn_sched_barrier(0);
        LOADK(kfb, 2); __builtin_amdgcn_sched_barrier(0); MMAK(kfa, 0); __builtin_amdgcn_sched_barrier(0);
        LOADK(kfa, 4); __builtin_amdgcn_sched_barrier(0); MMAK(kfb, 2); __builtin_amdgcn_sched_barrier(0);
        LOADK(kfb, 6); __builtin_amdgcn_sched_barrier(0); MMAK(kfa, 4); __builtin_amdgcn_sched_barrier(0);
        LOADK(kfa, 8); __builtin_amdgcn_sched_barrier(0); MMAK(kfb, 6); __builtin_amdgcn_sched_barrier(0);
        MMAK(kfa, 8);
#undef LOADK
#undef MMAK
#pragma unroll
        for (int kt = 0; kt < 9; ++kt)
#pragma unroll
            for (int rg = 0; rg < 4; ++rg) { const int diff = 16 * kt + 4 * fq + rg - 64 - fr, tk = tk0 + 16 * wid + 16 * kt + 4 * fq + rg;
                const bool valid = (diff >= -64) && (diff <= 64) && (tk >= 0) && (tk < L);
                if (!valid) s[kt][rg] = -1e30f; m = fmaxf(m, s[kt][rg]); }
        m = fmaxf(m, __shfl_xor(m, 16)); m = fmaxf(m, __shfl_xor(m, 32));
        float l = 0.f;
#pragma unroll
        for (int kt = 0; kt < 9; ++kt)
#pragma unroll
            for (int rg = 0; rg < 4; ++rg) { const float p = __builtin_amdgcn_exp2f(1.4426950408889634f * (s[kt][rg] - m)); s[kt][rg] = p; l += p; }
        l += __shfl_xor(l, 16); l += __shfl_xor(l, 32);
        bf16x8 pf[5];
#pragma unroll
        for (int sidx = 0; sidx < 5; ++sidx) pf[sidx] = pack8(s[2 * sidx], s[2 * sidx + 1]);
        const float invl = __builtin_amdgcn_rcpf(l);
        int vr[10];
#pragma unroll
        for (int sidx = 0; sidx < 5; ++sidx) { const int r1 = tk0 + 16 * wid + 32 * sidx + 4 * fq + (fr >> 2), r2 = r1 + 16; vr[2 * sidx] = (r1 & 255) * AT_VSTR; vr[2 * sidx + 1] = (r2 & 255) * AT_VSTR; }
        const LAS unsigned char* vbase = lds + AT_V + (4 * (fr & 3)) * 2;
        bf16x8 vfa[5], vfb[5];
#define LOADV(dst, t) do { _Pragma("unroll") for (int q_ = 0; q_ < 5; ++q_) dst[q_] = cat8(trread(vbase + vr[2 * q_] + (t) * 32), trread(vbase + vr[2 * q_ + 1] + (t) * 32)); } while (0)
#define MMAV(src, t) do { f32x4 o_ = {0.f, 0.f, 0.f, 0.f}; _Pragma("unroll") for (int q_ = 0; q_ < 5; ++q_) o_ = __builtin_amdgcn_mfma_f32_16x16x32_bf16(src[q_], pf[q_], o_, 0, 0, 0); \
            u32x2 w_; w_.x = pk2(o_[0] * invl, o_[1] * invl); w_.y = pk2(o_[2] * invl, o_[3] * invl); *(u32x2*)(QO + qoff + 16 * (t) + 4 * fq) = w_; } while (0)
        LOADV(vfa, 0); __builtin_amdgcn_sched_barrier(0);
        LOADV(vfb, 1); __builtin_amdgcn_sched_barrier(0); MMAV(vfa, 0); __builtin_amdgcn_sched_barrier(0);
        LOADV(vfa, 2); __builtin_amdgcn_sched_barrier(0); MMAV(vfb, 1); __builtin_amdgcn_sched_barrier(0);
        LOADV(vfb, 3); __builtin_amdgcn_sched_barrier(0); MMAV(vfa, 2); __builtin_amdgcn_sched_barrier(0);
        LOADV(vfa, 4); __builtin_amdgcn_sched_barrier(0); MMAV(vfb, 3); __builtin_amdgcn_sched_barrier(0);
        LOADV(vfb, 5); __builtin_amdgcn_sched_barrier(0); MMAV(vfa, 4); __builtin_amdgcn_sched_barrier(0);
        LOADV(vfa, 6); __builtin_amdgcn_sched_barrier(0); MMAV(vfb, 5); __builtin_amdgcn_sched_barrier(0);
        LOADV(vfb, 7); __builtin_amdgcn_sched_barrier(0); MMAV(vfa, 6); __builtin_amdgcn_sched_barrier(0);
        MMAV(vfb, 7);
#undef LOADV
#undef MMAV
        if (fq == 0) LSEg[(tokb + (size_t)tq) * 4 + h] = m + 0.6931471805599453f * __builtin_amdgcn_logf(l);
        if (k == 0 && tid == 0) *qslot = pulled;
      }
      R = Rn;
    }
}

__device__ __forceinline__ void run_proj(const Frame& F, unsigned char* ws, const bf16_t* WIN, const bf16_t* Hh, const float* ropec, const float* ropes, int tau0, int ntiles) {
    pg8::Gemm gm{Hh, WIN + (size_t)tau0 * 256 * 1024, T, ntiles * 256, 1024}; pg8::StaticOrder S; S.init(T, ntiles * 256, F.G, F.bid);
    EpiProj E{tau0, ws, ropec, ropes};
    pg8::gemm_phase<EpiProj, pg8::StaticOrder, true, true>(F.lds, gm, S, E, F.wave);
}

#define XB_TMO      128
#define XB_XCNT(j)  (256  + 64 * (j))
#define XB_XSUB(j)  (1280 + 64 * (j))
#define XB_XGEN(j)  (2304 + 64 * (j))
#define XB_TOP      3328
#define XB_TOPGEN   3392
#define XCD_BAR_WORDS 3456
#define XB_SPIN_CAP (1u << 18)

__device__ __forceinline__ unsigned xb_ld(unsigned* p)              { return __hip_atomic_load(p, __ATOMIC_RELAXED, __HIP_MEMORY_SCOPE_AGENT); }
__device__ __forceinline__ unsigned xb_add(unsigned* p, unsigned v) { return __hip_atomic_fetch_add(p, v, __ATOMIC_RELAXED, __HIP_MEMORY_SCOPE_AGENT); }
__device__ __forceinline__ unsigned xb_xcc_id() { return (unsigned)__builtin_amdgcn_s_getreg((3 << 11) | 20) & 0xFu; }
#define XB_SPIN(cond, bar) do { unsigned _sp = 0; while (cond) { __builtin_amdgcn_s_sleep(1); \
    if ((++_sp & 255u) == 0u) { if (xb_ld(&(bar)[XB_TMO])) break; if (_sp > XB_SPIN_CAP) { atomicAdd(&(bar)[XB_TMO], 1u); break; } } } } while (0)

struct XcdBarrier {
    unsigned* bar; unsigned x;
    volatile LAS unsigned* st;
};

__device__ __forceinline__ XcdBarrier xcd_barrier_post(unsigned* bar, volatile LAS unsigned* st) {
    XcdBarrier b; b.bar = bar; b.x = xb_xcc_id(); b.st = st;
    if (threadIdx.x == 0) (void)xb_add(&bar[XB_XCNT(b.x)], 1u);
    return b;
}
__device__ __forceinline__ void xcd_barrier_complete(unsigned* bar, unsigned x, unsigned& nloc, unsigned& nx) {
    const unsigned G = gridDim.x * gridDim.y * gridDim.z;
    unsigned sum, cnt, mine, sp = 0u;
    for (;;) {
        sum = 0u; cnt = 0u; mine = 0u;
#pragma unroll
        for (unsigned j = 0; j < 16; ++j) { const unsigned c = xb_ld(&bar[XB_XCNT(j)]); sum += c; cnt += (c > 0u) ? 1u : 0u; mine = (j == x) ? c : mine; }
        if (sum == G) break;
        __builtin_amdgcn_s_sleep(1);
        if ((++sp & 255u) == 0u) { if (xb_ld(&bar[XB_TMO])) break; if (sp > XB_SPIN_CAP) { atomicAdd(&bar[XB_TMO], 1u); break; } }
    }
    nloc = mine > 0u ? mine : 1u; nx = cnt > 0u ? cnt : 1u;
}

__device__ __forceinline__ void xcd_barrier(const XcdBarrier& b, const bool leader_thread) {
    asm volatile("s_waitcnt vmcnt(0)" ::: "memory");
    __syncthreads();
    if (leader_thread) {
        unsigned* bar = b.bar;
        __builtin_amdgcn_s_waitcnt(0);
        unsigned nloc = b.st[0], nx = b.st[1];
        if (nloc == 0u) { xcd_barrier_complete(bar, b.x, nloc, nx); b.st[0] = nloc; b.st[1] = nx; }
        const unsigned old = xb_add(&bar[XB_XSUB(b.x)], 1u);
        const unsigned gen = old / nloc;
        if (old + 1u == (gen + 1u) * nloc) {
            __builtin_amdgcn_fence(__ATOMIC_RELEASE, "agent");
            asm volatile("s_waitcnt vmcnt(0)" ::: "memory");
            const unsigned og = xb_add(&bar[XB_TOP], 1u);
            const unsigned tg = og / nx;
            if (og + 1u == (tg + 1u) * nx) xb_add(&bar[XB_TOPGEN], 1u);
            else XB_SPIN(xb_ld(&bar[XB_TOPGEN]) == tg, bar);
            __builtin_amdgcn_fence(__ATOMIC_ACQUIRE, "agent");
            xb_add(&bar[XB_XGEN(b.x)], 1u);
            asm volatile("s_waitcnt vmcnt(0)" ::: "memory");
        } else {
            XB_SPIN(xb_ld(&bar[XB_XGEN(b.x)]) == gen, bar);
            __builtin_amdgcn_fence(__ATOMIC_ACQUIRE, "agent");
            asm volatile("s_waitcnt vmcnt(0)" ::: "memory");
        }
    }
    __syncthreads();
}

constexpr int COMB_X = 2;
constexpr int CW_BAR = 4096;
constexpr size_t CTL_ZERO_BYTES = 64 * 1024;
constexpr int MISC_OFF = LDS_BYTES - 256;

#define LAUNDER() do { asm volatile("" : "+s"(F.wave), "+s"(F.bid), "+s"(F.G)); F.lane = fresh_lane(); F.tid = F.wave * 64 + F.lane; asm volatile("" : "+s"(ws)); } while (0)
#define GRID_BAR() do { XcdBarrier bb_ = bar; asm volatile("" : "+s"(bb_.bar), "+s"(bb_.x)); xcd_barrier(bb_, (F.wave * 64 + fresh_lane()) == 0); LAUNDER(); } while (0)

__global__ void __launch_bounds__(NTHR, 2) hybrid_fwd(Args args) {
    extern __shared__ __attribute__((aligned(16))) unsigned char lds_raw[];
    Frame F; F.lds = (LAS unsigned char*)lds_raw; F.tid = threadIdx.x; F.lane = F.tid & 63; F.wave = __builtin_amdgcn_readfirstlane(F.tid >> 6); F.G = gridDim.x; F.bid = blockIdx.x;
    unsigned char* ws = args.ws;
    volatile LAS unsigned* MISC = (volatile LAS unsigned*)(F.lds + MISC_OFF);
    if (F.tid < 64) MISC[F.tid] = 0u;
    __syncthreads();
    XcdBarrier bar = xcd_barrier_post((unsigned*)(ws + WS_CTL) + CW_BAR, MISC + 8);

    phase_prologue(F, args);
    __syncthreads(); LAUNDER();
#pragma unroll 1
    for (int layer = 0; layer < 2; ++layer) {
        LAUNDER();
        const float* ropec = (const float*)(ws + WS_ROPEC); const float* ropes = (const float*)(ws + WS_ROPES);
        const bf16_t* WIN = (const bf16_t*)(ws + WS_WIN + layer * WIN_BYTES);
        const bf16_t* Hh = (const bf16_t*)(ws + WS_H);
        if (layer == 0) phase_prep(F, args, 0, args.in[0], nullptr, nullptr, args.in[1]); else phase_prep(F, args, 1, args.in[0], args.out, args.in[11], args.in[1] + 1024);
        GRID_BAR();
        run_proj(F, ws, WIN, Hh, ropec, ropes, 0, 20);
        GRID_BAR();
        phase_attn(F, args, (unsigned*)(ws + WS_CTL) + 8192 + 64 * layer);
        GRID_BAR();
        {
            const int half = F.G >> 1; const bool five = F.bid < half;
            const int nch = five ? COMB_X : 8 - COMB_X, ch0 = five ? F.bid * COMB_X : half * COMB_X + (F.bid - half) * (8 - COMB_X);
            if (F.G == 256) phase_comb_a(F, args, ch0, nch); else phase_comb_a(F, args, (T / 32) * F.bid / F.G, (T / 32) * (F.bid + 1) / F.G - (T / 32) * F.bid / F.G); }
        LAUNDER();
        run_proj(F, ws, WIN, Hh, ropec, ropes, 20, 9);
        GRID_BAR();
        phase_gla_pre(F, args, layer);
        GRID_BAR();
        phase_gla_scan(F, args);
        GRID_BAR();
        run_proj(F, ws, WIN, Hh, ropec, ropes, 29, 12);
        GRID_BAR();
        phase_comb_b(F, args, layer);
        GRID_BAR();
        { pg8::Gemm gm{(const bf16_t*)(ws + X_OF), (const bf16_t*)(ws + WS_WA + layer * 3 * MiB), T, 1024, 1536}; pg8::StaticOrder S; S.init(T, 1024, F.G, F.bid);
          EpiMerge E{(const bf16_t*)(ws + X_GA), (const bf16_t*)(ws + X_GB), (bf16_t*)(ws + WS_H)};
          pg8::gemm_phase<EpiMerge, pg8::StaticOrder, true, true>(F.lds, gm, S, E, F.wave); }
        GRID_BAR();
        { pg8::Gemm gm{(const bf16_t*)(ws + WS_H), (const bf16_t*)(ws + WS_WO + layer * 2 * MiB), T, 1024, 1024}; pg8::StaticOrder S; S.init(T, 1024, F.G, F.bid);
          EpiOut E{(bf16_t*)(ws + X_OUT), (float*)(ws + WS_ROWSS)};
          pg8::gemm_phase<EpiOut, pg8::StaticOrder, true, true>(F.lds, gm, S, E, F.wave); }
        GRID_BAR();
    }
    phase_prep(F, args, 2, args.out, args.out, args.in[11] + 1024, nullptr);
}

extern "C" void kernel_launch(void* const* d_in, const int* in_sizes, int n_in, void* d_out, int out_size, void* d_ws, size_t ws_size, hipStream_t stream) {
    static int grid = 0;
    if (grid == 0) {
        if (n_in != 12 || out_size != T * DM || ws_size < WS_END) { fprintf(stderr, "kernel_launch: unexpected shapes (n_in %d out %d ws %zu)\n", n_in, out_size, ws_size); grid = -1; return; }
        int dev = 0, cus = 0;
        if (hipGetDevice(&dev) != hipSuccess || hipDeviceGetAttribute(&cus, hipDeviceAttributeMultiprocessorCount, dev) != hipSuccess) { grid = -1; return; }
        if (hipFuncSetAttribute((const void*)hybrid_fwd, hipFuncAttributeMaxDynamicSharedMemorySize, LDS_BYTES) != hipSuccess) { grid = -1; return; }
        grid = cus;
    }
    if (grid < 0) return;
    if (hipMemsetAsync((char*)d_ws + WS_CTL, 0, CTL_ZERO_BYTES, stream) != hipSuccess) return;
    Args a{};
    for (int i = 0; i < 12; ++i) a.in[i] = (const float*)d_in[i];
    a.out = (float*)d_out; a.ws = (unsigned char*)d_ws; a.ph_lo = 0; a.ph_hi = 0;
    hipLaunchKernelGGL(hybrid_fwd, dim3(grid), dim3(NTHR), LDS_BYTES, stream, a);
}
```

```cpp
#include <hip/hip_runtime.h>
#include <cstdio>
#include <cstdint>
__device__ __forceinline__ int fresh_lane() { int l; asm volatile("v_mbcnt_lo_u32_b32 %0, -1, 0\n\tv_mbcnt_hi_u32_b32 %0, -1, %0" : "=v"(l)); return l; }
namespace pg8 {
#define PG8_LAS __attribute__((address_space(3)))
typedef unsigned short bf16_t;
typedef short bf16x8 __attribute__((ext_vector_type(8)));
typedef float f32x4 __attribute__((ext_vector_type(4)));
typedef unsigned u32x4 __attribute__((ext_vector_type(4)));
constexpr int BM = 256, BK = 64, HALF = 128, HTB = HALF * BK * 2  , STAGE_BYTES = 8 * HTB, NXCD = 8, WGM = 8;

__host__ __device__ __forceinline__ int lds_byte(int r, int c) { const int st = (r >> 4) * 2 + (c >> 5), rr = r & 15, cc = c & 31, ob = rr * 64 + cc * 2; return st * 1024 + (ob ^ (((ob >> 9) & 1) << 5)); }
__host__ __device__ __forceinline__ void stage_rc(int b, int& R, int& C) { const int st = b / 1024, sb = b % 1024, swz = sb ^ (((sb >> 9) & 1) << 5); R = (st >> 1) * 16 + swz / 64; C = (st & 1) * 32 + (swz % 64) / 2; }
__host__ __device__ __forceinline__ int perm32(int rho) { const int n = rho >> 4, i = rho & 15; return 8 * (i >> 2) + 4 * n + (i & 3); }

struct Unit { int pm, pn; };
struct Gemm { const bf16_t* A; const bf16_t* Bt; int M, N, K; };

struct StaticOrder {
    int nM, nN, nwg, G, c;
    __host__ __device__ void init(int M, int N, int G_, int c_) { nM = M / BM; nN = N / BM; nwg = nM * nN; G = G_; c = c_; }
    __host__ __device__ bool next(int i, Unit& u) const {
        const long L = (long)i * G + c; if (L >= nwg) return false;
        int wgid = (int)L; { const int q = nwg / NXCD, r = nwg % NXCD, xcd = wgid % NXCD, off = wgid / NXCD; wgid = (xcd < r ? xcd * (q + 1) : r * (q + 1) + (xcd - r) * q) + off; }
        const int nig = WGM * nN, gid = wgid / nig, fm = gid * WGM, gsz = (nM - fm) < WGM ? (nM - fm) : WGM;
        u.pm = fm + ((wgid % nig) % gsz); u.pn = (wgid % nig) / gsz; return true;
    }
    __device__ __forceinline__ void a_ready(const Unit&) const {}
    __device__ __forceinline__ void done(const Unit&) const {}
};


__device__ __forceinline__ unsigned cvt_pk_bf16(float lo, float hi) { unsigned r; asm volatile("v_cvt_pk_bf16_f32 %0, %1, %2" : "=v"(r) : "v"(lo), "v"(hi)); return r; }
template <class Epi, class Sched, bool ALIGN_EPI = false, bool SP2 = false>
__device__ __forceinline__ void gemm_phase(PG8_LAS unsigned char* lds, const Gemm g, const Sched& S, const Epi& E, int wave_id) {
    const int lane = fresh_lane(), wid = wave_id, tid = wid * 64 + lane, wr = wid >> 2, wc = wid & 3, fr = lane & 15, fq = lane >> 4;
    const int K = g.K, nt = K / BK;
    unsigned voffA[2], voffB[2];
#pragma unroll
    for (int i = 0; i < 2; ++i) { int R, C; stage_rc(tid * 16 + i * 8192, R, C); const int Rb = Epi::PERM ? ((R & ~31) + perm32(R & 31)) : R;
        voffA[i] = (unsigned)(R * K + C) * 2u; voffB[i] = (unsigned)(Rb * K + C) * 2u; }
    const size_t kstep = (size_t)(BK * 2);
    const size_t hstep = (size_t)HALF * K * 2;
    const size_t tstep = 2 * hstep;
    const unsigned ldsw = (unsigned)wid * 1024u;
    const int aoff = lds_byte(wr * 64 + fr, fq * 8), boff = lds_byte(wc * 32 + fr, fq * 8);
#define PG8_SA(b, h) (((b) * 2 + (h)) * HTB)
#define PG8_SB(b, h) ((4 + (b) * 2 + (h)) * HTB)
#define PG8_STAGE(bufoff, gbase, voff) do { _Pragma("unroll") for (int _i = 0; _i < 2; ++_i) \
        __builtin_amdgcn_global_load_lds((const unsigned*)((const char*)(gbase) + (voff)[_i]), (PG8_LAS unsigned*)(lds + (bufoff) + ldsw + _i * 8192), 16, 0, 0); } while (0)
#define PG8_LDA(dst, b, h) do { _Pragma("unroll") for (int m = 0; m < 4; ++m) _Pragma("unroll") for (int k = 0; k < 2; ++k) dst[m][k] = *(const PG8_LAS bf16x8*)(lds + PG8_SA(b, h) + aoff + m * 2048 + k * 1024); } while (0)
#define PG8_LDB(dst, b, h) do { _Pragma("unroll") for (int n = 0; n < 2; ++n) _Pragma("unroll") for (int k = 0; k < 2; ++k) dst[n][k] = *(const PG8_LAS bf16x8*)(lds + PG8_SB(b, h) + boff + n * 2048 + k * 1024); } while (0)
#define PG8_MMA(ai, bj, At, Bt) do { __builtin_amdgcn_s_setprio(1); _Pragma("unroll") for (int m = 0; m < 4; ++m) _Pragma("unroll") for (int n = 0; n < 2; ++n) _Pragma("unroll") for (int k = 0; k < 2; ++k) \
        acc[ai][bj][m][n] = __builtin_amdgcn_mfma_f32_16x16x32_bf16(Bt[n][k], At[m][k], acc[ai][bj][m][n], 0, 0, 0); __builtin_amdgcn_s_setprio(0); } while (0)
#define PG8_WAIT_V(n) asm volatile("s_waitcnt vmcnt(" #n ")" ::: "memory")
#define PG8_WAIT_L(n) asm volatile("s_waitcnt lgkmcnt(" #n ")" ::: "memory")
#define PG8_BAR __builtin_amdgcn_s_barrier()
#define PG8_SCHED __builtin_amdgcn_sched_barrier(0)
    Unit cur, nxt; int ui = 0;
    if (!S.next(0, cur)) return;
    f32x4 acc[2][2][4][2];
#pragma unroll
    for (int a = 0; a < 2; ++a)
#pragma unroll
        for (int b = 0; b < 2; ++b)
#pragma unroll
            for (int m = 0; m < 4; ++m)
#pragma unroll
                for (int n = 0; n < 2; ++n) acc[a][b][m][n] = (f32x4){0.f, 0.f, 0.f, 0.f};
    bf16x8 At[4][2], B0[2][2], B1[2][2];
    const char* cA = (const char*)g.A + (size_t)cur.pm * tstep; const char* cB = (const char*)g.Bt + (size_t)cur.pn * tstep;
    S.a_ready(cur);
    if constexpr (SP2) {
        PG8_STAGE(PG8_SB(0, 0), cB, voffB); PG8_STAGE(PG8_SB(0, 1), cB + hstep, voffB); PG8_STAGE(PG8_SA(0, 0), cA, voffA); PG8_STAGE(PG8_SA(0, 1), cA + hstep, voffA);
        if (wr == 1) PG8_BAR;
        PG8_WAIT_V(2); PG8_BAR;
        PG8_STAGE(PG8_SB(1, 0), cB + kstep, voffB); PG8_STAGE(PG8_SA(1, 0), cA + kstep, voffA); PG8_STAGE(PG8_SB(1, 1), cB + hstep + kstep, voffB);
        PG8_WAIT_V(6); PG8_BAR;
    } else {
        PG8_STAGE(PG8_SB(0, 0), cB, voffB); PG8_STAGE(PG8_SA(0, 0), cA, voffA); PG8_STAGE(PG8_SB(0, 1), cB + hstep, voffB); PG8_STAGE(PG8_SA(0, 1), cA + hstep, voffA);
        if (wr == 1) PG8_BAR;
        PG8_WAIT_V(4); PG8_BAR;
        PG8_STAGE(PG8_SB(1, 0), cB + kstep, voffB); PG8_STAGE(PG8_SA(1, 0), cA + kstep, voffA); PG8_STAGE(PG8_SB(1, 1), cB + hstep + kstep, voffB);
        PG8_WAIT_V(6); PG8_BAR;
    }
    for (;;) {
        const bool has_next = S.next(ui + 1, nxt);
        const char* nA = has_next ? (const char*)g.A + (size_t)nxt.pm * tstep : cA; const char* nB = has_next ? (const char*)g.Bt + (size_t)nxt.pn * tstep : cB;
        for (int t = 0; t < nt; t += 2) {
            if constexpr (Epi::MIDT > 0) { if (t == Epi::MIDT) E.mid(acc, cur, wr, wc, fr, fq); }
            const bool last = (t == nt - 2);
            const char* a1 = cA + (size_t)(t + 1) * kstep;
            const char* a2 = last ? nA : cA + (size_t)(t + 2) * kstep; const char* b2 = last ? nB : cB + (size_t)(t + 2) * kstep;
            const char* a3 = a2 + kstep; const char* b3 = b2 + kstep;
            if (last && has_next) S.a_ready(nxt);
            if constexpr (SP2) {
            PG8_LDB(B0, 0, 0); PG8_LDB(B1, 0, 1); PG8_SCHED; PG8_LDA(At, 0, 0); PG8_STAGE(PG8_SA(1, 1), a1 + hstep, voffA);
            PG8_WAIT_V(8); PG8_WAIT_L(0); PG8_BAR; PG8_MMA(0, 0, At, B0); PG8_MMA(0, 1, At, B1); PG8_BAR; PG8_SCHED;
            PG8_LDA(At, 0, 1); PG8_STAGE(PG8_SB(0, 0), b2, voffB); PG8_STAGE(PG8_SB(0, 1), b2 + hstep, voffB); PG8_STAGE(PG8_SA(0, 0), a2, voffA);
            PG8_WAIT_V(8); PG8_WAIT_L(0); PG8_BAR; PG8_MMA(1, 0, At, B0); PG8_MMA(1, 1, At, B1); PG8_BAR; PG8_SCHED;
            PG8_LDB(B0, 1, 0); PG8_LDB(B1, 1, 1); PG8_SCHED; PG8_LDA(At, 1, 0); PG8_STAGE(PG8_SA(0, 1), a2 + hstep, voffA);
            PG8_WAIT_V(8); PG8_WAIT_L(0); PG8_BAR; PG8_MMA(0, 0, At, B0); PG8_MMA(0, 1, At, B1); PG8_BAR; PG8_SCHED;
            PG8_LDA(At, 1, 1); PG8_STAGE(PG8_SB(1, 0), b3, voffB); PG8_STAGE(PG8_SB(1, 1), b3 + hstep, voffB); PG8_STAGE(PG8_SA(1, 0), a3, voffA);
            PG8_WAIT_V(8); PG8_WAIT_L(0); PG8_BAR; PG8_MMA(1, 0, At, B0); PG8_MMA(1, 1, At, B1); PG8_BAR; PG8_SCHED;
            } else {
            PG8_LDB(B0, 0, 0); PG8_SCHED; PG8_LDA(At, 0, 0); PG8_STAGE(PG8_SA(1, 1), a1 + hstep, voffA);
            PG8_WAIT_L(8); PG8_BAR; PG8_WAIT_L(0); PG8_MMA(0, 0, At, B0); PG8_BAR; PG8_SCHED;
            PG8_LDB(B1, 0, 1); PG8_STAGE(PG8_SB(0, 0), b2, voffB);
            PG8_BAR; PG8_WAIT_L(0); PG8_MMA(0, 1, At, B1); PG8_BAR;
            PG8_LDA(At, 0, 1); PG8_STAGE(PG8_SA(0, 0), a2, voffA);
            PG8_BAR; PG8_WAIT_L(0); PG8_MMA(1, 0, At, B0); PG8_BAR; PG8_SCHED;
            PG8_STAGE(PG8_SB(0, 1), b2 + hstep, voffB);
            PG8_WAIT_V(6); PG8_BAR; PG8_MMA(1, 1, At, B1); PG8_BAR;
            PG8_LDB(B0, 1, 0); PG8_SCHED; PG8_LDA(At, 1, 0); PG8_STAGE(PG8_SA(0, 1), a2 + hstep, voffA);
            PG8_WAIT_L(8); PG8_BAR; PG8_WAIT_L(0); PG8_MMA(0, 0, At, B0); PG8_BAR; PG8_SCHED;
            PG8_LDB(B1, 1, 1); PG8_STAGE(PG8_SB(1, 0), b3, voffB);
            PG8_BAR; PG8_WAIT_L(0); PG8_MMA(0, 1, At, B1); PG8_BAR;
            PG8_LDA(At, 1, 1); PG8_STAGE(PG8_SA(1, 0), a3, voffA);
            PG8_BAR; PG8_WAIT_L(0); PG8_MMA(1, 0, At, B0); PG8_BAR; PG8_SCHED;
            PG8_STAGE(PG8_SB(1, 1), b3 + hstep, voffB);
            PG8_WAIT_V(6); PG8_BAR; PG8_MMA(1, 1, At, B1); PG8_BAR;
            }
        }
        if constexpr (ALIGN_EPI) { if (wr == 0) PG8_BAR; }
        if constexpr (!Epi::AFTER_DRAIN) { E(acc, cur, wr, wc, fr, fq); S.done(cur); }
        if (!has_next) break;
#pragma unroll
        for (int a = 0; a < 2; ++a)
#pragma unroll
            for (int b = 0; b < 2; ++b)
#pragma unroll
                for (int m = 0; m < 4; ++m)
#pragma unroll
                    for (int n = 0; n < 2; ++n) acc[a][b][m][n] = (f32x4){0.f, 0.f, 0.f, 0.f};
        cur = nxt; cA = nA; cB = nB; ++ui;
        if constexpr (ALIGN_EPI) { if (wr == 1) PG8_BAR; }
    }
    PG8_WAIT_V(0);
    if constexpr (!ALIGN_EPI) { if (wr == 0) PG8_BAR; }
    PG8_BAR;
    if constexpr (Epi::AFTER_DRAIN) { E.fused(acc, cur, wr, wc, fr, fq, lds, wid, lane); S.done(cur); }
#undef PG8_SA
#undef PG8_SB
#undef PG8_STAGE
#undef PG8_LDA
#undef PG8_LDB
#undef PG8_MMA
#undef PG8_WAIT_V
#undef PG8_WAIT_L
#undef PG8_BAR
#undef PG8_SCHED
}
}

#define LAS __attribute__((address_space(3)))
typedef unsigned short bf16_t;
typedef short bf16x8 __attribute__((ext_vector_type(8)));
typedef short s16x4 __attribute__((ext_vector_type(4)));
typedef float f32x4 __attribute__((ext_vector_type(4)));
typedef float f32x2 __attribute__((ext_vector_type(2)));
typedef unsigned u32x4 __attribute__((ext_vector_type(4)));
typedef unsigned u32x2 __attribute__((ext_vector_type(2)));

constexpr int NWAVES = 8, NTHR = 512;
constexpr int T = 32768, DM = 1024, SEQ = 4096, NB = 8;
constexpr int IN_DIM = 10272;
constexpr int NWIN_TILES = 41, NWIN = NWIN_TILES * 256;
constexpr float NORM_EPS = 1e-6f;
constexpr float QSCALE = 0.08838834764831845f;

constexpr size_t MiB = 1u << 20;
constexpr size_t WS_CTL = 0;
constexpr size_t WS_WIN = 1 * MiB;
constexpr size_t WIN_BYTES = (size_t)NWIN * 1024 * 2;
constexpr size_t WS_WA = 42 * MiB;
constexpr size_t WS_WB = 44 * MiB;
constexpr size_t WS_WO = 48 * MiB;
constexpr size_t WS_ROPEC = 52 * MiB, WS_ROPES = WS_ROPEC + 256 * 1024;
constexpr size_t WS_LSE = 53 * MiB;
constexpr size_t WS_LR = 55 * MiB;
constexpr size_t WS_ROWSS = 59 * MiB;
constexpr size_t WS_H = 62 * MiB;
constexpr size_t WS_X = 126 * MiB;
constexpr size_t X_QO = WS_X + 0 * MiB, X_KA = WS_X + 96 * MiB, X_VA = WS_X + 192 * MiB, X_ZA = WS_X + 288 * MiB;
constexpr size_t X_GQ = WS_X + 96 * MiB, X_GK = WS_X + 128 * MiB, X_GVL = WS_X + 160 * MiB, X_GVH = WS_X + 352 * MiB, X_BF = WS_X + 0 * MiB, X_BB = WS_X + 32 * MiB;
constexpr size_t X_OF = WS_X + 192 * MiB, X_OB = WS_X + 288 * MiB;
constexpr int OF_LD = 1536, OF_C0 = 512;
constexpr size_t X_ZB = WS_X + 0 * MiB, X_GA = WS_X + 64 * MiB, X_GB = WS_X + 128 * MiB, X_OUT = WS_X + 0 * MiB;
constexpr size_t WS_END = WS_X + 384 * MiB;

constexpr int LDS_BYTES = 147456;

__device__ __forceinline__ float bf2f(unsigned v) { return __uint_as_float(v << 16); }
__device__ __forceinline__ float bflo(unsigned w) { return __uint_as_float(w << 16); }
__device__ __forceinline__ float bfhi(unsigned w) { return __uint_as_float(w & 0xffff0000u); }
typedef __bf16 bf16x2_t __attribute__((ext_vector_type(2)));
__device__ __forceinline__ unsigned pk2(float lo, float hi) { f32x2 v = {lo, hi}; bf16x2_t b = __builtin_convertvector(v, bf16x2_t); return __builtin_bit_cast(unsigned, b); }
template <int M> __device__ __forceinline__ float xsum(float v) {
    if constexpr (M < 32) return v + __builtin_bit_cast(float, __builtin_amdgcn_ds_swizzle(__builtin_bit_cast(int, v), (M << 10) | 0x1F));
    else { const unsigned u = __builtin_bit_cast(unsigned, v); auto r = __builtin_amdgcn_permlane32_swap(u, u, false, false); return __builtin_bit_cast(float, r[0]) + __builtin_bit_cast(float, r[1]); }
}
template <int M> __device__ __forceinline__ float xmax(float v) {
    if constexpr (M < 32) return fmaxf(v, __builtin_bit_cast(float, __builtin_amdgcn_ds_swizzle(__builtin_bit_cast(int, v), (M << 10) | 0x1F)));
    else { const unsigned u = __builtin_bit_cast(unsigned, v); auto r = __builtin_amdgcn_permlane32_swap(u, u, false, false); return fmaxf(__builtin_bit_cast(float, r[0]), __builtin_bit_cast(float, r[1])); }
}
__device__ __forceinline__ float wave_sum(float v) { v += __shfl_xor(v, 1); v += __shfl_xor(v, 2); v += __shfl_xor(v, 4); v += __shfl_xor(v, 8); v += __shfl_xor(v, 16); v += __shfl_xor(v, 32); return v; }
__device__ __forceinline__ float sigmoidf_(float x) { return __builtin_amdgcn_rcpf(1.0f + __builtin_amdgcn_exp2f(-1.4426950408889634f * x)); }
__device__ __forceinline__ float siluf_(float x) { return x * sigmoidf_(x); }

struct EpiProj {
    static constexpr bool PERM = true, AFTER_DRAIN = false; static constexpr int MIDT = 0;
    int tau0; unsigned char* ws; const float* ropec; const float* ropes;
    __device__ __forceinline__ void operator()(const f32x4 (&acc)[2][2][4][2], const pg8::Unit& u, int wr, int wc, int fr, int fq) const {
        const int tau = tau0 + u.pn;
        int mode = 0, ldc = 512, colt = 0, dsh = 0; bf16_t* base = nullptr;
        if (tau < 18) { const int g = tau / 6, t = (tau % 6) >> 1, half = tau & 1; colt = half * 256; dsh = 2 * g;
                        base = (bf16_t*)(ws + (t == 0 ? X_QO : (t == 1 ? X_KA : X_VA)) + (size_t)g * 32 * MiB); mode = t < 2 ? 3 : 0; }
        else if (tau < 20) { base = (bf16_t*)(ws + X_ZA); colt = (tau - 18) * 256; }
        else if (tau < 22) { base = (bf16_t*)(ws + X_GQ); colt = (tau - 20) * 256; }
        else if (tau < 24) { base = (bf16_t*)(ws + X_GK); colt = (tau - 22) * 256; }
        else if (tau < 28) { base = (bf16_t*)(ws + (tau < 26 ? X_GVL : X_GVH)); colt = ((tau - 24) & 1) * 256; }
        else if (tau == 28) { mode = 4; }
        else if (tau < 33) { base = (bf16_t*)(ws + X_ZB); ldc = 1024; colt = (tau - 29) * 256; }
        else { mode = 5; }
        const int row0 = u.pm * 256 + wr * 64 + fr;
        if (mode == 5) {
            bf16_t* Rb = (bf16_t*)(ws + X_GA); bf16_t* Gb = (bf16_t*)(ws + X_GB); const int colg = (tau - 33) * 128 + wc * 32 + 8 * fq;
#pragma unroll
            for (int ai = 0; ai < 2; ++ai)
#pragma unroll
                for (int m = 0; m < 4; ++m) { const size_t off = (size_t)(row0 + ai * 128 + m * 16) * 1024 + colg;
                    float r[8], g[8];
#pragma unroll
                    for (int j = 0; j < 8; ++j) { const float av = acc[ai][0][m][j >> 2][j & 3], bv = acc[ai][1][m][j >> 2][j & 3];
                        const float ea = __builtin_amdgcn_exp2f(-1.4426950408889634f * av), eb = fminf(__builtin_amdgcn_exp2f(-1.4426950408889634f * bv), 1e30f);
                        r[j] = (1.0f + eb) * __builtin_amdgcn_rcpf(1.0f + ea); g[j] = __builtin_amdgcn_rcpf(1.0f + eb); }
                    u32x4 wr_, wg_; wr_.x = pk2(r[0], r[1]); wr_.y = pk2(r[2], r[3]); wr_.z = pk2(r[4], r[5]); wr_.w = pk2(r[6], r[7]);
                    wg_.x = pk2(g[0], g[1]); wg_.y = pk2(g[2], g[3]); wg_.z = pk2(g[4], g[5]); wg_.w = pk2(g[6], g[7]);
                    __builtin_nontemporal_store(wr_, (u32x4*)(Rb + off)); __builtin_nontemporal_store(wg_, (u32x4*)(Gb + off)); }
            return;
        }
        if (mode == 4) {
            if (wc == 0) { float* LR = (float*)(ws + WS_LR);
#pragma unroll
                for (int ai = 0; ai < 2; ++ai)
#pragma unroll
                    for (int m = 0; m < 4; ++m) { float* rp = LR + (size_t)(row0 + ai * 128 + m * 16) * 32 + 8 * fq;
                        *(f32x4*)(rp) = acc[ai][0][m][0]; *(f32x4*)(rp + 4) = acc[ai][0][m][1]; } }
            return;
        }
        const int col0 = colt + wc * 32 + 8 * fq;
#pragma unroll
        for (int ai = 0; ai < 2; ++ai) {
            f32x4 csv[4], snv[4];
            if (mode == 3 && wc == 0) {
#pragma unroll
                for (int m = 0; m < 4; ++m) { const float pos = (float)((row0 + ai * 128 + m * 16) & (SEQ - 1));
#pragma unroll
                    for (int j = 0; j < 4; ++j) { const float invr = __builtin_amdgcn_exp2f(-(float)(4 * fq + j) * (18.931568569324174f / 16.0f)) * 0.15915494309189535f;
                        const float xr = __builtin_amdgcn_fractf(pos * invr); csv[m][j] = __builtin_amdgcn_cosf(xr); snv[m][j] = __builtin_amdgcn_sinf(xr); } } }
#pragma unroll
            for (int m = 0; m < 4; ++m) { const int row = row0 + ai * 128 + m * 16;
                const int srow = (row & ~(SEQ - 1)) | (((row & ((1 << dsh) - 1)) << (12 - dsh)) | ((row & (SEQ - 1)) >> dsh));
                bf16_t* rowp = base + (size_t)srow * ldc + col0;
                const f32x4 cs = csv[m], sn = snv[m];
#pragma unroll
                for (int bj = 0; bj < 2; ++bj) { f32x4 v0 = acc[ai][bj][m][0], v1 = acc[ai][bj][m][1];
                    if (mode == 1) {
#pragma unroll
                        for (int j = 0; j < 4; ++j) { v0[j] = v0[j] * sigmoidf_(v0[j]); v1[j] = v1[j] * sigmoidf_(v1[j]); } }
                    else if (mode == 2) {
#pragma unroll
                        for (int j = 0; j < 4; ++j) { v0[j] = sigmoidf_(v0[j]); v1[j] = sigmoidf_(v1[j]); } }
                    else if (mode == 3 && wc == 0) {
                        f32x4 a = v0, b = v1;
                        v0[0] = a[0] * cs[0] - a[1] * sn[0]; v0[1] = a[1] * cs[0] + a[0] * sn[0]; v0[2] = a[2] * cs[1] - a[3] * sn[1]; v0[3] = a[3] * cs[1] + a[2] * sn[1];
                        v1[0] = b[0] * cs[2] - b[1] * sn[2]; v1[1] = b[1] * cs[2] + b[0] * sn[2]; v1[2] = b[2] * cs[3] - b[3] * sn[3]; v1[3] = b[3] * cs[3] + b[2] * sn[3]; }
                    u32x4 w; w.x = pk2(v0[0], v0[1]); w.y = pk2(v0[2], v0[3]); w.z = pk2(v1[0], v1[1]); w.w = pk2(v1[2], v1[3]);
                    __builtin_nontemporal_store(w, (u32x4*)(rowp + bj * 128)); } } }
    }
};
struct EpiMerge {
    static constexpr bool PERM = true, AFTER_DRAIN = false; static constexpr int MIDT = 8;
    const bf16_t* GA; const bf16_t* GB; bf16_t* O;
    __device__ __forceinline__ void mid(f32x4 (&acc)[2][2][4][2], const pg8::Unit& u, int wr, int wc, int fr, int fq) const {
        int row0 = u.pm * 256 + wr * 64 + fr; const int col0 = u.pn * 256 + wc * 32 + 8 * fq;
#pragma unroll
        for (int ai = 0; ai < 2; ++ai) {
            asm volatile("" : "+v"(row0));
            u32x4 g[4][2];
#pragma unroll
            for (int m = 0; m < 4; ++m) { const size_t off = (size_t)(row0 + ai * 128 + m * 16) * 1024 + col0;
#pragma unroll
                for (int bj = 0; bj < 2; ++bj) g[m][bj] = *(const u32x4*)(GA + off + bj * 128); }
#pragma unroll
            for (int m = 0; m < 4; ++m)
#pragma unroll
                for (int bj = 0; bj < 2; ++bj) { const u32x4 a = g[m][bj]; f32x4& v0 = acc[ai][bj][m][0]; f32x4& v1 = acc[ai][bj][m][1];
                    v0[0] *= bflo(a.x); v0[1] *= bfhi(a.x); v0[2] *= bflo(a.y); v0[3] *= bfhi(a.y); v1[0] *= bflo(a.z); v1[1] *= bfhi(a.z); v1[2] *= bflo(a.w); v1[3] *= bfhi(a.w); }
            asm volatile("" ::: "memory"); }
    }
    __device__ __forceinline__ void operator()(const f32x4 (&acc)[2][2][4][2], const pg8::Unit& u, int wr, int wc, int fr, int fq) const {
        int row0 = u.pm * 256 + wr * 64 + fr; const int col0 = u.pn * 256 + wc * 32 + 8 * fq;
#pragma unroll
        for (int ai = 0; ai < 2; ++ai) {
            asm volatile("" : "+v"(row0));
            u32x4 g[4][2];
#pragma unroll
            for (int m = 0; m < 4; ++m) { const size_t off = (size_t)(row0 + ai * 128 + m * 16) * 1024 + col0;
#pragma unroll
                for (int bj = 0; bj < 2; ++bj) g[m][bj] = *(const u32x4*)(GB + off + bj * 128); }
#pragma unroll
            for (int m = 0; m < 4; ++m) { const size_t off = (size_t)(row0 + ai * 128 + m * 16) * 1024 + col0;
#pragma unroll
                for (int bj = 0; bj < 2; ++bj) { const u32x4 gg = g[m][bj]; const f32x4 v0 = acc[ai][bj][m][0], v1 = acc[ai][bj][m][1];
                    u32x4 w; w.x = pk2(v0[0] * bflo(gg.x), v0[1] * bfhi(gg.x)); w.y = pk2(v0[2] * bflo(gg.y), v0[3] * bfhi(gg.y)); w.z = pk2(v1[0] * bflo(gg.z), v1[1] * bfhi(gg.z)); w.w = pk2(v1[2] * bflo(gg.w), v1[3] * bfhi(gg.w));
                    *(u32x4*)(O + off + bj * 128) = w; } }
            asm volatile("" ::: "memory"); }
    }
};
struct EpiOut {
    static constexpr bool PERM = true, AFTER_DRAIN = false; static constexpr int MIDT = 0;
    bf16_t* O; float* rowss;
    __device__ __forceinline__ void operator()(const f32x4 (&acc)[2][2][4][2], const pg8::Unit& u, int wr, int wc, int fr, int fq) const {
        const int row0 = u.pm * 256 + wr * 64 + fr, col0 = u.pn * 256 + wc * 32 + 8 * fq;
#pragma unroll
        for (int ai = 0; ai < 2; ++ai)
#pragma unroll
            for (int m = 0; m < 4; ++m) { const int row = row0 + ai * 128 + m * 16; const size_t off = (size_t)row * 1024 + col0; float s = 0.f;
#pragma unroll
                for (int bj = 0; bj < 2; ++bj) { const f32x4 v0 = acc[ai][bj][m][0], v1 = acc[ai][bj][m][1];
                    s += (v0[0] * v0[0] + v0[1] * v0[1]) + (v0[2] * v0[2] + v0[3] * v0[3]) + (v1[0] * v1[0] + v1[1] * v1[1]) + (v1[2] * v1[2] + v1[3] * v1[3]);
                    u32x4 w; w.x = pk2(v0[0], v0[1]); w.y = pk2(v0[2], v0[3]); w.z = pk2(v1[0], v1[1]); w.w = pk2(v1[2], v1[3]);
                    *(u32x4*)(O + off + bj * 128) = w; }
                s += __shfl_xor(s, 16); s += __shfl_xor(s, 32);
                if (fq == 0) rowss[(size_t)row * 16 + u.pn * 4 + wc] = s; }
    }
};

struct Args { const float* in[12]; float* out; unsigned char* ws; int ph_lo, ph_hi; };

struct Frame { LAS unsigned char* lds; int tid, lane, wave, G, bid; };

__device__ __forceinline__ int win_src(int np, float& sc) {
    sc = 1.f; const int tau = np >> 8, c = np & 255;
    if (tau < 18) { const int g = np / 1536, rem = np % 1536, t = rem / 512, hc = rem % 512, h = hc >> 7, d = hc & 127;
        int ds = d; if (t < 2 && d < 32) ds = (d & 1) ? 16 + (d >> 1) : (d >> 1);
        if (t == 0) sc = QSCALE;
        return g * 1536 + t * 512 + h * 128 + ds; }
    if (tau < 20) return 4608 + (np - 18 * 256);
    if (tau < 22) { sc = QSCALE; return 5120 + (np - 20 * 256); }
    if (tau < 24) return 5632 + (np - 22 * 256);
    if (tau < 28) return 6144 + (np - 24 * 256);
    if (tau == 28) return c < 32 ? 10240 + c : -1;
    if (tau < 33) return 7168 + (np - 29 * 256);
    { const int i = tau - 33; return c < 128 ? 8192 + 128 * i + c : 9216 + 128 * i + (c - 128); }
}
template <bool IS_WIN> __device__ __forceinline__ void transpose_item(const float* W, int K, int Nsrc, int Ndst, bf16_t* WT, LAS float* scr, int item, int lane, int ldd = 0, int koff = 0) {
    if (ldd == 0) ldd = K;
    const int nblk = Ndst / 32, kb = item / nblk, nb = item % nblk, k0 = 64 * kb, n0 = 32 * nb;
    const int np = n0 + (lane & 31); float sc = 1.f; int src = np; if (IS_WIN) src = win_src(np, sc);
#pragma unroll 8
    for (int i = 0; i < 32; ++i) { const int kk = 2 * i + (lane >> 5); float v = 0.f; if (src >= 0) v = W[(size_t)(k0 + kk) * Nsrc + src] * sc; scr[kk * 33 + (lane & 31)] = v; }
    asm volatile("s_waitcnt lgkmcnt(0)" ::: "memory");
    const int c = lane & 7;
#pragma unroll
    for (int j = 0; j < 4; ++j) { const int n = (lane >> 3) + 8 * j; const LAS float* s = scr + (8 * c) * 33 + n;
        u32x4 o; o.x = pk2(s[0 * 33], s[1 * 33]); o.y = pk2(s[2 * 33], s[3 * 33]); o.z = pk2(s[4 * 33], s[5 * 33]); o.w = pk2(s[6 * 33], s[7 * 33]);
        *(u32x4*)(WT + (size_t)(n0 + n) * ldd + koff + k0 + 8 * c) = o; }
    asm volatile("s_waitcnt lgkmcnt(0)" ::: "memory");
}
__device__ __forceinline__ void phase_prologue(const Frame& F, const Args& a) {
    LAS float* scr = (LAS float*)(F.lds + F.wave * 16384);
    const int gw = F.bid * NWAVES + F.wave, NGW = F.G * NWAVES;
    constexpr int I_WIN = 16 * (NWIN / 32), I_WA = 8 * 32, I_WB = 16 * 32, I_WO = 16 * 32, I_L = I_WIN + I_WA + I_WB + I_WO;
    for (int it = gw; it < 2 * I_L; it += NGW) {
        const int l = it / I_L; int r = it % I_L;
        if (r < I_WIN) { transpose_item<true>(a.in[2] + (size_t)l * 1024 * IN_DIM, 1024, IN_DIM, NWIN, (bf16_t*)(a.ws + WS_WIN + l * WIN_BYTES), scr, r, F.lane); continue; } r -= I_WIN;
        if (r < I_WA) { transpose_item<false>(a.in[8] + (size_t)l * 512 * 1024, 512, 1024, 1024, (bf16_t*)(a.ws + WS_WA + l * 3 * MiB), scr, r, F.lane, 1536, 0); continue; } r -= I_WA;
        if (r < I_WB) { transpose_item<false>(a.in[9] + (size_t)l * 1024 * 1024, 1024, 1024, 1024, (bf16_t*)(a.ws + WS_WA + l * 3 * MiB), scr, r, F.lane, 1536, 512); continue; } r -= I_WB;
        transpose_item<false>(a.in[10] + (size_t)l * 1024 * 1024, 1024, 1024, 1024, (bf16_t*)(a.ws + WS_WO + l * 2 * MiB), scr, r, F.lane);
    }
    float* rc = (float*)(a.ws + WS_ROPEC); float* rs = (float*)(a.ws + WS_ROPES);
    for (int e = F.bid * NTHR + F.tid; e < SEQ * 16; e += F.G * NTHR) { const int pos = e >> 4, i = e & 15;
        const float inv = (float)pow(500000.0, -(double)(2 * i) / 32.0); const float ang = (float)pos * inv;
        rc[e] = (float)cos((double)ang); rs[e] = (float)sin((double)ang); }
}

__device__ __forceinline__ void phase_prep(const Frame& F, const Args& a, int mode, const float* xprev, float* xout, const float* wpost, const float* wpre) {
    const int gw = F.bid * NWAVES + F.wave, NGW = F.G * NWAVES;
    const bf16_t* OUT = (const bf16_t*)(a.ws + X_OUT); const float* rowss = (const float*)(a.ws + WS_ROWSS); bf16_t* H = (bf16_t*)(a.ws + WS_H);
    f32x4 wpo[4], wpr[4];
#pragma unroll
    for (int j = 0; j < 4; ++j) { wpo[j] = (mode != 0) ? *((const f32x4*)wpost + F.lane + 64 * j) : (f32x4){0.f, 0.f, 0.f, 0.f}; wpr[j] = (mode != 2) ? *((const f32x4*)wpre + F.lane + 64 * j) : (f32x4){0.f, 0.f, 0.f, 0.f}; }
    for (int row0 = gw; row0 < T; row0 += 2 * NGW) {
        f32x4 v[2][4]; u32x2 ov[2][4]; float ssv[2];
#pragma unroll
        for (int rr = 0; rr < 2; ++rr) { const int row = row0 + rr * NGW; const f32x4* xr = (const f32x4*)(xprev + (size_t)row * DM) + F.lane;
#pragma unroll
            for (int j = 0; j < 4; ++j) v[rr][j] = __builtin_nontemporal_load(xr + 64 * j);
            if (mode != 0) { ssv[rr] = rowss[(size_t)row * 16 + (F.lane & 15)]; const u32x2* orow = (const u32x2*)(OUT + (size_t)row * DM) + F.lane;
#pragma unroll
                for (int j = 0; j < 4; ++j) ov[rr][j] = __builtin_nontemporal_load(orow + 64 * j); } }
#pragma unroll
        for (int rr = 0; rr < 2; ++rr) { const int row = row0 + rr * NGW;
            if (mode != 0) {
                float ss = ssv[rr];
                ss += __shfl_xor(ss, 1); ss += __shfl_xor(ss, 2); ss += __shfl_xor(ss, 4); ss += __shfl_xor(ss, 8);
                const float rstd = __builtin_amdgcn_rsqf(ss * (1.0f / DM) + NORM_EPS);
#pragma unroll
                for (int j = 0; j < 4; ++j) { const u32x2 o = ov[rr][j]; const f32x4 w = wpo[j];
                    v[rr][j][0] += bflo(o.x) * rstd * w[0]; v[rr][j][1] += bfhi(o.x) * rstd * w[1]; v[rr][j][2] += bflo(o.y) * rstd * w[2]; v[rr][j][3] += bfhi(o.y) * rstd * w[3]; }
                f32x4* xo = (f32x4*)(xout + (size_t)row * DM) + F.lane;
#pragma unroll
                for (int j = 0; j < 4; ++j) __builtin_nontemporal_store(v[rr][j], xo + 64 * j);
            }
            if (mode != 2) {
                float s = 0.f;
#pragma unroll
                for (int j = 0; j < 4; ++j) s += (v[rr][j][0] * v[rr][j][0] + v[rr][j][1] * v[rr][j][1]) + (v[rr][j][2] * v[rr][j][2] + v[rr][j][3] * v[rr][j][3]);
                const float rstd = __builtin_amdgcn_rsqf(wave_sum(s) * (1.0f / DM) + NORM_EPS);
                u32x2* ho = (u32x2*)(H + (size_t)row * DM) + F.lane;
#pragma unroll
                for (int j = 0; j < 4; ++j) { const f32x4 w = wpr[j]; u32x2 o;
                    o.x = pk2(v[rr][j][0] * rstd * w[0], v[rr][j][1] * rstd * w[1]); o.y = pk2(v[rr][j][2] * rstd * w[2], v[rr][j][3] * rstd * w[3]); ho[64 * j] = o; }
            }
        }
    }
}

#define LDS_BARRIER() do { asm volatile("s_waitcnt lgkmcnt(0)" ::: "memory"); __builtin_amdgcn_s_barrier(); asm volatile("" ::: "memory"); } while (0)
constexpr int GP_Q = 0, GP_K = 65536, GP_LR = 131072;
__device__ __forceinline__ void phase_gla_pre(const Frame& F, const Args& a, int layer) {
    const int tid = F.tid, dir = tid >> 8, c2 = (tid & 255) * 2;
    LAS unsigned char* lds = F.lds;
    const float* LR = (const float*)(a.ws + WS_LR);
    bf16_t* GQ = (bf16_t*)(a.ws + X_GQ); bf16_t* GK = (bf16_t*)(a.ws + X_GK);
    bf16_t* QDo = dir ? GQ : (bf16_t*)(a.ws + X_BF); bf16_t* KIo = dir ? GK : (bf16_t*)(a.ws + X_BB);
    float* DEC = (float*)(a.ws + WS_ROWSS);
    const float* Wup = (dir ? a.in[5] : a.in[3]) + (size_t)layer * 16 * 512; const float* bias = (dir ? a.in[6] : a.in[4]) + (size_t)layer * 512;
    f32x2 w[16];
#pragma unroll
    for (int i = 0; i < 16; ++i) w[i] = *(const f32x2*)(Wup + i * 512 + c2);
    const f32x2 bz = *(const f32x2*)(bias + c2);
    for (int item = F.bid; item < NB * 64; item += F.G) {
        const size_t tok0 = (size_t)item * 64;
        __syncthreads();
#pragma unroll
        for (int i = 0; i < 8; ++i) { const int c = tid + 512 * i, r = c >> 6, ch = c & 63;
            *(LAS u32x4*)(lds + GP_Q + r * 1024 + ch * 16) = __builtin_nontemporal_load((const u32x4*)(GQ + (tok0 + r) * 512 + ch * 8));
            *(LAS u32x4*)(lds + GP_K + r * 1024 + ch * 16) = __builtin_nontemporal_load((const u32x4*)(GK + (tok0 + r) * 512 + ch * 8)); }
        *(LAS f32x4*)(lds + GP_LR + 16 * tid) = *(const f32x4*)(LR + tok0 * 32 + 4 * tid);
        __syncthreads();
        f32x2 accum = {0.f, 0.f};
#pragma unroll 4
        for (int s0 = 0; s0 < 64; ++s0) { const int t = dir ? 63 - s0 : s0;
            const LAS f32x4* lr4 = (const LAS f32x4*)(lds + GP_LR + t * 128 + dir * 64);
            f32x2 xa = bz, xb = {0.f, 0.f}, xc = {0.f, 0.f}, xd = {0.f, 0.f};
            { const f32x4 l0 = lr4[0], l1 = lr4[1], l2 = lr4[2], l3 = lr4[3];
              xa += w[0] * l0[0]; xb += w[4] * l1[0]; xc += w[8] * l2[0]; xd += w[12] * l3[0];
              xa += w[1] * l0[1]; xb += w[5] * l1[1]; xc += w[9] * l2[1]; xd += w[13] * l3[1];
              xa += w[2] * l0[2]; xb += w[6] * l1[2]; xc += w[10] * l2[2]; xd += w[14] * l3[2];
              xa += w[3] * l0[3]; xb += w[7] * l1[3]; xc += w[11] * l2[3]; xd += w[15] * l3[3]; }
            const f32x2 x = (xa + xb) + (xc + xd);
            const float ls0 = fminf(x[0], 0.f) - 0.6931471805599453f * __builtin_amdgcn_logf(1.0f + __builtin_amdgcn_exp2f(-1.4426950408889634f * fabsf(x[0])));
            const float ls1 = fminf(x[1], 0.f) - 0.6931471805599453f * __builtin_amdgcn_logf(1.0f + __builtin_amdgcn_exp2f(-1.4426950408889634f * fabsf(x[1])));
            accum[0] += ls0 * (1.0f / 16.0f); accum[1] += ls1 * (1.0f / 16.0f);
            const float e0 = __builtin_amdgcn_exp2f(1.4426950408889634f * accum[0]), e1 = __builtin_amdgcn_exp2f(1.4426950408889634f * accum[1]);
            const float i0 = __builtin_amdgcn_rcpf(e0), i1 = __builtin_amdgcn_rcpf(e1);
            const unsigned qw = *(const LAS unsigned*)(lds + GP_Q + t * 1024 + c2 * 2), kw = *(const LAS unsigned*)(lds + GP_K + t * 1024 + c2 * 2);
            *(unsigned*)(QDo + (tok0 + t) * 512 + c2) = pk2(bflo(qw) * e0, bfhi(qw) * e1);
            *(unsigned*)(KIo + (tok0 + t) * 512 + c2) = pk2(bflo(kw) * i0, bfhi(kw) * i1);
        }
        *(f32x2*)(DEC + ((size_t)dir * NB * 64 + item) * 512 + c2) = (f32x2){__builtin_amdgcn_exp2f(1.4426950408889634f * accum[0]), __builtin_amdgcn_exp2f(1.4426950408889634f * accum[1])};
    }
}

constexpr int GS_STR = 272, GS_KSTR = 288, GS_VSTR = 160;
constexpr int GS_QD = 0, GS_KI = 64 * GS_STR, GS_V = GS_KI + 64 * GS_KSTR, GS_DEC = GS_V + 64 * GS_VSTR, GS_BUF = GS_DEC + 512;
constexpr int GS_ST = 2 * GS_BUF, GS_STB = 64 * GS_STR;
__device__ __forceinline__ s16x4 trread(const LAS unsigned char* p) { return __builtin_bit_cast(s16x4, __builtin_amdgcn_ds_read_tr16_b64_v4i16((LAS s16x4*)p)); }
__device__ __forceinline__ bf16x8 cat8(s16x4 lo, s16x4 hi) { return (bf16x8){lo[0], lo[1], lo[2], lo[3], hi[0], hi[1], hi[2], hi[3]}; }
__device__ __forceinline__ bf16x8 pack8(const f32x4& a, const f32x4& b) { u32x4 w; w.x = pk2(a[0], a[1]); w.y = pk2(a[2], a[3]); w.z = pk2(b[0], b[1]); w.w = pk2(b[2], b[3]); return __builtin_bit_cast(bf16x8, w); }

#define GS_LANE_VARS() const int lane = lane0, fr = lane & 15, fq = lane >> 4; (void)fr; (void)fq
#define GS_LOAD_CHUNK(ch) do { const int ch_ = (ch); const unsigned char* q_ = qdb + (size_t)ch_ * 65536 + lqk; const unsigned char* k_ = kib + (size_t)ch_ * 65536 + lqk; const unsigned char* v_ = gvb + (size_t)ch_ * 65536 + lv; \
        pq[0] = *(const u32x4*)(q_); pq[1] = *(const u32x4*)(q_ + 128); pq[2] = *(const u32x4*)(q_ + 8192); pq[3] = *(const u32x4*)(q_ + 8192 + 128); \
        pk[0] = *(const u32x4*)(k_); pk[1] = *(const u32x4*)(k_ + 128); pk[2] = *(const u32x4*)(k_ + 8192); pk[3] = *(const u32x4*)(k_ + 8192 + 128); \
        pv[0] = __builtin_nontemporal_load((const u32x4*)(v_)); pv[1] = __builtin_nontemporal_load((const u32x4*)(v_ + 8192)); \
        if (lane < 32) pdec = *(const float*)(decb + (size_t)ch_ * 2048 + (32 * sw + lane) * 4); } while (0)
#define GS_STAGE(bufi) do { LAS unsigned char* nl_ = F.lds + (bufi) * GS_BUF; LAS unsigned char* p_ = nl_ + GS_QD + ra * GS_STR + ci; LAS unsigned char* k2_ = nl_ + GS_KI + ra * GS_KSTR + ci; LAS unsigned char* v2_ = nl_ + GS_V + ra * GS_VSTR + ci; \
        *(LAS u32x4*)(p_) = pq[0]; *(LAS u32x4*)(p_ + 128) = pq[1]; *(LAS u32x4*)(p_ + 8 * GS_STR) = pq[2]; *(LAS u32x4*)(p_ + 8 * GS_STR + 128) = pq[3]; \
        *(LAS u32x4*)(k2_) = pk[0]; *(LAS u32x4*)(k2_ + 128) = pk[1]; *(LAS u32x4*)(k2_ + 8 * GS_KSTR) = pk[2]; *(LAS u32x4*)(k2_ + 8 * GS_KSTR + 128) = pk[3]; \
        *(LAS u32x4*)(v2_) = pv[0]; *(LAS u32x4*)(v2_ + 8 * GS_VSTR) = pv[1]; if (lane < 32) *(LAS float*)(nl_ + GS_DEC + (32 * sw + lane) * 4) = pdec; } while (0)
#define GS_STAGE_VARS() const int ra = 16 * sw + (lane >> 3), ci = (lane & 7) * 16; const unsigned lqk = (unsigned)(ra * 1024 + ci), lv = lqk

__device__ __forceinline__ void phase_gla_scan(const Frame& F, const Args& a) {
    const int lane0 = F.lane, wid = F.wave;
    for (int u = F.bid; u < 256; u += F.G) {
        const int slot = u >> 3, dvq = slot & 3, grp = (u & 7) * 8 + (slot >> 2), dir = grp & 1, h = (grp >> 1) & 3, b = grp >> 3;
        const unsigned char* qdb = a.ws + (dir ? X_GQ : X_BF) + ((size_t)b * SEQ * 512 + h * 128) * 2; const unsigned char* kib = a.ws + (dir ? X_GK : X_BB) + ((size_t)b * SEQ * 512 + h * 128) * 2;
        const unsigned char* gvb = a.ws + (h < 2 ? X_GVL : X_GVH) + ((size_t)b * SEQ * 512 + (h & 1) * 256 + dvq * 64) * 2;
        const unsigned char* decb = a.ws + WS_ROWSS + (((size_t)dir * NB * 64 + (size_t)b * 64) * 512 + h * 128) * 4;
        const int OLD = dir ? 1024 : OF_LD;
        unsigned char* ob = a.ws + (dir ? X_OB : X_OF) + ((size_t)b * SEQ * OLD + (dir ? 0 : OF_C0) + h * 256 + dvq * 64) * 2;
        __syncthreads();
        {   GS_LANE_VARS(); const int tid = wid * 64 + lane;
            LAS unsigned char* p = F.lds + GS_ST + (tid >> 3) * GS_STR + (tid & 7) * 16; *(LAS u32x4*)p = (u32x4){0u, 0u, 0u, 0u}; *(LAS u32x4*)(p + 128) = (u32x4){0u, 0u, 0u, 0u}; }
        if (wid < 4) {
            const int cb = wid;
            const int sA = dir ? 1 : 0, sB = 1 - sA;
            const bool both = dir ? (cb <= 1) : (cb >= 2);
            float mk[2][4];
            {   GS_LANE_VARS(); const int sD = both ? sB : sA, c = 16 * cb + fr;
#pragma unroll
                for (int jj = 0; jj < 2; ++jj)
#pragma unroll
                    for (int r = 0; r < 4; ++r) { const int j = 32 * sD + 16 * jj + 4 * fq + r; mk[jj][r] = (dir ? (j > c) : (j <= c)) ? 1.f : 0.f; } }
            u32x2 ow[4] = {{0u, 0u}, {0u, 0u}, {0u, 0u}, {0u, 0u}}; unsigned char* oc = ob;
            __syncthreads();
            for (int step = 0; step < 64; ++step) {
                GS_LANE_VARS();
                const int chunk = dir ? 63 - step : step;
                const LAS unsigned char* lds = F.lds + (step & 1) * GS_BUF;
                const LAS unsigned char* stR = F.lds + GS_ST + (step & 1) * GS_STB;
                bf16x8 qb[4], stf[4][4], kaA[2][4], kaB[2][4], viA[4], viB[4];
#pragma unroll
                for (int ks = 0; ks < 4; ++ks) qb[ks] = *(const LAS bf16x8*)(lds + GS_QD + (16 * cb + fr) * GS_STR + (32 * ks + 8 * fq) * 2);
#pragma unroll
                for (int jj = 0; jj < 2; ++jj)
#pragma unroll
                    for (int ks = 0; ks < 4; ++ks) kaA[jj][ks] = *(const LAS bf16x8*)(lds + GS_KI + (32 * sA + 16 * jj + fr) * GS_KSTR + (32 * ks + 8 * fq) * 2);
                if (both) {
#pragma unroll
                    for (int jj = 0; jj < 2; ++jj)
#pragma unroll
                        for (int ks = 0; ks < 4; ++ks) kaB[jj][ks] = *(const LAS bf16x8*)(lds + GS_KI + (32 * sB + 16 * jj + fr) * GS_KSTR + (32 * ks + 8 * fq) * 2);
                }
#pragma unroll
                for (int t = 0; t < 4; ++t)
#pragma unroll
                    for (int ks = 0; ks < 4; ++ks) stf[t][ks] = *(const LAS bf16x8*)(stR + (16 * t + fr) * GS_STR + (32 * ks + 8 * fq) * 2);
                const LAS unsigned char* vb = lds + GS_V + (4 * fq + (fr >> 2)) * GS_VSTR + (4 * (fr & 3)) * 2;
#pragma unroll
                for (int t = 0; t < 4; ++t) viA[t] = cat8(trread(vb + (32 * sA) * GS_VSTR + 32 * t), trread(vb + (32 * sA + 16) * GS_VSTR + 32 * t));
                if (both) {
#pragma unroll
                    for (int t = 0; t < 4; ++t) viB[t] = cat8(trread(vb + (32 * sB) * GS_VSTR + 32 * t), trread(vb + (32 * sB + 16) * GS_VSTR + 32 * t));
                }
                if (step > 0) { const unsigned lo = (unsigned)((16 * cb + fr) * OLD + 4 * fq) * 2u;
#pragma unroll
                    for (int t = 0; t < 4; ++t) __builtin_nontemporal_store(ow[t], (u32x2*)(oc + lo + 32 * t)); }
                f32x4 atA[2] = {(f32x4){0.f, 0.f, 0.f, 0.f}, (f32x4){0.f, 0.f, 0.f, 0.f}}, atB[2] = {(f32x4){0.f, 0.f, 0.f, 0.f}, (f32x4){0.f, 0.f, 0.f, 0.f}};
#pragma unroll
                for (int ks = 0; ks < 4; ++ks)
#pragma unroll
                    for (int jj = 0; jj < 2; ++jj) atA[jj] = __builtin_amdgcn_mfma_f32_16x16x32_bf16(kaA[jj][ks], qb[ks], atA[jj], 0, 0, 0);
                if (both) {
#pragma unroll
                    for (int ks = 0; ks < 4; ++ks)
#pragma unroll
                        for (int jj = 0; jj < 2; ++jj) atB[jj] = __builtin_amdgcn_mfma_f32_16x16x32_bf16(kaB[jj][ks], qb[ks], atB[jj], 0, 0, 0);
                }
                f32x4 oT[4];
#pragma unroll
                for (int t = 0; t < 4; ++t) oT[t] = (f32x4){0.f, 0.f, 0.f, 0.f};
#pragma unroll
                for (int ks = 0; ks < 4; ++ks)
#pragma unroll
                    for (int t = 0; t < 4; ++t) oT[t] = __builtin_amdgcn_mfma_f32_16x16x32_bf16(stf[t][ks], qb[ks], oT[t], 0, 0, 0);
                if (both) {
#pragma unroll
                    for (int jj = 0; jj < 2; ++jj)
#pragma unroll
                        for (int r = 0; r < 4; ++r) atB[jj][r] *= mk[jj][r];
                    const bf16x8 pfA = pack8(atA[0], atA[1]), pfB = pack8(atB[0], atB[1]);
#pragma unroll
                    for (int t = 0; t < 4; ++t) oT[t] = __builtin_amdgcn_mfma_f32_16x16x32_bf16(viA[t], pfA, oT[t], 0, 0, 0);
#pragma unroll
                    for (int t = 0; t < 4; ++t) oT[t] = __builtin_amdgcn_mfma_f32_16x16x32_bf16(viB[t], pfB, oT[t], 0, 0, 0);
                } else {
#pragma unroll
                    for (int jj = 0; jj < 2; ++jj)
#pragma unroll
                        for (int r = 0; r < 4; ++r) atA[jj][r] *= mk[jj][r];
                    const bf16x8 pfA = pack8(atA[0], atA[1]);
#pragma unroll
                    for (int t = 0; t < 4; ++t) oT[t] = __builtin_amdgcn_mfma_f32_16x16x32_bf16(viA[t], pfA, oT[t], 0, 0, 0);
                }
#pragma unroll
                for (int t = 0; t < 4; ++t) { ow[t].x = pk2(oT[t][0], oT[t][1]); ow[t].y = pk2(oT[t][2], oT[t][3]); }
                oc = ob + (size_t)chunk * 64 * OLD * 2;
                LDS_BARRIER();
            }
            {   GS_LANE_VARS(); const unsigned lo = (unsigned)((16 * cb + fr) * OLD + 4 * fq) * 2u;
#pragma unroll
                for (int t = 0; t < 4; ++t) *(u32x2*)(oc + lo + 32 * t) = ow[t]; }
        } else {
            const int sw = wid - 4;
            u32x4 pq[4], pk[4], pv[2]; float pdec = 0.f;
            {   GS_LANE_VARS(); GS_STAGE_VARS(); GS_LOAD_CHUNK(dir ? 63 : 0); GS_STAGE(0); GS_LOAD_CHUNK(dir ? 62 : 1); }
            f32x4 S[2][4];
#pragma unroll
            for (int d = 0; d < 2; ++d)
#pragma unroll
                for (int t = 0; t < 4; ++t) S[d][t] = (f32x4){0.f, 0.f, 0.f, 0.f};
            __syncthreads();
            for (int step = 0; step < 64; ++step) {
                GS_LANE_VARS();
                const LAS unsigned char* lds = F.lds + (step & 1) * GS_BUF;
                LAS unsigned char* stW = F.lds + GS_ST + ((step + 1) & 1) * GS_STB;
                bf16x8 kef[2][2], vi[4][2];
                const LAS unsigned char* vb = lds + GS_V + (4 * fq + (fr >> 2)) * GS_VSTR + (4 * (fr & 3)) * 2;
#pragma unroll
                for (int t = 0; t < 4; ++t) { vi[t][0] = cat8(trread(vb + 32 * t), trread(vb + 16 * GS_VSTR + 32 * t)); vi[t][1] = cat8(trread(vb + 32 * GS_VSTR + 32 * t), trread(vb + 48 * GS_VSTR + 32 * t)); }
#pragma unroll
                for (int d = 0; d < 2; ++d) { const LAS unsigned char* kb = lds + GS_KI + (4 * fq + (fr >> 2)) * GS_KSTR + (32 * sw + 16 * d + 4 * (fr & 3)) * 2;
                    kef[d][0] = cat8(trread(kb), trread(kb + 16 * GS_KSTR)); kef[d][1] = cat8(trread(kb + 32 * GS_KSTR), trread(kb + 48 * GS_KSTR)); }
                f32x4 dcv[2];
#pragma unroll
                for (int d = 0; d < 2; ++d) dcv[d] = *(const LAS f32x4*)(lds + GS_DEC + (32 * sw + 16 * d + 4 * fq) * 4);
#pragma unroll
                for (int sidx = 0; sidx < 2; ++sidx)
#pragma unroll
                    for (int d = 0; d < 2; ++d)
#pragma unroll
                        for (int t = 0; t < 4; ++t) S[d][t] = __builtin_amdgcn_mfma_f32_16x16x32_bf16(kef[d][sidx], vi[t][sidx], S[d][t], 0, 0, 0);
#pragma unroll
                for (int d = 0; d < 2; ++d)
#pragma unroll
                    for (int t = 0; t < 4; ++t) { S[d][t] = S[d][t] * dcv[d]; u32x2 w; w.x = pk2(S[d][t][0], S[d][t][1]); w.y = pk2(S[d][t][2], S[d][t][3]);
                        *(LAS u32x2*)(stW + (16 * t + fr) * GS_STR + (32 * sw + 16 * d + 4 * fq) * 2) = w; }
                {   GS_STAGE_VARS();
                    if (step < 63) GS_STAGE((step + 1) & 1);
                    if (step < 62) GS_LOAD_CHUNK(dir ? 61 - step : step + 2); }
                LDS_BARRIER();
            }
        }
    }
}

__device__ __forceinline__ void phase_comb_b(const Frame& F, const Args& a, int layer) {
    const int gw = F.bid * NWAVES + F.wave, NGW = F.G * NWAVES;
    bf16_t* OF = (bf16_t*)(a.ws + X_OF); const bf16_t* OB = (const bf16_t*)(a.ws + X_OB); const bf16_t* ZB = (const bf16_t*)(a.ws + X_ZB);
    const float* wn = a.in[7] + (size_t)layer * 256 + 8 * (F.lane & 31);
    const f32x4 w0 = *(const f32x4*)wn, w1 = *(const f32x4*)(wn + 4);
    for (int tok0 = gw; tok0 < T; tok0 += 2 * NGW) {
        u32x4 f[4], bq[4], z[4];
#pragma unroll
        for (int q = 0; q < 4; ++q) { const int tok = tok0 + (q >> 1) * NGW, hh = q & 1; const size_t off = (size_t)tok * 1024 + hh * 512 + 8 * F.lane, offf = (size_t)tok * OF_LD + OF_C0 + hh * 512 + 8 * F.lane;
            f[q] = __builtin_nontemporal_load((const u32x4*)(OF + offf)); bq[q] = __builtin_nontemporal_load((const u32x4*)(OB + off)); z[q] = __builtin_nontemporal_load((const u32x4*)(ZB + off)); }
#pragma unroll
        for (int q = 0; q < 4; ++q) { const int tok = tok0 + (q >> 1) * NGW, hh = q & 1; const size_t offf = (size_t)tok * OF_LD + OF_C0 + hh * 512 + 8 * F.lane;
            float o[8];
            o[0] = bflo(f[q].x) + bflo(bq[q].x); o[1] = bfhi(f[q].x) + bfhi(bq[q].x); o[2] = bflo(f[q].y) + bflo(bq[q].y); o[3] = bfhi(f[q].y) + bfhi(bq[q].y);
            o[4] = bflo(f[q].z) + bflo(bq[q].z); o[5] = bfhi(f[q].z) + bfhi(bq[q].z); o[6] = bflo(f[q].w) + bflo(bq[q].w); o[7] = bfhi(f[q].w) + bfhi(bq[q].w);
            float ss = (o[0] * o[0] + o[1] * o[1]) + (o[2] * o[2] + o[3] * o[3]) + (o[4] * o[4] + o[5] * o[5]) + (o[6] * o[6] + o[7] * o[7]);
            ss += __shfl_xor(ss, 1); ss += __shfl_xor(ss, 2); ss += __shfl_xor(ss, 4); ss += __shfl_xor(ss, 8); ss += __shfl_xor(ss, 16);
            const float rstd = __builtin_amdgcn_rsqf(ss * (1.0f / 256.0f) + NORM_EPS);
            u32x4 y;
            y.x = pk2(o[0] * rstd * w0[0] * siluf_(bflo(z[q].x)), o[1] * rstd * w0[1] * siluf_(bfhi(z[q].x))); y.y = pk2(o[2] * rstd * w0[2] * siluf_(bflo(z[q].y)), o[3] * rstd * w0[3] * siluf_(bfhi(z[q].y)));
            y.z = pk2(o[4] * rstd * w1[0] * siluf_(bflo(z[q].z)), o[5] * rstd * w1[1] * siluf_(bfhi(z[q].z))); y.w = pk2(o[6] * rstd * w1[2] * siluf_(bflo(z[q].w)), o[7] * rstd * w1[3] * siluf_(bfhi(z[q].w)));
            *(u32x4*)(OF + offf) = y; }
    }
}

__device__ __forceinline__ void phase_comb_a(const Frame& F, const Args& a, int ch0, int nch) {
    const float* LSE = (const float*)(a.ws + WS_LSE); const bf16_t* ZA = (const bf16_t*)(a.ws + X_ZA); bf16_t* YA = (bf16_t*)(a.ws + X_OF);
    const int head = F.lane >> 4;
    for (int ch = ch0; ch < ch0 + nch; ++ch) {
#pragma unroll 1
        for (int trip = 0; trip < 2; ++trip) {
            const int tokb = ch * 32 + F.wave + 16 * trip;
            float l0[2], l1[2], l2[2]; u32x4 a0[2], a1[2], a2[2], z[2];
#pragma unroll
            for (int rr = 0; rr < 2; ++rr) { const int tok = tokb + 8 * rr; const size_t off = (size_t)tok * 512 + 8 * F.lane;
                const int sq = tok & (SEQ - 1), bb = tok & ~(SEQ - 1); const int t1 = bb | ((sq & 3) << 10) | (sq >> 2), t2 = bb | ((sq & 15) << 8) | (sq >> 4);
                const size_t off1 = (size_t)t1 * 512 + 8 * F.lane, off2 = (size_t)t2 * 512 + 8 * F.lane;
                l0[rr] = LSE[(size_t)tok * 4 + head]; l1[rr] = LSE[(size_t)T * 4 + (size_t)t1 * 4 + head]; l2[rr] = LSE[(size_t)2 * T * 4 + (size_t)t2 * 4 + head];
                a0[rr] = __builtin_nontemporal_load((const u32x4*)((const bf16_t*)(a.ws + X_QO) + off)); a1[rr] = __builtin_nontemporal_load((const u32x4*)((const bf16_t*)(a.ws + X_QO + 32 * MiB) + off1)); a2[rr] = __builtin_nontemporal_load((const u32x4*)((const bf16_t*)(a.ws + X_QO + 64 * MiB) + off2));
                z[rr] = __builtin_nontemporal_load((const u32x4*)(ZA + off)); }
#pragma unroll
            for (int rr = 0; rr < 2; ++rr) { const int tok = tokb + 8 * rr;
                const float mx = fmaxf(l0[rr], fmaxf(l1[rr], l2[rr]));
                float w0 = __builtin_amdgcn_exp2f(1.4426950408889634f * (l0[rr] - mx)), w1 = __builtin_amdgcn_exp2f(1.4426950408889634f * (l1[rr] - mx)), w2 = __builtin_amdgcn_exp2f(1.4426950408889634f * (l2[rr] - mx));
                const float inv = __builtin_amdgcn_rcpf(w0 + w1 + w2); w0 *= inv; w1 *= inv; w2 *= inv;
                const u32x4 p = a0[rr], q = a1[rr], r = a2[rr], zz = z[rr];
                u32x4 y;
                y.x = pk2((w0 * bflo(p.x) + w1 * bflo(q.x) + w2 * bflo(r.x)) * siluf_(bflo(zz.x)), (w0 * bfhi(p.x) + w1 * bfhi(q.x) + w2 * bfhi(r.x)) * siluf_(bfhi(zz.x)));
                y.y = pk2((w0 * bflo(p.y) + w1 * bflo(q.y) + w2 * bflo(r.y)) * siluf_(bflo(zz.y)), (w0 * bfhi(p.y) + w1 * bfhi(q.y) + w2 * bfhi(r.y)) * siluf_(bfhi(zz.y)));
                y.z = pk2((w0 * bflo(p.z) + w1 * bflo(q.z) + w2 * bflo(r.z)) * siluf_(bflo(zz.z)), (w0 * bfhi(p.z) + w1 * bfhi(q.z) + w2 * bfhi(r.z)) * siluf_(bfhi(zz.z)));
                y.w = pk2((w0 * bflo(p.w) + w1 * bflo(q.w) + w2 * bflo(r.w)) * siluf_(bflo(zz.w)), (w0 * bfhi(p.w) + w1 * bfhi(q.w) + w2 * bfhi(r.w)) * siluf_(bfhi(zz.w)));
                *(u32x4*)(YA + (size_t)tok * OF_LD + 8 * F.lane) = y; }
        }
    }
}

constexpr int AT_STR = 272, AT_VSTR = 288, AT_K = 0, AT_V = 256 * AT_STR;
__device__ __forceinline__ void phase_attn(const Frame& F, const Args& a, unsigned* qctr) {
    const int tid = F.tid, lane = F.lane, wid = F.wave, fr = lane & 15, fq = lane >> 4;
    LAS unsigned char* lds = F.lds;
    constexpr int NU = 3072, NRUN = NU / 4;
    u32x4 pk[8], pv[8];
    auto geom = [&](int ug, int& g, int& d, int& L, int& r, int& jj, int& h, int& b) { g = ug >> 10; const int u = ug & 1023; d = (g == 0) ? 1 : (g == 1 ? 4 : 16); L = SEQ / d; const int upc = L / 128;
        const int cls = u & 31; r = cls / upc; jj = cls % upc; h = (u >> 5) & 3; b = u >> 7; };
    auto prefetch = [&](int ug, bool reuse) {
        int g, d, L, r, jj, h, b; geom(ug, g, d, L, r, jj, h, b);
        const bf16_t* KA = (const bf16_t*)(a.ws + X_KA + (size_t)g * 32 * MiB); const bf16_t* VA = (const bf16_t*)(a.ws + X_VA + (size_t)g * 32 * MiB);
        const int tk0 = 128 * jj - 64; const size_t tokb = (size_t)b * SEQ + (size_t)r * L;
        if (!reuse) {
#pragma unroll
            for (int i = 0; i < 4; ++i) { const int c = tid + 512 * i, row = c >> 4, ch = c & 15, tk = tk0 + row; const int tkc = tk < 0 ? 0 : (tk >= L ? L - 1 : tk);
                const size_t go = (tokb + (size_t)tkc) * 512 + h * 128 + ch * 8; pk[i] = *(const u32x4*)(KA + go); pv[i] = *(const u32x4*)(VA + go); } }
#pragma unroll
        for (int i = 4; i < 8; ++i) { const int c = tid + 512 * i, row = c >> 4, ch = c & 15, tk = tk0 + row; const int tkc = tk < 0 ? 0 : (tk >= L ? L - 1 : tk);
            const size_t go = (tokb + (size_t)tkc) * 512 + h * 128 + ch * 8; pk[i] = *(const u32x4*)(KA + go); pv[i] = *(const u32x4*)(VA + go); }
    };
    volatile LAS unsigned* qslot = (volatile LAS unsigned*)(F.lds + LDS_BYTES - 256 + 64);
    int R = F.bid;
    if (R < NRUN) prefetch(4 * R, false);
    while (R < NRUN) {
      int Rn = NRUN;
#pragma unroll 1
      for (int k = 0; k < 4; ++k) {
        const int ug = 4 * R + k;
        int g, d, L, r, jj, h, b; geom(ug, g, d, L, r, jj, h, b);
        const bool reuse = (k > 0) && (jj > 0);
        bf16_t* QO = (bf16_t*)(a.ws + X_QO + (size_t)g * 32 * MiB); float* LSEg = (float*)(a.ws + WS_LSE) + (size_t)g * T * 4;
        const int t0 = 128 * jj, tk0 = t0 - 64;
        const size_t tokb = (size_t)b * SEQ + (size_t)r * L;
        LDS_BARRIER();
        if (k == 3) Rn = (int)*qslot;
        if (!reuse) {
#pragma unroll
            for (int i = 0; i < 4; ++i) { const int c = tid + 512 * i, slot = (tk0 + (c >> 4)) & 255, ch = c & 15;
                *(LAS u32x4*)(lds + AT_K + slot * AT_STR + ch * 16) = pk[i]; *(LAS u32x4*)(lds + AT_V + slot * AT_VSTR + ch * 16) = pv[i]; } }
#pragma unroll
        for (int i = 4; i < 8; ++i) { const int c = tid + 512 * i, slot = (tk0 + (c >> 4)) & 255, ch = c & 15;
            *(LAS u32x4*)(lds + AT_K + slot * AT_STR + ch * 16) = pk[i]; *(LAS u32x4*)(lds + AT_V + slot * AT_VSTR + ch * 16) = pv[i]; }
        const int tq = t0 + 16 * wid + fr; const size_t qoff = (tokb + (size_t)tq) * 512 + h * 128;
        bf16x8 qf[4];
#pragma unroll
        for (int ks = 0; ks < 4; ++ks) qf[ks] = *(const bf16x8*)(QO + qoff + 32 * ks + 8 * fq);
        if (k < 3) { int g2, d2, L2, r2, jj2, h2, b2; geom(ug + 1, g2, d2, L2, r2, jj2, h2, b2); prefetch(ug + 1, jj2 > 0); }
        else if (Rn < NRUN) prefetch(4 * Rn, false);
        LDS_BARRIER();
        unsigned pulled = (unsigned)NRUN; if (k == 0 && tid == 0) pulled = (unsigned)F.G + __hip_atomic_fetch_add(qctr, 1u, __ATOMIC_RELAXED, __HIP_MEMORY_SCOPE_AGENT);
        f32x4 s[10]; float m = -1e30f;
        const LAS unsigned char* kbase = lds + AT_K + fr * AT_STR + (8 * fq) * 2;
        const int ktile0 = tk0 + 16 * wid;
        bf16x8 kfa[8], kfb[8];
#define LOADK(dst, kt0) do { _Pragma("unroll") for (int q_ = 0; q_ < 8; ++q_) { const int kt_ = (kt0) + (q_ >> 2); if (kt_ < 9) dst[q_] = *(const LAS bf16x8*)(kbase + ((ktile0 + 16 * kt_) & 255) * AT_STR + (q_ & 3) * 64); } } while (0)
#define MMAK(src, kt0) do { _Pragma("unroll") for (int q_ = 0; q_ < 8; ++q_) { const int kt_ = (kt0) + (q_ >> 2); if (kt_ < 9) s[kt_] = __builtin_amdgcn_mfma_f32_16x16x32_bf16(src[q_], qf[q_ & 3], s[kt_], 0, 0, 0); } } while (0)
#pragma unroll
        for (int kt = 0; kt < 10; ++kt) s[kt] = (f32x4){0.f, 0.f, 0.f, 0.f};
        LOADK(kfa, 0); __builtin_amdgcn_sched_barrier(0);
        LOADK(kfb, 2); __builtin_amdgcn_sched_barrier(0); MMAK(kfa, 0); __builtin_amdgcn_sched_barrier(0);
        LOADK(kfa, 4); __builtin_amdgcn_sched_barrier(0); MMAK(kfb, 2); __builtin_amdgcn_sched_barrier(0);
        LOADK(kfb, 6); __builtin_amdgcn_sched_barrier(0); MMAK(kfa, 4); __builtin_amdgcn_sched_barrier(0);
        LOADK(kfa, 8); __builtin_amdgcn_sched_barrier(0); MMAK(kfb, 6); __builtin_amdgcn_sched_barrier(0);
        MMAK(kfa, 8);
#undef LOADK
#undef MMAK
#pragma unroll
        for (int kt = 0; kt < 9; ++kt)
#pragma unroll
            for (int rg = 0; rg < 4; ++rg) { const int diff = 16 * kt + 4 * fq + rg - 64 - fr, tk = tk0 + 16 * wid + 16 * kt + 4 * fq + rg;
                const bool valid = (diff >= -64) && (diff <= 64) && (tk >= 0) && (tk < L);
                if (!valid) s[kt][rg] = -1e30f; m = fmaxf(m, s[kt][rg]); }
        m = fmaxf(m, __shfl_xor(m, 16)); m = fmaxf(m, __shfl_xor(m, 32));
        float l = 0.f;
#pragma unroll
        for (int kt = 0; kt < 9; ++kt)
#pragma unroll
            for (int rg = 0; rg < 4; ++rg) { const float p = __builtin_amdgcn_exp2f(1.4426950408889634f * (s[kt][rg] - m)); s[kt][rg] = p; l += p; }
        l += __shfl_xor(l, 16); l += __shfl_xor(l, 32);
        bf16x8 pf[5];
#pragma unroll
        for (int sidx = 0; sidx < 5; ++sidx) pf[sidx] = pack8(s[2 * sidx], s[2 * sidx + 1]);
        const float invl = __builtin_amdgcn_rcpf(l);
        int vr[10];
#pragma unroll
        for (int sidx = 0; sidx < 5; ++sidx) { const int r1 = tk0 + 16 * wid + 32 * sidx + 4 * fq + (fr >> 2), r2 = r1 + 16; vr[2 * sidx] = (r1 & 255) * AT_VSTR; vr[2 * sidx + 1] = (r2 & 255) * AT_VSTR; }
        const LAS unsigned char* vbase = lds + AT_V + (4 * (fr & 3)) * 2;
        bf16x8 vfa[5], vfb[5];
#define LOADV(dst, t) do { _Pragma("unroll") for (int q_ = 0; q_ < 5; ++q_) dst[q_] = cat8(trread(vbase + vr[2 * q_] + (t) * 32), trread(vbase + vr[2 * q_ + 1] + (t) * 32)); } while (0)
#define MMAV(src, t) do { f32x4 o_ = {0.f, 0.f, 0.f, 0.f}; _Pragma("unroll") for (int q_ = 0; q_ < 5; ++q_) o_ = __builtin_amdgcn_mfma_f32_16x16x32_bf16(src[q_], pf[q_], o_, 0, 0, 0); \
            u32x2 w_; w_.x = pk2(o_[0] * invl, o_[1] * invl); w_.y = pk2(o_[2] * invl, o_[3] * invl); *(u32x2*)(QO + qoff + 16 * (t) + 4 * fq) = w_; } while (0)
        LOADV(vfa, 0); __builtin_amdgcn_sched_barrier(0);
        LOADV(vfb, 1); __builtin_amdgcn_sched_barrier(0); MMAV(vfa, 0); __builtin_amdgcn_sched_barrier(0);
        LOADV(vfa, 2); __builtin_amdgcn_sched_barrier(0); MMAV(vfb, 1); __builtin_amdgcn_sched_barrier(0);
        LOADV(vfb, 3); __builtin_amdgcn_sched_barrier(0); MMAV(vfa, 2); __builtin_amdgcn_sched_barrier(0);
        LOADV(vfa, 4); __builtin_amdgcn_sched_barrier(0); MMAV(vfb, 3); __builtin_amdgcn_sched_barrier(0);
        LOADV(vfb, 5); __builtin_amdgcn_sched_barrier(0); MMAV(vfa, 4); __builtin_amdgcn_sched_barrier(0);
        LOADV(vfa, 6); __builtin_amdgcn_sched_barrier(0); MMAV(vfb, 5); __builtin_amdgcn_sched_barrier(0);
        LOADV(vfb, 7); __builtin_amdgcn_sched_barrier(0); MMAV(vfa, 6); __builtin_amdgcn_sched_barrier(0);
        MMAV(vfb, 7);
#undef LOADV
#undef MMAV
        if (fq == 0) LSEg[(tokb + (size_t)tq) * 4 + h] = m + 0.6931471805599453f * __builtin_amdgcn_logf(l);
        if (k == 0 && tid == 0) *qslot = pulled;
      }
      R = Rn;
    }
}

__device__ __forceinline__ void run_proj(const Frame& F, unsigned char* ws, const bf16_t* WIN, const bf16_t* Hh, const float* ropec, const float* ropes, int tau0, int ntiles) {
    pg8::Gemm gm{Hh, WIN + (size_t)tau0 * 256 * 1024, T, ntiles * 256, 1024}; pg8::StaticOrder S; S.init(T, ntiles * 256, F.G, F.bid);
    EpiProj E{tau0, ws, ropec, ropes};
    pg8::gemm_phase<EpiProj, pg8::StaticOrder, true, true>(F.lds, gm, S, E, F.wave);
}

#define XB_TMO      128
#define XB_XCNT(j)  (256  + 64 * (j))
#define XB_XSUB(j)  (1280 + 64 * (j))
#define XB_XGEN(j)  (2304 + 64 * (j))
#define XB_TOP      3328
#define XB_TOPGEN   3392
#define XCD_BAR_WORDS 3456
#define XB_SPIN_CAP (1u << 18)

__device__ __forceinline__ unsigned xb_ld(unsigned* p)              { return __hip_atomic_load(p, __ATOMIC_RELAXED, __HIP_MEMORY_SCOPE_AGENT); }
__device__ __forceinline__ unsigned xb_add(unsigned* p, unsigned v) { return __hip_atomic_fetch_add(p, v, __ATOMIC_RELAXED, __HIP_MEMORY_SCOPE_AGENT); }
__device__ __forceinline__ unsigned xb_xcc_id() { return (unsigned)__builtin_amdgcn_s_getreg((3 << 11) | 20) & 0xFu; }
#define XB_SPIN(cond, bar) do { unsigned _sp = 0; while (cond) { __builtin_amdgcn_s_sleep(1); \
    if ((++_sp & 255u) == 0u) { if (xb_ld(&(bar)[XB_TMO])) break; if (_sp > XB_SPIN_CAP) { atomicAdd(&(bar)[XB_TMO], 1u); break; } } } } while (0)

struct XcdBarrier {
    unsigned* bar; unsigned x;
    volatile LAS unsigned* st;
};

__device__ __forceinline__ XcdBarrier xcd_barrier_post(unsigned* bar, volatile LAS unsigned* st) {
    XcdBarrier b; b.bar = bar; b.x = xb_xcc_id(); b.st = st;
    if (threadIdx.x == 0) (void)xb_add(&bar[XB_XCNT(b.x)], 1u);
    return b;
}
__device__ __forceinline__ void xcd_barrier_complete(unsigned* bar, unsigned x, unsigned& nloc, unsigned& nx) {
    const unsigned G = gridDim.x * gridDim.y * gridDim.z;
    unsigned sum, cnt, mine, sp = 0u;
    for (;;) {
        sum = 0u; cnt = 0u; mine = 0u;
#pragma unroll
        for (unsigned j = 0; j < 16; ++j) { const unsigned c = xb_ld(&bar[XB_XCNT(j)]); sum += c; cnt += (c > 0u) ? 1u : 0u; mine = (j == x) ? c : mine; }
        if (sum == G) break;
        __builtin_amdgcn_s_sleep(1);
        if ((++sp & 255u) == 0u) { if (xb_ld(&bar[XB_TMO])) break; if (sp > XB_SPIN_CAP) { atomicAdd(&bar[XB_TMO], 1u); break; } }
    }
    nloc = mine > 0u ? mine : 1u; nx = cnt > 0u ? cnt : 1u;
}

__device__ __forceinline__ void xcd_barrier(const XcdBarrier& b, const bool leader_thread) {
    asm volatile("s_waitcnt vmcnt(0)" ::: "memory");
    __syncthreads();
    if (leader_thread) {
        unsigned* bar = b.bar;
        __builtin_amdgcn_s_waitcnt(0);
        unsigned nloc = b.st[0], nx = b.st[1];
        if (nloc == 0u) { xcd_barrier_complete(bar, b.x, nloc, nx); b.st[0] = nloc; b.st[1] = nx; }
        const unsigned old = xb_add(&bar[XB_XSUB(b.x)], 1u);
        const unsigned gen = old / nloc;
        if (old + 1u == (gen + 1u) * nloc) {
            __builtin_amdgcn_fence(__ATOMIC_RELEASE, "agent");
            asm volatile("s_waitcnt vmcnt(0)" ::: "memory");
            const unsigned og = xb_add(&bar[XB_TOP], 1u);
            const unsigned tg = og / nx;
            if (og + 1u == (tg + 1u) * nx) xb_add(&bar[XB_TOPGEN], 1u);
            else XB_SPIN(xb_ld(&bar[XB_TOPGEN]) == tg, bar);
            __builtin_amdgcn_fence(__ATOMIC_ACQUIRE, "agent");
            xb_add(&bar[XB_XGEN(b.x)], 1u);
            asm volatile("s_waitcnt vmcnt(0)" ::: "memory");
        } else {
            XB_SPIN(xb_ld(&bar[XB_XGEN(b.x)]) == gen, bar);
            __builtin_amdgcn_fence(__ATOMIC_ACQUIRE, "agent");
            asm volatile("s_waitcnt vmcnt(0)" ::: "memory");
        }
    }
    __syncthreads();
}

constexpr int COMB_X = 2;
constexpr int CW_BAR = 4096;
constexpr size_t CTL_ZERO_BYTES = 64 * 1024;
constexpr int MISC_OFF = LDS_BYTES - 256;

#define LAUNDER() do { asm volatile("" : "+s"(F.wave), "+s"(F.bid), "+s"(F.G)); F.lane = fresh_lane(); F.tid = F.wave * 64 + F.lane; asm volatile("" : "+s"(ws)); } while (0)
#define GRID_BAR() do { XcdBarrier bb_ = bar; asm volatile("" : "+s"(bb_.bar), "+s"(bb_.x)); xcd_barrier(bb_, (F.wave * 64 + fresh_lane()) == 0); LAUNDER(); } while (0)

__global__ void __launch_bounds__(NTHR, 2) hybrid_fwd(Args args) {
    extern __shared__ __attribute__((aligned(16))) unsigned char lds_raw[];
    Frame F; F.lds = (LAS unsigned char*)lds_raw; F.tid = threadIdx.x; F.lane = F.tid & 63; F.wave = __builtin_amdgcn_readfirstlane(F.tid >> 6); F.G = gridDim.x; F.bid = blockIdx.x;
    unsigned char* ws = args.ws;
    volatile LAS unsigned* MISC = (volatile LAS unsigned*)(F.lds + MISC_OFF);
    if (F.tid < 64) MISC[F.tid] = 0u;
    __syncthreads();
    XcdBarrier bar = xcd_barrier_post((unsigned*)(ws + WS_CTL) + CW_BAR, MISC + 8);

    phase_prologue(F, args);
    __syncthreads(); LAUNDER();
#pragma unroll 1
    for (int layer = 0; layer < 2; ++layer) {
        LAUNDER();
        const float* ropec = (const float*)(ws + WS_ROPEC); const float* ropes = (const float*)(ws + WS_ROPES);
        const bf16_t* WIN = (const bf16_t*)(ws + WS_WIN + layer * WIN_BYTES);
        const bf16_t* Hh = (const bf16_t*)(ws + WS_H);
        if (layer == 0) phase_prep(F, args, 0, args.in[0], nullptr, nullptr, args.in[1]); else phase_prep(F, args, 1, args.in[0], args.out, args.in[11], args.in[1] + 1024);
        GRID_BAR();
        run_proj(F, ws, WIN, Hh, ropec, ropes, 0, 20);
        GRID_BAR();
        phase_attn(F, args, (unsigned*)(ws + WS_CTL) + 8192 + 64 * layer);
        GRID_BAR();
        {
            const int half = F.G >> 1; const bool five = F.bid < half;
            const int nch = five ? COMB_X : 8 - COMB_X, ch0 = five ? F.bid * COMB_X : half * COMB_X + (F.bid - half) * (8 - COMB_X);
            if (F.G == 256) phase_comb_a(F, args, ch0, nch); else phase_comb_a(F, args, (T / 32) * F.bid / F.G, (T / 32) * (F.bid + 1) / F.G - (T / 32) * F.bid / F.G); }
        LAUNDER();
        run_proj(F, ws, WIN, Hh, ropec, ropes, 20, 9);
        GRID_BAR();
        phase_gla_pre(F, args, layer);
        GRID_BAR();
        phase_gla_scan(F, args);
        GRID_BAR();
        run_proj(F, ws, WIN, Hh, ropec, ropes, 29, 12);
        GRID_BAR();
        phase_comb_b(F, args, layer);
        GRID_BAR();
        { pg8::Gemm gm{(const bf16_t*)(ws + X_OF), (const bf16_t*)(ws + WS_WA + layer * 3 * MiB), T, 1024, 1536}; pg8::StaticOrder S; S.init(T, 1024, F.G, F.bid);
          EpiMerge E{(const bf16_t*)(ws + X_GA), (const bf16_t*)(ws + X_GB), (bf16_t*)(ws + WS_H)};
          pg8::gemm_phase<EpiMerge, pg8::StaticOrder, true, true>(F.lds, gm, S, E, F.wave); }
        GRID_BAR();
        { pg8::Gemm gm{(const bf16_t*)(ws + WS_H), (const bf16_t*)(ws + WS_WO + layer * 2 * MiB), T, 1024, 1024}; pg8::StaticOrder S; S.init(T, 1024, F.G, F.bid);
          EpiOut E{(bf16_t*)(ws + X_OUT), (float*)(ws + WS_ROWSS)};
          pg8::gemm_phase<EpiOut, pg8::StaticOrder, true, true>(F.lds, gm, S, E, F.wave); }
        GRID_BAR();
    }
    phase_prep(F, args, 2, args.out, args.out, args.in[11] + 1024, nullptr);
}

extern "C" void kernel_launch(void* const* d_in, const int* in_sizes, int n_in, void* d_out, int out_size, void* d_ws, size_t ws_size, hipStream_t stream) {
    static int grid = 0;
    if (grid == 0) {
        if (n_in != 12 || out_size != T * DM || ws_size < WS_END) { fprintf(stderr, "kernel_launch: unexpected shapes (n_in %d out %d ws %zu)\n", n_in, out_size, ws_size); grid = -1; return; }
        int dev = 0, cus = 0;
        if (hipGetDevice(&dev) != hipSuccess || hipDeviceGetAttribute(&cus, hipDeviceAttributeMultiprocessorCount, dev) != hipSuccess) { grid = -1; return; }
        if (hipFuncSetAttribute((const void*)hybrid_fwd, hipFuncAttributeMaxDynamicSharedMemorySize, LDS_BYTES) != hipSuccess) { grid = -1; return; }
        grid = cus;
    }
    if (grid < 0) return;
    if (hipMemsetAsync((char*)d_ws + WS_CTL, 0, CTL_ZERO_BYTES, stream) != hipSuccess) return;
    Args a{};
    for (int i = 0; i < 12; ++i) a.in[i] = (const float*)d_in[i];
    a.out = (float*)d_out; a.ws = (unsigned char*)d_ws; a.ph_lo = 0; a.ph_hi = 0;
    hipLaunchKernelGGL(hybrid_fwd, dim3(grid), dim3(NTHR), LDS_BYTES, stream, a);
}
```

```cpp
#include <hip/hip_runtime.h>
#include <cstdio>
#include <cstdint>
__device__ __forceinline__ int fresh_lane() { int l; asm volatile("v_mbcnt_lo_u32_b32 %0, -1, 0\n\tv_mbcnt_hi_u32_b32 %0, -1, %0" : "=v"(l)); return l; }
namespace pg8 {
#define PG8_LAS __attribute__((address_space(3)))
typedef unsigned short bf16_t;
typedef short bf16x8 __attribute__((ext_vector_type(8)));
typedef float f32x4 __attribute__((ext_vector_type(4)));
typedef unsigned u32x4 __attribute__((ext_vector_type(4)));
constexpr int BM = 256, BK = 64, HALF = 128, HTB = HALF * BK * 2  , STAGE_BYTES = 8 * HTB, NXCD = 8, WGM = 8;

__host__ __device__ __forceinline__ int lds_byte(int r, int c) { const int st = (r >> 4) * 2 + (c >> 5), rr = r & 15, cc = c & 31, ob = rr * 64 + cc * 2; return st * 1024 + (ob ^ (((ob >> 9) & 1) << 5)); }
__host__ __device__ __forceinline__ void stage_rc(int b, int& R, int& C) { const int st = b / 1024, sb = b % 1024, swz = sb ^ (((sb >> 9) & 1) << 5); R = (st >> 1) * 16 + swz / 64; C = (st & 1) * 32 + (swz % 64) / 2; }
__host__ __device__ __forceinline__ int perm32(int rho) { const int n = rho >> 4, i = rho & 15; return 8 * (i >> 2) + 4 * n + (i & 3); }

struct Unit { int pm, pn; };
struct Gemm { const bf16_t* A; const bf16_t* Bt; int M, N, K; };

struct StaticOrder {
    int nM, nN, nwg, G, c;
    __host__ __device__ void init(int M, int N, int G_, int c_) { nM = M / BM; nN = N / BM; nwg = nM * nN; G = G_; c = c_; }
    __host__ __device__ bool next(int i, Unit& u) const {
        const long L = (long)i * G + c; if (L >= nwg) return false;
        int wgid = (int)L; { const int q = nwg / NXCD, r = nwg % NXCD, xcd = wgid % NXCD, off = wgid / NXCD; wgid = (xcd < r ? xcd * (q + 1) : r * (q + 1) + (xcd - r) * q) + off; }
        const int nig = WGM * nN, gid = wgid / nig, fm = gid * WGM, gsz = (nM - fm) < WGM ? (nM - fm) : WGM;
        u.pm = fm + ((wgid % nig) % gsz); u.pn = (wgid % nig) / gsz; return true;
    }
    __device__ __forceinline__ void a_ready(const Unit&) const {}
    __device__ __forceinline__ void done(const Unit&) const {}
};


__device__ __forceinline__ unsigned cvt_pk_bf16(float lo, float hi) { unsigned r; asm volatile("v_cvt_pk_bf16_f32 %0, %1, %2" : "=v"(r) : "v"(lo), "v"(hi)); return r; }
template <class Epi, class Sched, bool ALIGN_EPI = false, bool SP2 = false>
__device__ __forceinline__ void gemm_phase(PG8_LAS unsigned char* lds, const Gemm g, const Sched& S, const Epi& E, int wave_id) {
    const int lane = fresh_lane(), wid = wave_id, tid = wid * 64 + lane, wr = wid >> 2, wc = wid & 3, fr = lane & 15, fq = lane >> 4;
    const int K = g.K, nt = K / BK;
    unsigned voffA[2], voffB[2];
#pragma unroll
    for (int i = 0; i < 2; ++i) { int R, C; stage_rc(tid * 16 + i * 8192, R, C); const int Rb = Epi::PERM ? ((R & ~31) + perm32(R & 31)) : R;
        voffA[i] = (unsigned)(R * K + C) * 2u; voffB[i] = (unsigned)(Rb * K + C) * 2u; }
    const size_t kstep = (size_t)(BK * 2);
    const size_t hstep = (size_t)HALF * K * 2;
    const size_t tstep = 2 * hstep;
    const unsigned ldsw = (unsigned)wid * 1024u;
    const int aoff = lds_byte(wr * 64 + fr, fq * 8), boff = lds_byte(wc * 32 + fr, fq * 8);
#define PG8_SA(b, h) (((b) * 2 + (h)) * HTB)
#define PG8_SB(b, h) ((4 + (b) * 2 + (h)) * HTB)
#define PG8_STAGE(bufoff, gbase, voff) do { _Pragma("unroll") for (int _i = 0; _i < 2; ++_i) \
        __builtin_amdgcn_global_load_lds((const unsigned*)((const char*)(gbase) + (voff)[_i]), (PG8_LAS unsigned*)(lds + (bufoff) + ldsw + _i * 8192), 16, 0, 0); } while (0)
#define PG8_LDA(dst, b, h) do { _Pragma("unroll") for (int m = 0; m < 4; ++m) _Pragma("unroll") for (int k = 0; k < 2; ++k) dst[m][k] = *(const PG8_LAS bf16x8*)(lds + PG8_SA(b, h) + aoff + m * 2048 + k * 1024); } while (0)
#define PG8_LDB(dst, b, h) do { _Pragma("unroll") for (int n = 0; n < 2; ++n) _Pragma("unroll") for (int k = 0; k < 2; ++k) dst[n][k] = *(const PG8_LAS bf16x8*)(lds + PG8_SB(b, h) + boff + n * 2048 + k * 1024); } while (0)
#define PG8_MMA(ai, bj, At, Bt) do { __builtin_amdgcn_s_setprio(1); _Pragma("unroll") for (int m = 0; m < 4; ++m) _Pragma("unroll") for (int n = 0; n < 2; ++n) _Pragma("unroll") for (int k = 0; k < 2; ++k) \
        acc[ai][bj][m][n] = __builtin_amdgcn_mfma_f32_16x16x32_bf16(Bt[n][k], At[m][k], acc[ai][bj][m][n], 0, 0, 0); __builtin_amdgcn_s_setprio(0); } while (0)
#define PG8_WAIT_V(n) asm volatile("s_waitcnt vmcnt(" #n ")" ::: "memory")
#define PG8_WAIT_L(n) asm volatile("s_waitcnt lgkmcnt(" #n ")" ::: "memory")
#define PG8_BAR __builtin_amdgcn_s_barrier()
#define PG8_SCHED __builtin_amdgcn_sched_barrier(0)
    Unit cur, nxt; int ui = 0;
    if (!S.next(0, cur)) return;
    f32x4 acc[2][2][4][2];
#pragma unroll
    for (int a = 0; a < 2; ++a)
#pragma unroll
        for (int b = 0; b < 2; ++b)
#pragma unroll
            for (int m = 0; m < 4; ++m)
#pragma unroll
                for (int n = 0; n < 2; ++n) acc[a][b][m][n] = (f32x4){0.f, 0.f, 0.f, 0.f};
    bf16x8 At[4][2], B0[2][2], B1[2][2];
    const char* cA = (const char*)g.A + (size_t)cur.pm * tstep; const char* cB = (const char*)g.Bt + (size_t)cur.pn * tstep;
    S.a_ready(cur);
    if constexpr (SP2) {
        PG8_STAGE(PG8_SB(0, 0), cB, voffB); PG8_STAGE(PG8_SB(0, 1), cB + hstep, voffB); PG8_STAGE(PG8_SA(0, 0), cA, voffA); PG8_STAGE(PG8_SA(0, 1), cA + hstep, voffA);
        if (wr == 1) PG8_BAR;
        PG8_WAIT_V(2); PG8_BAR;
        PG8_STAGE(PG8_SB(1, 0), cB + kstep, voffB); PG8_STAGE(PG8_SA(1, 0), cA + kstep, voffA); PG8_STAGE(PG8_SB(1, 1), cB + hstep + kstep, voffB);
        PG8_WAIT_V(6); PG8_BAR;
    } else {
        PG8_STAGE(PG8_SB(0, 0), cB, voffB); PG8_STAGE(PG8_SA(0, 0), cA, voffA); PG8_STAGE(PG8_SB(0, 1), cB + hstep, voffB); PG8_STAGE(PG8_SA(0, 1), cA + hstep, voffA);
        if (wr == 1) PG8_BAR;
        PG8_WAIT_V(4); PG8_BAR;
        PG8_STAGE(PG8_SB(1, 0), cB + kstep, voffB); PG8_STAGE(PG8_SA(1, 0), cA + kstep, voffA); PG8_STAGE(PG8_SB(1, 1), cB + hstep + kstep, voffB);
        PG8_WAIT_V(6); PG8_BAR;
    }
    for (;;) {
        const bool has_next = S.next(ui + 1, nxt);
        const char* nA = has_next ? (const char*)g.A + (size_t)nxt.pm * tstep : cA; const char* nB = has_next ? (const char*)g.Bt + (size_t)nxt.pn * tstep : cB;
        for (int t = 0; t < nt; t += 2) {
            if constexpr (Epi::MIDT > 0) { if (t == Epi::MIDT) E.mid(acc, cur, wr, wc, fr, fq); }
            const bool last = (t == nt - 2);
            const char* a1 = cA + (size_t)(t + 1) * kstep;
            const char* a2 = last ? nA : cA + (size_t)(t + 2) * kstep; const char* b2 = last ? nB : cB + (size_t)(t + 2) * kstep;
            const char* a3 = a2 + kstep; const char* b3 = b2 + kstep;
            if (last && has_next) S.a_ready(nxt);
            if constexpr (SP2) {
            PG8_LDB(B0, 0, 0); PG8_LDB(B1, 0, 1); PG8_SCHED; PG8_LDA(At, 0, 0); PG8_STAGE(PG8_SA(1, 1), a1 + hstep, voffA);
            PG8_WAIT_V(8); PG8_WAIT_L(0); PG8_BAR; PG8_MMA(0, 0, At, B0); PG8_MMA(0, 1, At, B1); PG8_BAR; PG8_SCHED;
            PG8_LDA(At, 0, 1); PG8_STAGE(PG8_SB(0, 0), b2, voffB); PG8_STAGE(PG8_SB(0, 1), b2 + hstep, voffB); PG8_STAGE(PG8_SA(0, 0), a2, voffA);
            PG8_WAIT_V(8); PG8_WAIT_L(0); PG8_BAR; PG8_MMA(1, 0, At, B0); PG8_MMA(1, 1, At, B1); PG8_BAR; PG8_SCHED;
            PG8_LDB(B0, 1, 0); PG8_LDB(B1, 1, 1); PG8_SCHED; PG8_LDA(At, 1, 0); PG8_STAGE(PG8_SA(0, 1), a2 + hstep, voffA);
            PG8_WAIT_V(8); PG8_WAIT_L(0); PG8_BAR; PG8_MMA(0, 0, At, B0); PG8_MMA(0, 1, At, B1); PG8_BAR; PG8_SCHED;
            PG8_LDA(At, 1, 1); PG8_STAGE(PG8_SB(1, 0), b3, voffB); PG8_STAGE(PG8_SB(1, 1), b3 + hstep, voffB); PG8_STAGE(PG8_SA(1, 0), a3, voffA);
            PG8_WAIT_V(8); PG8_WAIT_L(0); PG8_BAR; PG8_MMA(1, 0, At, B0); PG8_MMA(1, 1, At, B1); PG8_BAR; PG8_SCHED;
            } else {
            PG8_LDB(B0, 0, 0); PG8_SCHED; PG8_LDA(At, 0, 0); PG8_STAGE(PG8_SA(1, 1), a1 + hstep, voffA);
            PG8_WAIT_L(8); PG8_BAR; PG8_WAIT_L(0); PG8_MMA(0, 0, At, B0); PG8_BAR; PG8_SCHED;
            PG8_LDB(B1, 0, 1); PG8_STAGE(PG8_SB(0, 0), b2, voffB);
            PG8_BAR; PG8_WAIT_L(0); PG8_MMA(0, 1, At, B1); PG8_BAR;
            PG8_LDA(At, 0, 1); PG8_STAGE(PG8_SA(0, 0), a2, voffA);
            PG8_BAR; PG8_WAIT_L(0); PG8_MMA(1, 0, At, B0); PG8_BAR; PG8_SCHED;
            PG8_STAGE(PG8_SB(0, 1), b2 + hstep, voffB);
            PG8_WAIT_V(6); PG8_BAR; PG8_MMA(1, 1, At, B1); PG8_BAR;
            PG8_LDB(B0, 1, 0); PG8_SCHED; PG8_LDA(At, 1, 0); PG8_STAGE(PG8_SA(0, 1), a2 + hstep, voffA);
            PG8_WAIT_L(8); PG8_BAR; PG8_WAIT_L(0); PG8_MMA(0, 0, At, B0); PG8_BAR; PG8_SCHED;
            PG8_LDB(B1, 1, 1); PG8_STAGE(PG8_SB(1, 0), b3, voffB);
            PG8_BAR; PG8_WAIT_L(0); PG8_MMA(0, 1, At, B1); PG8_BAR;
            PG8_LDA(At, 1, 1); PG8_STAGE(PG8_SA(1, 0), a3, voffA);
            PG8_BAR; PG8_WAIT_L(0); PG8_MMA(1, 0, At, B0); PG8_BAR; PG8_SCHED;
            PG8_STAGE(PG8_SB(1, 1), b3 + hstep, voffB);
            PG8_WAIT_V(6); PG8_BAR; PG8_MMA(1, 1, At, B1); PG8_BAR;
            }
        }
        if constexpr (ALIGN_EPI) { if (wr == 0) PG8_BAR; }
        if constexpr (!Epi::AFTER_DRAIN) { E(acc, cur, wr, wc, fr, fq); S.done(cur); }
        if (!has_next) break;
#pragma unroll
        for (int a = 0; a < 2; ++a)
#pragma unroll
            for (int b = 0; b < 2; ++b)
#pragma unroll
                for (int m = 0; m < 4; ++m)
#pragma unroll
                    for (int n = 0; n < 2; ++n) acc[a][b][m][n] = (f32x4){0.f, 0.f, 0.f, 0.f};
        cur = nxt; cA = nA; cB = nB; ++ui;
        if constexpr (ALIGN_EPI) { if (wr == 1) PG8_BAR; }
    }
    PG8_WAIT_V(0);
    if constexpr (!ALIGN_EPI) { if (wr == 0) PG8_BAR; }
    PG8_BAR;
    if constexpr (Epi::AFTER_DRAIN) { E.fused(acc, cur, wr, wc, fr, fq, lds, wid, lane); S.done(cur); }
#undef PG8_SA
#undef PG8_SB
#undef PG8_STAGE
#undef PG8_LDA
#undef PG8_LDB
#undef PG8_MMA
#undef PG8_WAIT_V
#undef PG8_WAIT_L
#undef PG8_BAR
#undef PG8_SCHED
}
}

#define LAS __attribute__((address_space(3)))
typedef unsigned short bf16_t;
typedef short bf16x8 __attribute__((ext_vector_type(8)));
typedef short s16x4 __attribute__((ext_vector_type(4)));
typedef float f32x4 __attribute__((ext_vector_type(4)));
typedef float f32x2 __attribute__((ext_vector_type(2)));
typedef unsigned u32x4 __attribute__((ext_vector_type(4)));
typedef unsigned u32x2 __attribute__((ext_vector_type(2)));

constexpr int NWAVES = 8, NTHR = 512;
constexpr int T = 32768, DM = 1024, SEQ = 4096, NB = 8;
constexpr int IN_DIM = 10272;
constexpr int NWIN_TILES = 41, NWIN = NWIN_TILES * 256;
constexpr float NORM_EPS = 1e-6f;
constexpr float QSCALE = 0.08838834764831845f;

constexpr size_t MiB = 1u << 20;
constexpr size_t WS_CTL = 0;
constexpr size_t WS_WIN = 1 * MiB;
constexpr size_t WIN_BYTES = (size_t)NWIN * 1024 * 2;
constexpr size_t WS_WA = 42 * MiB;
constexpr size_t WS_WB = 44 * MiB;
constexpr size_t WS_WO = 48 * MiB;
constexpr size_t WS_ROPEC = 52 * MiB, WS_ROPES = WS_ROPEC + 256 * 1024;
constexpr size_t WS_LSE = 53 * MiB;
constexpr size_t WS_LR = 55 * MiB;
constexpr size_t WS_ROWSS = 59 * MiB;
constexpr size_t WS_H = 62 * MiB;
constexpr size_t WS_X = 126 * MiB;
constexpr size_t X_QO = WS_X + 0 * MiB, X_KA = WS_X + 96 * MiB, X_VA = WS_X + 192 * MiB, X_ZA = WS_X + 288 * MiB;
constexpr size_t X_GQ = WS_X + 96 * MiB, X_GK = WS_X + 128 * MiB, X_GVL = WS_X + 160 * MiB, X_GVH = WS_X + 352 * MiB, X_BF = WS_X + 0 * MiB, X_BB = WS_X + 32 * MiB;
constexpr size_t X_OF = WS_X + 192 * MiB, X_OB = WS_X + 288 * MiB;
constexpr int OF_LD = 1536, OF_C0 = 512;
constexpr size_t X_ZB = WS_X + 0 * MiB, X_GA = WS_X + 64 * MiB, X_GB = WS_X + 128 * MiB, X_OUT = WS_X + 0 * MiB;
constexpr size_t WS_END = WS_X + 384 * MiB;

constexpr int LDS_BYTES = 147456;

__device__ __forceinline__ float bf2f(unsigned v) { return __uint_as_float(v << 16); }
__device__ __forceinline__ float bflo(unsigned w) { return __uint_as_float(w << 16); }
__device__ __forceinline__ float bfhi(unsigned w) { return __uint_as_float(w & 0xffff0000u); }
typedef __bf16 bf16x2_t __attribute__((ext_vector_type(2)));
__device__ __forceinline__ unsigned pk2(float lo, float hi) { f32x2 v = {lo, hi}; bf16x2_t b = __builtin_convertvector(v, bf16x2_t); return __builtin_bit_cast(unsigned, b); }
template <int M> __device__ __forceinline__ float xsum(float v) {
    if constexpr (M < 32) return v + __builtin_bit_cast(float, __builtin_amdgcn_ds_swizzle(__builtin_bit_cast(int, v), (M << 10) | 0x1F));
    else { const unsigned u = __builtin_bit_cast(unsigned, v); auto r = __builtin_amdgcn_permlane32_swap(u, u, false, false); return __builtin_bit_cast(float, r[0]) + __builtin_bit_cast(float, r[1]); }
}
template <int M> __device__ __forceinline__ float xmax(float v) {
    if constexpr (M < 32) return fmaxf(v, __builtin_bit_cast(float, __builtin_amdgcn_ds_swizzle(__builtin_bit_cast(int, v), (M << 10) | 0x1F)));
    else { const unsigned u = __builtin_bit_cast(unsigned, v); auto r = __builtin_amdgcn_permlane32_swap(u, u, false, false); return fmaxf(__builtin_bit_cast(float, r[0]), __builtin_bit_cast(float, r[1])); }
}
__device__ __forceinline__ float wave_sum(float v) { v += __shfl_xor(v, 1); v += __shfl_xor(v, 2); v += __shfl_xor(v, 4); v += __shfl_xor(v, 8); v += __shfl_xor(v, 16); v += __shfl_xor(v, 32); return v; }
__device__ __forceinline__ float sigmoidf_(float x) { return __builtin_amdgcn_rcpf(1.0f + __builtin_amdgcn_exp2f(-1.4426950408889634f * x)); }
__device__ __forceinline__ float siluf_(float x) { return x * sigmoidf_(x); }

struct EpiProj {
    static constexpr bool PERM = true, AFTER_DRAIN = false; static constexpr int MIDT = 0;
    int tau0; unsigned char* ws; const float* ropec; const float* ropes;
    __device__ __forceinline__ void operator()(const f32x4 (&acc)[2][2][4][2], const pg8::Unit& u, int wr, int wc, int fr, int fq) const {
        const int tau = tau0 + u.pn;
        int mode = 0, ldc = 512, colt = 0, dsh = 0; bf16_t* base = nullptr;
        if (tau < 18) { const int g = tau / 6, t = (tau % 6) >> 1, half = tau & 1; colt = half * 256; dsh = 2 * g;
                        base = (bf16_t*)(ws + (t == 0 ? X_QO : (t == 1 ? X_KA : X_VA)) + (size_t)g * 32 * MiB); mode = t < 2 ? 3 : 0; }
        else if (tau < 20) { base = (bf16_t*)(ws + X_ZA); colt = (tau - 18) * 256; }
        else if (tau < 22) { base = (bf16_t*)(ws + X_GQ); colt = (tau - 20) * 256; }
        else if (tau < 24) { base = (bf16_t*)(ws + X_GK); colt = (tau - 22) * 256; }
        else if (tau < 28) { base = (bf16_t*)(ws + (tau < 26 ? X_GVL : X_GVH)); colt = ((tau - 24) & 1) * 256; }
        else if (tau == 28) { mode = 4; }
        else if (tau < 33) { base = (bf16_t*)(ws + X_ZB); ldc = 1024; colt = (tau - 29) * 256; }
        else { mode = 5; }
        const int row0 = u.pm * 256 + wr * 64 + fr;
        if (mode == 5) {
            bf16_t* Rb = (bf16_t*)(ws + X_GA); bf16_t* Gb = (bf16_t*)(ws + X_GB); const int tix = ((wr * 4 + wc) * 4 + fq) * 16 + fr;
#pragma unroll
            for (int ai = 0; ai < 2; ++ai)
#pragma unroll
                for (int m = 0; m < 4; ++m) { const size_t off = ((((size_t)u.pm * 8 + (tau - 33)) * 8 + (ai * 4 + m)) * 512 + tix) * 8;
                    float r[8], g[8];
#pragma unroll
                    for (int j = 0; j < 8; ++j) { const float av = acc[ai][0][m][j >> 2][j & 3], bv = acc[ai][1][m][j >> 2][j & 3];
                        const float ea = __builtin_amdgcn_exp2f(-1.4426950408889634f * av), eb = fminf(__builtin_amdgcn_exp2f(-1.4426950408889634f * bv), 1e30f);
                        r[j] = (1.0f + eb) * __builtin_amdgcn_rcpf(1.0f + ea); g[j] = __builtin_amdgcn_rcpf(1.0f + eb); }
                    u32x4 wr_, wg_; wr_.x = pk2(r[0], r[1]); wr_.y = pk2(r[2], r[3]); wr_.z = pk2(r[4], r[5]); wr_.w = pk2(r[6], r[7]);
                    wg_.x = pk2(g[0], g[1]); wg_.y = pk2(g[2], g[3]); wg_.z = pk2(g[4], g[5]); wg_.w = pk2(g[6], g[7]);
                    __builtin_nontemporal_store(wr_, (u32x4*)(Rb + off)); __builtin_nontemporal_store(wg_, (u32x4*)(Gb + off)); }
            return;
        }
        if (mode == 4) {
            if (wc == 0) { float* LR = (float*)(ws + WS_LR);
#pragma unroll
                for (int ai = 0; ai < 2; ++ai)
#pragma unroll
                    for (int m = 0; m < 4; ++m) { float* rp = LR + (size_t)(row0 + ai * 128 + m * 16) * 32 + 8 * fq;
                        *(f32x4*)(rp) = acc[ai][0][m][0]; *(f32x4*)(rp + 4) = acc[ai][0][m][1]; } }
            return;
        }
        const int col0 = colt + wc * 32 + 8 * fq;
#pragma unroll
        for (int ai = 0; ai < 2; ++ai) {
            f32x4 csv[4], snv[4];
            if (mode == 3 && wc == 0) {
#pragma unroll
                for (int m = 0; m < 4; ++m) { const float pos = (float)((row0 + ai * 128 + m * 16) & (SEQ - 1));
#pragma unroll
                    for (int j = 0; j < 4; ++j) { const float invr = __builtin_amdgcn_exp2f(-(float)(4 * fq + j) * (18.931568569324174f / 16.0f)) * 0.15915494309189535f;
                        const float xr = __builtin_amdgcn_fractf(pos * invr); csv[m][j] = __builtin_amdgcn_cosf(xr); snv[m][j] = __builtin_amdgcn_sinf(xr); } } }
#pragma unroll
            for (int m = 0; m < 4; ++m) { const int row = row0 + ai * 128 + m * 16;
                const int srow = (row & ~(SEQ - 1)) | (((row & ((1 << dsh) - 1)) << (12 - dsh)) | ((row & (SEQ - 1)) >> dsh));
                bf16_t* rowp = base + (size_t)srow * ldc + col0;
                const f32x4 cs = csv[m], sn = snv[m];
#pragma unroll
                for (int bj = 0; bj < 2; ++bj) { f32x4 v0 = acc[ai][bj][m][0], v1 = acc[ai][bj][m][1];
                    if (mode == 1) {
#pragma unroll
                        for (int j = 0; j < 4; ++j) { v0[j] = v0[j] * sigmoidf_(v0[j]); v1[j] = v1[j] * sigmoidf_(v1[j]); } }
                    else if (mode == 2) {
#pragma unroll
                        for (int j = 0; j < 4; ++j) { v0[j] = sigmoidf_(v0[j]); v1[j] = sigmoidf_(v1[j]); } }
                    else if (mode == 3 && wc == 0) {
                        f32x4 a = v0, b = v1;
                        v0[0] = a[0] * cs[0] - a[1] * sn[0]; v0[1] = a[1] * cs[0] + a[0] * sn[0]; v0[2] = a[2] * cs[1] - a[3] * sn[1]; v0[3] = a[3] * cs[1] + a[2] * sn[1];
                        v1[0] = b[0] * cs[2] - b[1] * sn[2]; v1[1] = b[1] * cs[2] + b[0] * sn[2]; v1[2] = b[2] * cs[3] - b[3] * sn[3]; v1[3] = b[3] * cs[3] + b[2] * sn[3]; }
                    u32x4 w; w.x = pk2(v0[0], v0[1]); w.y = pk2(v0[2], v0[3]); w.z = pk2(v1[0], v1[1]); w.w = pk2(v1[2], v1[3]);
                    __builtin_nontemporal_store(w, (u32x4*)(rowp + bj * 128)); } } }
    }
};
struct EpiMerge {
    static constexpr bool PERM = true, AFTER_DRAIN = false; static constexpr int MIDT = 8;
    const bf16_t* GA; const bf16_t* GB; bf16_t* O;
    __device__ __forceinline__ void mid(f32x4 (&acc)[2][2][4][2], const pg8::Unit& u, int wr, int wc, int fr, int fq) const {
        int row0 = u.pm * 256 + wr * 64 + fr; const int col0 = u.pn * 256 + wc * 32 + 8 * fq; int tix = ((wr * 4 + wc) * 4 + fq) * 16 + fr;
#pragma unroll
        for (int ai = 0; ai < 2; ++ai) {
            asm volatile("" : "+v"(row0), "+v"(tix));
            u32x4 g[4][2];
#pragma unroll
            for (int m = 0; m < 4; ++m)
#pragma unroll
                for (int bj = 0; bj < 2; ++bj) g[m][bj] = *(const u32x4*)((const unsigned char*)GA + (unsigned)((((u.pm * 8 + (2 * u.pn + bj)) * 8 + (ai * 4 + m)) * 512 + tix) * 16));
#pragma unroll
            for (int m = 0; m < 4; ++m)
#pragma unroll
                for (int bj = 0; bj < 2; ++bj) { const u32x4 a = g[m][bj]; f32x4& v0 = acc[ai][bj][m][0]; f32x4& v1 = acc[ai][bj][m][1];
                    v0[0] *= bflo(a.x); v0[1] *= bfhi(a.x); v0[2] *= bflo(a.y); v0[3] *= bfhi(a.y); v1[0] *= bflo(a.z); v1[1] *= bfhi(a.z); v1[2] *= bflo(a.w); v1[3] *= bfhi(a.w); }
            asm volatile("" ::: "memory"); }
    }
    __device__ __forceinline__ void operator()(const f32x4 (&acc)[2][2][4][2], const pg8::Unit& u, int wr, int wc, int fr, int fq) const {
        int row0 = u.pm * 256 + wr * 64 + fr; const int col0 = u.pn * 256 + wc * 32 + 8 * fq; int tix = ((wr * 4 + wc) * 4 + fq) * 16 + fr;
#pragma unroll
        for (int ai = 0; ai < 2; ++ai) {
            asm volatile("" : "+v"(row0), "+v"(tix));
            u32x4 g[4][2];
#pragma unroll
            for (int m = 0; m < 4; ++m)
#pragma unroll
                for (int bj = 0; bj < 2; ++bj) g[m][bj] = *(const u32x4*)((const unsigned char*)GB + (unsigned)((((u.pm * 8 + (2 * u.pn + bj)) * 8 + (ai * 4 + m)) * 512 + tix) * 16));
#pragma unroll
            for (int m = 0; m < 4; ++m) { const size_t off = (size_t)(row0 + ai * 128 + m * 16) * 1024 + col0;
#pragma unroll
                for (int bj = 0; bj < 2; ++bj) { const u32x4 gg = g[m][bj]; const f32x4 v0 = acc[ai][bj][m][0], v1 = acc[ai][bj][m][1];
                    u32x4 w; w.x = pk2(v0[0] * bflo(gg.x), v0[1] * bfhi(gg.x)); w.y = pk2(v0[2] * bflo(gg.y), v0[3] * bfhi(gg.y)); w.z = pk2(v1[0] * bflo(gg.z), v1[1] * bfhi(gg.z)); w.w = pk2(v1[2] * bflo(gg.w), v1[3] * bfhi(gg.w));
                    *(u32x4*)(O + off + bj * 128) = w; } }
            asm volatile("" ::: "memory"); }
    }
};
struct EpiOut {
    static constexpr bool PERM = true, AFTER_DRAIN = false; static constexpr int MIDT = 0;
    bf16_t* O; float* rowss;
    __device__ __forceinline__ void operator()(const f32x4 (&acc)[2][2][4][2], const pg8::Unit& u, int wr, int wc, int fr, int fq) const {
        const int row0 = u.pm * 256 + wr * 64 + fr, col0 = u.pn * 256 + wc * 32 + 8 * fq;
#pragma unroll
        for (int ai = 0; ai < 2; ++ai)
#pragma unroll
            for (int m = 0; m < 4; ++m) { const int row = row0 + ai * 128 + m * 16; const size_t off = (size_t)row * 1024 + col0; float s = 0.f;
#pragma unroll
                for (int bj = 0; bj < 2; ++bj) { const f32x4 v0 = acc[ai][bj][m][0], v1 = acc[ai][bj][m][1];
                    s += (v0[0] * v0[0] + v0[1] * v0[1]) + (v0[2] * v0[2] + v0[3] * v0[3]) + (v1[0] * v1[0] + v1[1] * v1[1]) + (v1[2] * v1[2] + v1[3] * v1[3]);
                    u32x4 w; w.x = pk2(v0[0], v0[1]); w.y = pk2(v0[2], v0[3]); w.z = pk2(v1[0], v1[1]); w.w = pk2(v1[2], v1[3]);
                    *(u32x4*)(O + off + bj * 128) = w; }
                s += __shfl_xor(s, 16); s += __shfl_xor(s, 32);
                if (fq == 0) rowss[(size_t)row * 16 + u.pn * 4 + wc] = s; }
    }
};

struct Args { const float* in[12]; float* out; unsigned char* ws; int ph_lo, ph_hi; };

struct Frame { LAS unsigned char* lds; int tid, lane, wave, G, bid; };

__device__ __forceinline__ int win_src(int np, float& sc) {
    sc = 1.f; const int tau = np >> 8, c = np & 255;
    if (tau < 18) { const int g = np / 1536, rem = np % 1536, t = rem / 512, hc = rem % 512, h = hc >> 7, d = hc & 127;
        int ds = d; if (t < 2 && d < 32) ds = (d & 1) ? 16 + (d >> 1) : (d >> 1);
        if (t == 0) sc = QSCALE;
        return g * 1536 + t * 512 + h * 128 + ds; }
    if (tau < 20) return 4608 + (np - 18 * 256);
    if (tau < 22) { sc = QSCALE; return 5120 + (np - 20 * 256); }
    if (tau < 24) return 5632 + (np - 22 * 256);
    if (tau < 28) return 6144 + (np - 24 * 256);
    if (tau == 28) return c < 32 ? 10240 + c : -1;
    if (tau < 33) return 7168 + (np - 29 * 256);
    { const int i = tau - 33; return c < 128 ? 8192 + 128 * i + c : 9216 + 128 * i + (c - 128); }
}
template <bool IS_WIN> __device__ __forceinline__ void transpose_item(const float* W, int K, int Nsrc, int Ndst, bf16_t* WT, LAS float* scr, int item, int lane, int ldd = 0, int koff = 0) {
    if (ldd == 0) ldd = K;
    const int nblk = Ndst / 32, kb = item / nblk, nb = item % nblk, k0 = 64 * kb, n0 = 32 * nb;
    const int np = n0 + (lane & 31); float sc = 1.f; int src = np; if (IS_WIN) src = win_src(np, sc);
#pragma unroll 8
    for (int i = 0; i < 32; ++i) { const int kk = 2 * i + (lane >> 5); float v = 0.f; if (src >= 0) v = W[(size_t)(k0 + kk) * Nsrc + src] * sc; scr[kk * 33 + (lane & 31)] = v; }
    asm volatile("s_waitcnt lgkmcnt(0)" ::: "memory");
    const int c = lane & 7;
#pragma unroll
    for (int j = 0; j < 4; ++j) { const int n = (lane >> 3) + 8 * j; const LAS float* s = scr + (8 * c) * 33 + n;
        u32x4 o; o.x = pk2(s[0 * 33], s[1 * 33]); o.y = pk2(s[2 * 33], s[3 * 33]); o.z = pk2(s[4 * 33], s[5 * 33]); o.w = pk2(s[6 * 33], s[7 * 33]);
        *(u32x4*)(WT + (size_t)(n0 + n) * ldd + koff + k0 + 8 * c) = o; }
    asm volatile("s_waitcnt lgkmcnt(0)" ::: "memory");
}
__device__ __forceinline__ void phase_prologue(const Frame& F, const Args& a) {
    LAS float* scr = (LAS float*)(F.lds + F.wave * 16384);
    const int gw = F.bid * NWAVES + F.wave, NGW = F.G * NWAVES;
    constexpr int I_WIN = 16 * (NWIN / 32), I_WA = 8 * 32, I_WB = 16 * 32, I_WO = 16 * 32, I_L = I_WIN + I_WA + I_WB + I_WO;
    for (int it = gw; it < 2 * I_L; it += NGW) {
        const int l = it / I_L; int r = it % I_L;
        if (r < I_WIN) { transpose_item<true>(a.in[2] + (size_t)l * 1024 * IN_DIM, 1024, IN_DIM, NWIN, (bf16_t*)(a.ws + WS_WIN + l * WIN_BYTES), scr, r, F.lane); continue; } r -= I_WIN;
        if (r < I_WA) { transpose_item<false>(a.in[8] + (size_t)l * 512 * 1024, 512, 1024, 1024, (bf16_t*)(a.ws + WS_WA + l * 3 * MiB), scr, r, F.lane, 1536, 0); continue; } r -= I_WA;
        if (r < I_WB) { transpose_item<false>(a.in[9] + (size_t)l * 1024 * 1024, 1024, 1024, 1024, (bf16_t*)(a.ws + WS_WA + l * 3 * MiB), scr, r, F.lane, 1536, 512); continue; } r -= I_WB;
        transpose_item<false>(a.in[10] + (size_t)l * 1024 * 1024, 1024, 1024, 1024, (bf16_t*)(a.ws + WS_WO + l * 2 * MiB), scr, r, F.lane);
    }
    float* rc = (float*)(a.ws + WS_ROPEC); float* rs = (float*)(a.ws + WS_ROPES);
    for (int e = F.bid * NTHR + F.tid; e < SEQ * 16; e += F.G * NTHR) { const int pos = e >> 4, i = e & 15;
        const float inv = (float)pow(500000.0, -(double)(2 * i) / 32.0); const float ang = (float)pos * inv;
        rc[e] = (float)cos((double)ang); rs[e] = (float)sin((double)ang); }
}

__device__ __forceinline__ void phase_prep(const Frame& F, const Args& a, int mode, const float* xprev, float* xout, const float* wpost, const float* wpre) {
    const int gw = F.bid * NWAVES + F.wave, NGW = F.G * NWAVES;
    const bf16_t* OUT = (const bf16_t*)(a.ws + X_OUT); const float* rowss = (const float*)(a.ws + WS_ROWSS); bf16_t* H = (bf16_t*)(a.ws + WS_H);
    f32x4 wpo[4], wpr[4];
#pragma unroll
    for (int j = 0; j < 4; ++j) { wpo[j] = (mode != 0) ? *((const f32x4*)wpost + F.lane + 64 * j) : (f32x4){0.f, 0.f, 0.f, 0.f}; wpr[j] = (mode != 2) ? *((const f32x4*)wpre + F.lane + 64 * j) : (f32x4){0.f, 0.f, 0.f, 0.f}; }
    for (int row0 = gw; row0 < T; row0 += 2 * NGW) {
        f32x4 v[2][4]; u32x2 ov[2][4]; float ssv[2];
#pragma unroll
        for (int rr = 0; rr < 2; ++rr) { const int row = row0 + rr * NGW; const f32x4* xr = (const f32x4*)(xprev + (size_t)row * DM) + F.lane;
#pragma unroll
            for (int j = 0; j < 4; ++j) v[rr][j] = __builtin_nontemporal_load(xr + 64 * j);
            if (mode != 0) { ssv[rr] = rowss[(size_t)row * 16 + (F.lane & 15)]; const u32x2* orow = (const u32x2*)(OUT + (size_t)row * DM) + F.lane;
#pragma unroll
                for (int j = 0; j < 4; ++j) ov[rr][j] = __builtin_nontemporal_load(orow + 64 * j); } }
#pragma unroll
        for (int rr = 0; rr < 2; ++rr) { const int row = row0 + rr * NGW;
            if (mode != 0) {
                float ss = ssv[rr];
                ss += __shfl_xor(ss, 1); ss += __shfl_xor(ss, 2); ss += __shfl_xor(ss, 4); ss += __shfl_xor(ss, 8);
                const float rstd = __builtin_amdgcn_rsqf(ss * (1.0f / DM) + NORM_EPS);
#pragma unroll
                for (int j = 0; j < 4; ++j) { const u32x2 o = ov[rr][j]; const f32x4 w = wpo[j];
                    v[rr][j][0] += bflo(o.x) * rstd * w[0]; v[rr][j][1] += bfhi(o.x) * rstd * w[1]; v[rr][j][2] += bflo(o.y) * rstd * w[2]; v[rr][j][3] += bfhi(o.y) * rstd * w[3]; }
                f32x4* xo = (f32x4*)(xout + (size_t)row * DM) + F.lane;
#pragma unroll
                for (int j = 0; j < 4; ++j) __builtin_nontemporal_store(v[rr][j], xo + 64 * j);
            }
            if (mode != 2) {
                float s = 0.f;
#pragma unroll
                for (int j = 0; j < 4; ++j) s += (v[rr][j][0] * v[rr][j][0] + v[rr][j][1] * v[rr][j][1]) + (v[rr][j][2] * v[rr][j][2] + v[rr][j][3] * v[rr][j][3]);
                const float rstd = __builtin_amdgcn_rsqf(wave_sum(s) * (1.0f / DM) + NORM_EPS);
                u32x2* ho = (u32x2*)(H + (size_t)row * DM) + F.lane;
#pragma unroll
                for (int j = 0; j < 4; ++j) { const f32x4 w = wpr[j]; u32x2 o;
                    o.x = pk2(v[rr][j][0] * rstd * w[0], v[rr][j][1] * rstd * w[1]); o.y = pk2(v[rr][j][2] * rstd * w[2], v[rr][j][3] * rstd * w[3]); ho[64 * j] = o; }
            }
        }
    }
}

#define LDS_BARRIER() do { asm volatile("s_waitcnt lgkmcnt(0)" ::: "memory"); __builtin_amdgcn_s_barrier(); asm volatile("" ::: "memory"); } while (0)
constexpr int GP_Q = 0, GP_K = 65536, GP_LR = 131072;
__device__ __forceinline__ void phase_gla_pre(const Frame& F, const Args& a, int layer) {
    const int tid = F.tid, dir = tid >> 8, c2 = (tid & 255) * 2;
    LAS unsigned char* lds = F.lds;
    const float* LR = (const float*)(a.ws + WS_LR);
    bf16_t* GQ = (bf16_t*)(a.ws + X_GQ); bf16_t* GK = (bf16_t*)(a.ws + X_GK);
    bf16_t* QDo = dir ? GQ : (bf16_t*)(a.ws + X_BF); bf16_t* KIo = dir ? GK : (bf16_t*)(a.ws + X_BB);
    float* DEC = (float*)(a.ws + WS_ROWSS);
    const float* Wup = (dir ? a.in[5] : a.in[3]) + (size_t)layer * 16 * 512; const float* bias = (dir ? a.in[6] : a.in[4]) + (size_t)layer * 512;
    f32x2 w[16];
#pragma unroll
    for (int i = 0; i < 16; ++i) w[i] = *(const f32x2*)(Wup + i * 512 + c2);
    const f32x2 bz = *(const f32x2*)(bias + c2);
    for (int item = F.bid; item < NB * 64; item += F.G) {
        const size_t tok0 = (size_t)item * 64;
        __syncthreads();
#pragma unroll
        for (int i = 0; i < 8; ++i) { const int c = tid + 512 * i, r = c >> 6, ch = c & 63;
            *(LAS u32x4*)(lds + GP_Q + r * 1024 + ch * 16) = __builtin_nontemporal_load((const u32x4*)(GQ + (tok0 + r) * 512 + ch * 8));
            *(LAS u32x4*)(lds + GP_K + r * 1024 + ch * 16) = __builtin_nontemporal_load((const u32x4*)(GK + (tok0 + r) * 512 + ch * 8)); }
        *(LAS f32x4*)(lds + GP_LR + 16 * tid) = *(const f32x4*)(LR + tok0 * 32 + 4 * tid);
        __syncthreads();
        f32x2 accum = {0.f, 0.f};
#pragma unroll 4
        for (int s0 = 0; s0 < 64; ++s0) { const int t = dir ? 63 - s0 : s0;
            const LAS f32x4* lr4 = (const LAS f32x4*)(lds + GP_LR + t * 128 + dir * 64);
            f32x2 xa = bz, xb = {0.f, 0.f}, xc = {0.f, 0.f}, xd = {0.f, 0.f};
            { const f32x4 l0 = lr4[0], l1 = lr4[1], l2 = lr4[2], l3 = lr4[3];
              xa += w[0] * l0[0]; xb += w[4] * l1[0]; xc += w[8] * l2[0]; xd += w[12] * l3[0];
              xa += w[1] * l0[1]; xb += w[5] * l1[1]; xc += w[9] * l2[1]; xd += w[13] * l3[1];
              xa += w[2] * l0[2]; xb += w[6] * l1[2]; xc += w[10] * l2[2]; xd += w[14] * l3[2];
              xa += w[3] * l0[3]; xb += w[7] * l1[3]; xc += w[11] * l2[3]; xd += w[15] * l3[3]; }
            const f32x2 x = (xa + xb) + (xc + xd);
            const float ls0 = fminf(x[0], 0.f) - 0.6931471805599453f * __builtin_amdgcn_logf(1.0f + __builtin_amdgcn_exp2f(-1.4426950408889634f * fabsf(x[0])));
            const float ls1 = fminf(x[1], 0.f) - 0.6931471805599453f * __builtin_amdgcn_logf(1.0f + __builtin_amdgcn_exp2f(-1.4426950408889634f * fabsf(x[1])));
            accum[0] += ls0 * (1.0f / 16.0f); accum[1] += ls1 * (1.0f / 16.0f);
            const float e0 = __builtin_amdgcn_exp2f(1.4426950408889634f * accum[0]), e1 = __builtin_amdgcn_exp2f(1.4426950408889634f * accum[1]);
            const float i0 = __builtin_amdgcn_rcpf(e0), i1 = __builtin_amdgcn_rcpf(e1);
            const unsigned qw = *(const LAS unsigned*)(lds + GP_Q + t * 1024 + c2 * 2), kw = *(const LAS unsigned*)(lds + GP_K + t * 1024 + c2 * 2);
            *(unsigned*)(QDo + (tok0 + t) * 512 + c2) = pk2(bflo(qw) * e0, bfhi(qw) * e1);
            *(unsigned*)(KIo + (tok0 + t) * 512 + c2) = pk2(bflo(kw) * i0, bfhi(kw) * i1);
        }
        *(f32x2*)(DEC + ((size_t)dir * NB * 64 + item) * 512 + c2) = (f32x2){__builtin_amdgcn_exp2f(1.4426950408889634f * accum[0]), __builtin_amdgcn_exp2f(1.4426950408889634f * accum[1])};
    }
}

constexpr int GS_STR = 272, GS_KSTR = 288, GS_VSTR = 160;
constexpr int GS_QD = 0, GS_KI = 64 * GS_STR, GS_V = GS_KI + 64 * GS_KSTR, GS_DEC = GS_V + 64 * GS_VSTR, GS_BUF = GS_DEC + 512;
constexpr int GS_ST = 2 * GS_BUF, GS_STB = 64 * GS_STR;
__device__ __forceinline__ s16x4 trread(const LAS unsigned char* p) { return __builtin_bit_cast(s16x4, __builtin_amdgcn_ds_read_tr16_b64_v4i16((LAS s16x4*)p)); }
__device__ __forceinline__ bf16x8 cat8(s16x4 lo, s16x4 hi) { return (bf16x8){lo[0], lo[1], lo[2], lo[3], hi[0], hi[1], hi[2], hi[3]}; }
__device__ __forceinline__ bf16x8 pack8(const f32x4& a, const f32x4& b) { u32x4 w; w.x = pk2(a[0], a[1]); w.y = pk2(a[2], a[3]); w.z = pk2(b[0], b[1]); w.w = pk2(b[2], b[3]); return __builtin_bit_cast(bf16x8, w); }

#define GS_LANE_VARS() const int lane = lane0, fr = lane & 15, fq = lane >> 4; (void)fr; (void)fq
#define GS_LOAD_CHUNK(ch) do { const int ch_ = (ch); const unsigned char* q_ = qdb + (size_t)ch_ * 65536 + lqk; const unsigned char* k_ = kib + (size_t)ch_ * 65536 + lqk; const unsigned char* v_ = gvb + (size_t)ch_ * 65536 + lv; \
        pq[0] = *(const u32x4*)(q_); pq[1] = *(const u32x4*)(q_ + 128); pq[2] = *(const u32x4*)(q_ + 8192); pq[3] = *(const u32x4*)(q_ + 8192 + 128); \
        pk[0] = *(const u32x4*)(k_); pk[1] = *(const u32x4*)(k_ + 128); pk[2] = *(const u32x4*)(k_ + 8192); pk[3] = *(const u32x4*)(k_ + 8192 + 128); \
        pv[0] = __builtin_nontemporal_load((const u32x4*)(v_)); pv[1] = __builtin_nontemporal_load((const u32x4*)(v_ + 8192)); \
        if (lane < 32) pdec = *(const float*)(decb + (size_t)ch_ * 2048 + (32 * sw + lane) * 4); } while (0)
#define GS_STAGE(bufi) do { LAS unsigned char* nl_ = F.lds + (bufi) * GS_BUF; LAS unsigned char* p_ = nl_ + GS_QD + ra * GS_STR + ci; LAS unsigned char* k2_ = nl_ + GS_KI + ra * GS_KSTR + ci; LAS unsigned char* v2_ = nl_ + GS_V + ra * GS_VSTR + ci; \
        *(LAS u32x4*)(p_) = pq[0]; *(LAS u32x4*)(p_ + 128) = pq[1]; *(LAS u32x4*)(p_ + 8 * GS_STR) = pq[2]; *(LAS u32x4*)(p_ + 8 * GS_STR + 128) = pq[3]; \
        *(LAS u32x4*)(k2_) = pk[0]; *(LAS u32x4*)(k2_ + 128) = pk[1]; *(LAS u32x4*)(k2_ + 8 * GS_KSTR) = pk[2]; *(LAS u32x4*)(k2_ + 8 * GS_KSTR + 128) = pk[3]; \
        *(LAS u32x4*)(v2_) = pv[0]; *(LAS u32x4*)(v2_ + 8 * GS_VSTR) = pv[1]; if (lane < 32) *(LAS float*)(nl_ + GS_DEC + (32 * sw + lane) * 4) = pdec; } while (0)
#define GS_STAGE_VARS() const int ra = 16 * sw + (lane >> 3), ci = (lane & 7) * 16; const unsigned lqk = (unsigned)(ra * 1024 + ci), lv = lqk

__device__ __forceinline__ void phase_gla_scan(const Frame& F, const Args& a) {
    const int lane0 = F.lane, wid = F.wave;
    for (int u = F.bid; u < 256; u += F.G) {
        const int slot = u >> 3, dvq = slot & 3, grp = (u & 7) * 8 + (slot >> 2), dir = grp & 1, h = (grp >> 1) & 3, b = grp >> 3;
        const unsigned char* qdb = a.ws + (dir ? X_GQ : X_BF) + ((size_t)b * SEQ * 512 + h * 128) * 2; const unsigned char* kib = a.ws + (dir ? X_GK : X_BB) + ((size_t)b * SEQ * 512 + h * 128) * 2;
        const unsigned char* gvb = a.ws + (h < 2 ? X_GVL : X_GVH) + ((size_t)b * SEQ * 512 + (h & 1) * 256 + dvq * 64) * 2;
        const unsigned char* decb = a.ws + WS_ROWSS + (((size_t)dir * NB * 64 + (size_t)b * 64) * 512 + h * 128) * 4;
        const int OLD = dir ? 1024 : OF_LD;
        unsigned char* ob = a.ws + (dir ? X_OB : X_OF) + ((size_t)b * SEQ * OLD + (dir ? 0 : OF_C0) + h * 256 + dvq * 64) * 2;
        __syncthreads();
        {   GS_LANE_VARS(); const int tid = wid * 64 + lane;
            LAS unsigned char* p = F.lds + GS_ST + (tid >> 3) * GS_STR + (tid & 7) * 16; *(LAS u32x4*)p = (u32x4){0u, 0u, 0u, 0u}; *(LAS u32x4*)(p + 128) = (u32x4){0u, 0u, 0u, 0u}; }
        if (wid < 4) {
            const int cb = wid;
            const int sA = dir ? 1 : 0, sB = 1 - sA;
            const bool both = dir ? (cb <= 1) : (cb >= 2);
            float mk[2][4];
            {   GS_LANE_VARS(); const int sD = both ? sB : sA, c = 16 * cb + fr;
#pragma unroll
                for (int jj = 0; jj < 2; ++jj)
#pragma unroll
                    for (int r = 0; r < 4; ++r) { const int j = 32 * sD + 16 * jj + 4 * fq + r; mk[jj][r] = (dir ? (j > c) : (j <= c)) ? 1.f : 0.f; } }
            u32x2 ow[4] = {{0u, 0u}, {0u, 0u}, {0u, 0u}, {0u, 0u}}; unsigned char* oc = ob;
            __syncthreads();
            for (int step = 0; step < 64; ++step) {
                GS_LANE_VARS();
                const int chunk = dir ? 63 - step : step;
                const LAS unsigned char* lds = F.lds + (step & 1) * GS_BUF;
                const LAS unsigned char* stR = F.lds + GS_ST + (step & 1) * GS_STB;
                bf16x8 qb[4], stf[4][4], kaA[2][4], kaB[2][4], viA[4], viB[4];
#pragma unroll
                for (int ks = 0; ks < 4; ++ks) qb[ks] = *(const LAS bf16x8*)(lds + GS_QD + (16 * cb + fr) * GS_STR + (32 * ks + 8 * fq) * 2);
#pragma unroll
                for (int jj = 0; jj < 2; ++jj)
#pragma unroll
                    for (int ks = 0; ks < 4; ++ks) kaA[jj][ks] = *(const LAS bf16x8*)(lds + GS_KI + (32 * sA + 16 * jj + fr) * GS_KSTR + (32 * ks + 8 * fq) * 2);
                if (both) {
#pragma unroll
                    for (int jj = 0; jj < 2; ++jj)
#pragma unroll
                        for (int ks = 0; ks < 4; ++ks) kaB[jj][ks] = *(const LAS bf16x8*)(lds + GS_KI + (32 * sB + 16 * jj + fr) * GS_KSTR + (32 * ks + 8 * fq) * 2);
                }
#pragma unroll
                for (int t = 0; t < 4; ++t)
#pragma unroll
                    for (int ks = 0; ks < 4; ++ks) stf[t][ks] = *(const LAS bf16x8*)(stR + (16 * t + fr) * GS_STR + (32 * ks + 8 * fq) * 2);
                const LAS unsigned char* vb = lds + GS_V + (4 * fq + (fr >> 2)) * GS_VSTR + (4 * (fr & 3)) * 2;
#pragma unroll
                for (int t = 0; t < 4; ++t) viA[t] = cat8(trread(vb + (32 * sA) * GS_VSTR + 32 * t), trread(vb + (32 * sA + 16) * GS_VSTR + 32 * t));
                if (both) {
#pragma unroll
                    for (int t = 0; t < 4; ++t) viB[t] = cat8(trread(vb + (32 * sB) * GS_VSTR + 32 * t), trread(vb + (32 * sB + 16) * GS_VSTR + 32 * t));
                }
                if (step > 0) { const unsigned lo = (unsigned)((16 * cb + fr) * OLD + 4 * fq) * 2u;
#pragma unroll
                    for (int t = 0; t < 4; ++t) __builtin_nontemporal_store(ow[t], (u32x2*)(oc + lo + 32 * t)); }
                f32x4 atA[2] = {(f32x4){0.f, 0.f, 0.f, 0.f}, (f32x4){0.f, 0.f, 0.f, 0.f}}, atB[2] = {(f32x4){0.f, 0.f, 0.f, 0.f}, (f32x4){0.f, 0.f, 0.f, 0.f}};
#pragma unroll
                for (int ks = 0; ks < 4; ++ks)
#pragma unroll
                    for (int jj = 0; jj < 2; ++jj) atA[jj] = __builtin_amdgcn_mfma_f32_16x16x32_bf16(kaA[jj][ks], qb[ks], atA[jj], 0, 0, 0);
                if (both) {
#pragma unroll
                    for (int ks = 0; ks < 4; ++ks)
#pragma unroll
                        for (int jj = 0; jj < 2; ++jj) atB[jj] = __builtin_amdgcn_mfma_f32_16x16x32_bf16(kaB[jj][ks], qb[ks], atB[jj], 0, 0, 0);
                }
                f32x4 oT[4];
#pragma unroll
                for (int t = 0; t < 4; ++t) oT[t] = (f32x4){0.f, 0.f, 0.f, 0.f};
#pragma unroll
                for (int ks = 0; ks < 4; ++ks)
#pragma unroll
                    for (int t = 0; t < 4; ++t) oT[t] = __builtin_amdgcn_mfma_f32_16x16x32_bf16(stf[t][ks], qb[ks], oT[t], 0, 0, 0);
                if (both) {
#pragma unroll
                    for (int jj = 0; jj < 2; ++jj)
#pragma unroll
                        for (int r = 0; r < 4; ++r) atB[jj][r] *= mk[jj][r];
                    const bf16x8 pfA = pack8(atA[0], atA[1]), pfB = pack8(atB[0], atB[1]);
#pragma unroll
                    for (int t = 0; t < 4; ++t) oT[t] = __builtin_amdgcn_mfma_f32_16x16x32_bf16(viA[t], pfA, oT[t], 0, 0, 0);
#pragma unroll
                    for (int t = 0; t < 4; ++t) oT[t] = __builtin_amdgcn_mfma_f32_16x16x32_bf16(viB[t], pfB, oT[t], 0, 0, 0);
                } else {
#pragma unroll
                    for (int jj = 0; jj < 2; ++jj)
#pragma unroll
                        for (int r = 0; r < 4; ++r) atA[jj][r] *= mk[jj][r];
                    const bf16x8 pfA = pack8(atA[0], atA[1]);
#pragma unroll
                    for (int t = 0; t < 4; ++t) oT[t] = __builtin_amdgcn_mfma_f32_16x16x32_bf16(viA[t], pfA, oT[t], 0, 0, 0);
                }
#pragma unroll
                for (int t = 0; t < 4; ++t) { ow[t].x = pk2(oT[t][0], oT[t][1]); ow[t].y = pk2(oT[t][2], oT[t][3]); }
                oc = ob + (size_t)chunk * 64 * OLD * 2;
                LDS_BARRIER();
            }
            {   GS_LANE_VARS(); const unsigned lo = (unsigned)((16 * cb + fr) * OLD + 4 * fq) * 2u;
#pragma unroll
                for (int t = 0; t < 4; ++t) *(u32x2*)(oc + lo + 32 * t) = ow[t]; }
        } else {
            const int sw = wid - 4;
            u32x4 pq[4], pk[4], pv[2]; float pdec = 0.f;
            {   GS_LANE_VARS(); GS_STAGE_VARS(); GS_LOAD_CHUNK(dir ? 63 : 0); GS_STAGE(0); GS_LOAD_CHUNK(dir ? 62 : 1); }
            f32x4 S[2][4];
#pragma unroll
            for (int d = 0; d < 2; ++d)
#pragma unroll
                for (int t = 0; t < 4; ++t) S[d][t] = (f32x4){0.f, 0.f, 0.f, 0.f};
            __syncthreads();
            for (int step = 0; step < 64; ++step) {
                GS_LANE_VARS();
                const LAS unsigned char* lds = F.lds + (step & 1) * GS_BUF;
                LAS unsigned char* stW = F.lds + GS_ST + ((step + 1) & 1) * GS_STB;
                bf16x8 kef[2][2], vi[4][2];
                const LAS unsigned char* vb = lds + GS_V + (4 * fq + (fr >> 2)) * GS_VSTR + (4 * (fr & 3)) * 2;
#pragma unroll
                for (int t = 0; t < 4; ++t) { vi[t][0] = cat8(trread(vb + 32 * t), trread(vb + 16 * GS_VSTR + 32 * t)); vi[t][1] = cat8(trread(vb + 32 * GS_VSTR + 32 * t), trread(vb + 48 * GS_VSTR + 32 * t)); }
#pragma unroll
                for (int d = 0; d < 2; ++d) { const LAS unsigned char* kb = lds + GS_KI + (4 * fq + (fr >> 2)) * GS_KSTR + (32 * sw + 16 * d + 4 * (fr & 3)) * 2;
                    kef[d][0] = cat8(trread(kb), trread(kb + 16 * GS_KSTR)); kef[d][1] = cat8(trread(kb + 32 * GS_KSTR), trread(kb + 48 * GS_KSTR)); }
                f32x4 dcv[2];
#pragma unroll
                for (int d = 0; d < 2; ++d) dcv[d] = *(const LAS f32x4*)(lds + GS_DEC + (32 * sw + 16 * d + 4 * fq) * 4);
#pragma unroll
                for (int sidx = 0; sidx < 2; ++sidx)
#pragma unroll
                    for (int d = 0; d < 2; ++d)
#pragma unroll
                        for (int t = 0; t < 4; ++t) S[d][t] = __builtin_amdgcn_mfma_f32_16x16x32_bf16(kef[d][sidx], vi[t][sidx], S[d][t], 0, 0, 0);
#pragma unroll
                for (int d = 0; d < 2; ++d)
#pragma unroll
                    for (int t = 0; t < 4; ++t) { S[d][t] = S[d][t] * dcv[d]; u32x2 w; w.x = pk2(S[d][t][0], S[d][t][1]); w.y = pk2(S[d][t][2], S[d][t][3]);
                        *(LAS u32x2*)(stW + (16 * t + fr) * GS_STR + (32 * sw + 16 * d + 4 * fq) * 2) = w; }
                {   GS_STAGE_VARS();
                    if (step < 63) GS_STAGE((step + 1) & 1);
                    if (step < 62) GS_LOAD_CHUNK(dir ? 61 - step : step + 2); }
                LDS_BARRIER();
            }
        }
    }
}

__device__ __forceinline__ void phase_comb_b(const Frame& F, const Args& a, int layer) {
    const int gw = F.bid * NWAVES + F.wave, NGW = F.G * NWAVES;
    bf16_t* OF = (bf16_t*)(a.ws + X_OF); const bf16_t* OB = (const bf16_t*)(a.ws + X_OB); const bf16_t* ZB = (const bf16_t*)(a.ws + X_ZB);
    const float* wn = a.in[7] + (size_t)layer * 256 + 8 * (F.lane & 31);
    const f32x4 w0 = *(const f32x4*)wn, w1 = *(const f32x4*)(wn + 4);
    for (int tok0 = gw; tok0 < T; tok0 += 2 * NGW) {
        u32x4 f[4], bq[4], z[4];
#pragma unroll
        for (int q = 0; q < 4; ++q) { const int tok = tok0 + (q >> 1) * NGW, hh = q & 1; const size_t off = (size_t)tok * 1024 + hh * 512 + 8 * F.lane, offf = (size_t)tok * OF_LD + OF_C0 + hh * 512 + 8 * F.lane;
            f[q] = __builtin_nontemporal_load((const u32x4*)(OF + offf)); bq[q] = __builtin_nontemporal_load((const u32x4*)(OB + off)); z[q] = __builtin_nontemporal_load((const u32x4*)(ZB + off)); }
#pragma unroll
        for (int q = 0; q < 4; ++q) { const int tok = tok0 + (q >> 1) * NGW, hh = q & 1; const size_t offf = (size_t)tok * OF_LD + OF_C0 + hh * 512 + 8 * F.lane;
            float o[8];
            o[0] = bflo(f[q].x) + bflo(bq[q].x); o[1] = bfhi(f[q].x) + bfhi(bq[q].x); o[2] = bflo(f[q].y) + bflo(bq[q].y); o[3] = bfhi(f[q].y) + bfhi(bq[q].y);
            o[4] = bflo(f[q].z) + bflo(bq[q].z); o[5] = bfhi(f[q].z) + bfhi(bq[q].z); o[6] = bflo(f[q].w) + bflo(bq[q].w); o[7] = bfhi(f[q].w) + bfhi(bq[q].w);
            float ss = (o[0] * o[0] + o[1] * o[1]) + (o[2] * o[2] + o[3] * o[3]) + (o[4] * o[4] + o[5] * o[5]) + (o[6] * o[6] + o[7] * o[7]);
            ss += __shfl_xor(ss, 1); ss += __shfl_xor(ss, 2); ss += __shfl_xor(ss, 4); ss += __shfl_xor(ss, 8); ss += __shfl_xor(ss, 16);
            const float rstd = __builtin_amdgcn_rsqf(ss * (1.0f / 256.0f) + NORM_EPS);
            u32x4 y;
            y.x = pk2(o[0] * rstd * w0[0] * siluf_(bflo(z[q].x)), o[1] * rstd * w0[1] * siluf_(bfhi(z[q].x))); y.y = pk2(o[2] * rstd * w0[2] * siluf_(bflo(z[q].y)), o[3] * rstd * w0[3] * siluf_(bfhi(z[q].y)));
            y.z = pk2(o[4] * rstd * w1[0] * siluf_(bflo(z[q].z)), o[5] * rstd * w1[1] * siluf_(bfhi(z[q].z))); y.w = pk2(o[6] * rstd * w1[2] * siluf_(bflo(z[q].w)), o[7] * rstd * w1[3] * siluf_(bfhi(z[q].w)));
            *(u32x4*)(OF + offf) = y; }
    }
}

__device__ __forceinline__ void phase_comb_a(const Frame& F, const Args& a, int ch0, int nch) {
    const float* LSE = (const float*)(a.ws + WS_LSE); const bf16_t* ZA = (const bf16_t*)(a.ws + X_ZA); bf16_t* YA = (bf16_t*)(a.ws + X_OF);
    const int head = F.lane >> 4;
    for (int ch = ch0; ch < ch0 + nch; ++ch) {
#pragma unroll 1
        for (int trip = 0; trip < 2; ++trip) {
            const int tokb = ch * 32 + F.wave + 16 * trip;
            float l0[2], l1[2], l2[2]; u32x4 a0[2], a1[2], a2[2], z[2];
#pragma unroll
            for (int rr = 0; rr < 2; ++rr) { const int tok = tokb + 8 * rr; const size_t off = (size_t)tok * 512 + 8 * F.lane;
                const int sq = tok & (SEQ - 1), bb = tok & ~(SEQ - 1); const int t1 = bb | ((sq & 3) << 10) | (sq >> 2), t2 = bb | ((sq & 15) << 8) | (sq >> 4);
                const size_t off1 = (size_t)t1 * 512 + 8 * F.lane, off2 = (size_t)t2 * 512 + 8 * F.lane;
                l0[rr] = LSE[(size_t)tok * 4 + head]; l1[rr] = LSE[(size_t)T * 4 + (size_t)t1 * 4 + head]; l2[rr] = LSE[(size_t)2 * T * 4 + (size_t)t2 * 4 + head];
                a0[rr] = __builtin_nontemporal_load((const u32x4*)((const bf16_t*)(a.ws + X_QO) + off)); a1[rr] = __builtin_nontemporal_load((const u32x4*)((const bf16_t*)(a.ws + X_QO + 32 * MiB) + off1)); a2[rr] = __builtin_nontemporal_load((const u32x4*)((const bf16_t*)(a.ws + X_QO + 64 * MiB) + off2));
                z[rr] = __builtin_nontemporal_load((const u32x4*)(ZA + off)); }
#pragma unroll
            for (int rr = 0; rr < 2; ++rr) { const int tok = tokb + 8 * rr;
                const float mx = fmaxf(l0[rr], fmaxf(l1[rr], l2[rr]));
                float w0 = __builtin_amdgcn_exp2f(1.4426950408889634f * (l0[rr] - mx)), w1 = __builtin_amdgcn_exp2f(1.4426950408889634f * (l1[rr] - mx)), w2 = __builtin_amdgcn_exp2f(1.4426950408889634f * (l2[rr] - mx));
                const float inv = __builtin_amdgcn_rcpf(w0 + w1 + w2); w0 *= inv; w1 *= inv; w2 *= inv;
                const u32x4 p = a0[rr], q = a1[rr], r = a2[rr], zz = z[rr];
                u32x4 y;
                y.x = pk2((w0 * bflo(p.x) + w1 * bflo(q.x) + w2 * bflo(r.x)) * siluf_(bflo(zz.x)), (w0 * bfhi(p.x) + w1 * bfhi(q.x) + w2 * bfhi(r.x)) * siluf_(bfhi(zz.x)));
                y.y = pk2((w0 * bflo(p.y) + w1 * bflo(q.y) + w2 * bflo(r.y)) * siluf_(bflo(zz.y)), (w0 * bfhi(p.y) + w1 * bfhi(q.y) + w2 * bfhi(r.y)) * siluf_(bfhi(zz.y)));
                y.z = pk2((w0 * bflo(p.z) + w1 * bflo(q.z) + w2 * bflo(r.z)) * siluf_(bflo(zz.z)), (w0 * bfhi(p.z) + w1 * bfhi(q.z) + w2 * bfhi(r.z)) * siluf_(bfhi(zz.z)));
                y.w = pk2((w0 * bflo(p.w) + w1 * bflo(q.w) + w2 * bflo(r.w)) * siluf_(bflo(zz.w)), (w0 * bfhi(p.w) + w1 * bfhi(q.w) + w2 * bfhi(r.w)) * siluf_(bfhi(zz.w)));
                *(u32x4*)(YA + (size_t)tok * OF_LD + 8 * F.lane) = y; }
        }
    }
}

constexpr int AT_STR = 272, AT_VSTR = 288, AT_K = 0, AT_V = 256 * AT_STR;
__device__ __forceinline__ void phase_attn(const Frame& F, const Args& a, unsigned* qctr) {
    const int tid = F.tid, lane = F.lane, wid = F.wave, fr = lane & 15, fq = lane >> 4;
    LAS unsigned char* lds = F.lds;
    constexpr int NU = 3072, NRUN = NU / 4;
    u32x4 pk[8], pv[8];
    auto geom = [&](int ug, int& g, int& d, int& L, int& r, int& jj, int& h, int& b) { g = ug >> 10; const int u = ug & 1023; d = (g == 0) ? 1 : (g == 1 ? 4 : 16); L = SEQ / d; const int upc = L / 128;
        const int cls = u & 31; r = cls / upc; jj = cls % upc; h = (u >> 5) & 3; b = u >> 7; };
    auto prefetch = [&](int ug, bool reuse) {
        int g, d, L, r, jj, h, b; geom(ug, g, d, L, r, jj, h, b);
        const bf16_t* KA = (const bf16_t*)(a.ws + X_KA + (size_t)g * 32 * MiB); const bf16_t* VA = (const bf16_t*)(a.ws + X_VA + (size_t)g * 32 * MiB);
        const int tk0 = 128 * jj - 64; const size_t tokb = (size_t)b * SEQ + (size_t)r * L;
        if (!reuse) {
#pragma unroll
            for (int i = 0; i < 4; ++i) { const int c = tid + 512 * i, row = c >> 4, ch = c & 15, tk = tk0 + row; const int tkc = tk < 0 ? 0 : (tk >= L ? L - 1 : tk);
                const size_t go = (tokb + (size_t)tkc) * 512 + h * 128 + ch * 8; pk[i] = *(const u32x4*)(KA + go); pv[i] = *(const u32x4*)(VA + go); } }
#pragma unroll
        for (int i = 4; i < 8; ++i) { const int c = tid + 512 * i, row = c >> 4, ch = c & 15, tk = tk0 + row; const int tkc = tk < 0 ? 0 : (tk >= L ? L - 1 : tk);
            const size_t go = (tokb + (size_t)tkc) * 512 + h * 128 + ch * 8; pk[i] = *(const u32x4*)(KA + go); pv[i] = *(const u32x4*)(VA + go); }
    };
    volatile LAS unsigned* qslot = (volatile LAS unsigned*)(F.lds + LDS_BYTES - 256 + 64);
    int R = F.bid;
    if (R < NRUN) prefetch(4 * R, false);
    while (R < NRUN) {
      int Rn = NRUN;
#pragma unroll 1
      for (int k = 0; k < 4; ++k) {
        const int ug = 4 * R + k;
        int g, d, L, r, jj, h, b; geom(ug, g, d, L, r, jj, h, b);
        const bool reuse = (k > 0) && (jj > 0);
        bf16_t* QO = (bf16_t*)(a.ws + X_QO + (size_t)g * 32 * MiB); float* LSEg = (float*)(a.ws + WS_LSE) + (size_t)g * T * 4;
        const int t0 = 128 * jj, tk0 = t0 - 64;
        const size_t tokb = (size_t)b * SEQ + (size_t)r * L;
        LDS_BARRIER();
        if (k == 3) Rn = (int)*qslot;
        if (!reuse) {
#pragma unroll
            for (int i = 0; i < 4; ++i) { const int c = tid + 512 * i, slot = (tk0 + (c >> 4)) & 255, ch = c & 15;
                *(LAS u32x4*)(lds + AT_K + slot * AT_STR + ch * 16) = pk[i]; *(LAS u32x4*)(lds + AT_V + slot * AT_VSTR + ch * 16) = pv[i]; } }
#pragma unroll
        for (int i = 4; i < 8; ++i) { const int c = tid + 512 * i, slot = (tk0 + (c >> 4)) & 255, ch = c & 15;
            *(LAS u32x4*)(lds + AT_K + slot * AT_STR + ch * 16) = pk[i]; *(LAS u32x4*)(lds + AT_V + slot * AT_VSTR + ch * 16) = pv[i]; }
        const int tq = t0 + 16 * wid + fr; const size_t qoff = (tokb + (size_t)tq) * 512 + h * 128;
        bf16x8 qf[4];
#pragma unroll
        for (int ks = 0; ks < 4; ++ks) qf[ks] = *(const bf16x8*)(QO + qoff + 32 * ks + 8 * fq);
        if (k < 3) { int g2, d2, L2, r2, jj2, h2, b2; geom(ug + 1, g2, d2, L2, r2, jj2, h2, b2); prefetch(ug + 1, jj2 > 0); }
        else if (Rn < NRUN) prefetch(4 * Rn, false);
        LDS_BARRIER();
        unsigned pulled = (unsigned)NRUN; if (k == 0 && tid == 0) pulled = (unsigned)F.G + __hip_atomic_fetch_add(qctr, 1u, __ATOMIC_RELAXED, __HIP_MEMORY_SCOPE_AGENT);
        f32x4 s[10]; float m = -1e30f;
        const LAS unsigned char* kbase = lds + AT_K + fr * AT_STR + (8 * fq) * 2;
        const int ktile0 = tk0 + 16 * wid;
        bf16x8 kfa[8], kfb[8];
#define LOADK(dst, kt0) do { _Pragma("unroll") for (int q_ = 0; q_ < 8; ++q_) { const int kt_ = (kt0) + (q_ >> 2); if (kt_ < 9) dst[q_] = *(const LAS bf16x8*)(kbase + ((ktile0 + 16 * kt_) & 255) * AT_STR + (q_ & 3) * 64); } } while (0)
#define MMAK(src, kt0) do { _Pragma("unroll") for (int q_ = 0; q_ < 8; ++q_) { const int kt_ = (kt0) + (q_ >> 2); if (kt_ < 9) s[kt_] = __builtin_amdgcn_mfma_f32_16x16x32_bf16(src[q_], qf[q_ & 3], s[kt_], 0, 0, 0); } } while (0)
#pragma unroll
        for (int kt = 0; kt < 10; ++kt) s[kt] = (f32x4){0.f, 0.f, 0.f, 0.f};
        LOADK(kfa, 0); __builtin_amdgcn_sched_barrier(0);
        LOADK(kfb, 2); __builtin_amdgcn_sched_barrier(0); MMAK(kfa, 0); __builtin_amdgcn_sched_barrier(0);
        LOADK(kfa, 4); __builtin_amdgcn_sched_barrier(0); MMAK(kfb, 2); __builtin_amdgcn_sched_barrier(0);
        LOADK(kfb, 6); __builtin_amdgcn_sched_barrier(0); MMAK(kfa, 4); __builtin_amdgcn_sched_barrier(0);
        LOADK(kfa, 8); __builtin_amdgcn_sched_barrier(0); MMAK(kfb, 6); __builtin_amdgcn_sched_barrier(0);
        MMAK(kfa, 8);
#undef LOADK
#undef MMAK
#pragma unroll
        for (int kt = 0; kt < 9; ++kt)
#pragma unroll
            for (int rg = 0; rg < 4; ++rg) { const int diff = 16 * kt + 4 * fq + rg - 64 - fr, tk = tk0 + 16 * wid + 16 * kt + 4 * fq + rg;
                const bool valid = (diff >= -64) && (diff <= 64) && (tk >= 0) && (tk < L);
                if (!valid) s[kt][rg] = -1e30f; m = fmaxf(m, s[kt][rg]); }
        m = fmaxf(m, __shfl_xor(m, 16)); m = fmaxf(m, __shfl_xor(m, 32));
        float l = 0.f;
#pragma unroll
        for (int kt = 0; kt < 9; ++kt)
#pragma unroll
            for (int rg = 0; rg < 4; ++rg) { const float p = __builtin_amdgcn_exp2f(1.4426950408889634f * (s[kt][rg] - m)); s[kt][rg] = p; l += p; }
        l += __shfl_xor(l, 16); l += __shfl_xor(l, 32);
        bf16x8 pf[5];
#pragma unroll
        for (int sidx = 0; sidx < 5; ++sidx) pf[sidx] = pack8(s[2 * sidx], s[2 * sidx + 1]);
        const float invl = __builtin_amdgcn_rcpf(l);
        int vr[10];
#pragma unroll
        for (int sidx = 0; sidx < 5; ++sidx) { const int r1 = tk0 + 16 * wid + 32 * sidx + 4 * fq + (fr >> 2), r2 = r1 + 16; vr[2 * sidx] = (r1 & 255) * AT_VSTR; vr[2 * sidx + 1] = (r2 & 255) * AT_VSTR; }
        const LAS unsigned char* vbase = lds + AT_V + (4 * (fr & 3)) * 2;
        bf16x8 vfa[5], vfb[5];
#define LOADV(dst, t) do { _Pragma("unroll") for (int q_ = 0; q_ < 5; ++q_) dst[q_] = cat8(trread(vbase + vr[2 * q_] + (t) * 32), trread(vbase + vr[2 * q_ + 1] + (t) * 32)); } while (0)
#define MMAV(src, t) do { f32x4 o_ = {0.f, 0.f, 0.f, 0.f}; _Pragma("unroll") for (int q_ = 0; q_ < 5; ++q_) o_ = __builtin_amdgcn_mfma_f32_16x16x32_bf16(src[q_], pf[q_], o_, 0, 0, 0); \
            u32x2 w_; w_.x = pk2(o_[0] * invl, o_[1] * invl); w_.y = pk2(o_[2] * invl, o_[3] * invl); *(u32x2*)(QO + qoff + 16 * (t) + 4 * fq) = w_; } while (0)
        LOADV(vfa, 0); __builtin_amdgcn_sched_barrier(0);
        LOADV(vfb, 1); __builtin_amdgcn_sched_barrier(0); MMAV(vfa, 0); __builtin_amdgcn_sched_barrier(0);
        LOADV(vfa, 2); __builtin_amdgcn_sched_barrier(0); MMAV(vfb, 1); __builtin_amdgcn_sched_barrier(0);
        LOADV(vfb, 3); __builtin_amdgcn_sched_barrier(0); MMAV(vfa, 2); __builtin_amdgcn_sched_barrier(0);
        LOADV(vfa, 4); __builtin_amdgcn_sched_barrier(0); MMAV(vfb, 3); __builtin_amdgcn_sched_barrier(0);
        LOADV(vfb, 5); __builtin_amdgcn_sched_barrier(0); MMAV(vfa, 4); __builtin_amdgcn_sched_barrier(0);
        LOADV(vfa, 6); __builtin_amdgcn_sched_barrier(0); MMAV(vfb, 5); __builtin_amdgcn_sched_barrier(0);
        LOADV(vfb, 7); __builtin_amdgcn_sched_barrier(0); MMAV(vfa, 6); __builtin_amdgcn_sched_barrier(0);
        MMAV(vfb, 7);
#undef LOADV
#undef MMAV
        if (fq == 0) LSEg[(tokb + (size_t)tq) * 4 + h] = m + 0.6931471805599453f * __builtin_amdgcn_logf(l);
        if (k == 0 && tid == 0) *qslot = pulled;
      }
      R = Rn;
    }
}

__device__ __forceinline__ void run_proj(const Frame& F, unsigned char* ws, const bf16_t* WIN, const bf16_t* Hh, const float* ropec, const float* ropes, int tau0, int ntiles) {
    pg8::Gemm gm{Hh, WIN + (size_t)tau0 * 256 * 1024, T, ntiles * 256, 1024}; pg8::StaticOrder S; S.init(T, ntiles * 256, F.G, F.bid);
    EpiProj E{tau0, ws, ropec, ropes};
    pg8::gemm_phase<EpiProj, pg8::StaticOrder, true, true>(F.lds, gm, S, E, F.wave);
}

#define XB_TMO      128
#define XB_XCNT(j)  (256  + 64 * (j))
#define XB_XSUB(j)  (1280 + 64 * (j))
#define XB_XGEN(j)  (2304 + 64 * (j))
#define XB_TOP      3328
#define XB_TOPGEN   3392
#define XCD_BAR_WORDS 3456
#define XB_SPIN_CAP (1u << 18)

__device__ __forceinline__ unsigned xb_ld(unsigned* p)              { return __hip_atomic_load(p, __ATOMIC_RELAXED, __HIP_MEMORY_SCOPE_AGENT); }
__device__ __forceinline__ unsigned xb_add(unsigned* p, unsigned v) { return __hip_atomic_fetch_add(p, v, __ATOMIC_RELAXED, __HIP_MEMORY_SCOPE_AGENT); }
__device__ __forceinline__ unsigned xb_xcc_id() { return (unsigned)__builtin_amdgcn_s_getreg((3 << 11) | 20) & 0xFu; }
#define XB_SPIN(cond, bar) do { unsigned _sp = 0; while (cond) { __builtin_amdgcn_s_sleep(1); \
    if ((++_sp & 255u) == 0u) { if (xb_ld(&(bar)[XB_TMO])) break; if (_sp > XB_SPIN_CAP) { atomicAdd(&(bar)[XB_TMO], 1u); break; } } } } while (0)

struct XcdBarrier {
    unsigned* bar; unsigned x;
    volatile LAS unsigned* st;
};

__device__ __forceinline__ XcdBarrier xcd_barrier_post(unsigned* bar, volatile LAS unsigned* st) {
    XcdBarrier b; b.bar = bar; b.x = xb_xcc_id(); b.st = st;
    if (threadIdx.x == 0) (void)xb_add(&bar[XB_XCNT(b.x)], 1u);
    return b;
}
__device__ __forceinline__ void xcd_barrier_complete(unsigned* bar, unsigned x, unsigned& nloc, unsigned& nx) {
    const unsigned G = gridDim.x * gridDim.y * gridDim.z;
    unsigned sum, cnt, mine, sp = 0u;
    for (;;) {
        sum = 0u; cnt = 0u; mine = 0u;
#pragma unroll
        for (unsigned j = 0; j < 16; ++j) { const unsigned c = xb_ld(&bar[XB_XCNT(j)]); sum += c; cnt += (c > 0u) ? 1u : 0u; mine = (j == x) ? c : mine; }
        if (sum == G) break;
        __builtin_amdgcn_s_sleep(1);
        if ((++sp & 255u) == 0u) { if (xb_ld(&bar[XB_TMO])) break; if (sp > XB_SPIN_CAP) { atomicAdd(&bar[XB_TMO], 1u); break; } }
    }
    nloc = mine > 0u ? mine : 1u; nx = cnt > 0u ? cnt : 1u;
}

__device__ __forceinline__ void xcd_barrier(const XcdBarrier& b, const bool leader_thread) {
    asm volatile("s_waitcnt vmcnt(0)" ::: "memory");
    __syncthreads();
    if (leader_thread) {
        unsigned* bar = b.bar;
        __builtin_amdgcn_s_waitcnt(0);
        unsigned nloc = b.st[0], nx = b.st[1];
        if (nloc == 0u) { xcd_barrier_complete(bar, b.x, nloc, nx); b.st[0] = nloc; b.st[1] = nx; }
        const unsigned old = xb_add(&bar[XB_XSUB(b.x)], 1u);
        const unsigned gen = old / nloc;
        if (old + 1u == (gen + 1u) * nloc) {
            __builtin_amdgcn_fence(__ATOMIC_RELEASE, "agent");
            asm volatile("s_waitcnt vmcnt(0)" ::: "memory");
            const unsigned og = xb_add(&bar[XB_TOP], 1u);
            const unsigned tg = og / nx;
            if (og + 1u == (tg + 1u) * nx) xb_add(&bar[XB_TOPGEN], 1u);
            else XB_SPIN(xb_ld(&bar[XB_TOPGEN]) == tg, bar);
            __builtin_amdgcn_fence(__ATOMIC_ACQUIRE, "agent");
            xb_add(&bar[XB_XGEN(b.x)], 1u);
            asm volatile("s_waitcnt vmcnt(0)" ::: "memory");
        } else {
            XB_SPIN(xb_ld(&bar[XB_XGEN(b.x)]) == gen, bar);
            __builtin_amdgcn_fence(__ATOMIC_ACQUIRE, "agent");
            asm volatile("s_waitcnt vmcnt(0)" ::: "memory");
        }
    }
    __syncthreads();
}

constexpr int COMB_X = 2;
constexpr int CW_BAR = 4096;
constexpr size_t CTL_ZERO_BYTES = 64 * 1024;
constexpr int MISC_OFF = LDS_BYTES - 256;

#define LAUNDER() do { asm volatile("" : "+s"(F.wave), "+s"(F.bid), "+s"(F.G)); F.lane = fresh_lane(); F.tid = F.wave * 64 + F.lane; asm volatile("" : "+s"(ws)); } while (0)
#define GRID_BAR() do { XcdBarrier bb_ = bar; asm volatile("" : "+s"(bb_.bar), "+s"(bb_.x)); xcd_barrier(bb_, (F.wave * 64 + fresh_lane()) == 0); LAUNDER(); } while (0)

__global__ void __launch_bounds__(NTHR, 2) hybrid_fwd(Args args) {
    extern __shared__ __attribute__((aligned(16))) unsigned char lds_raw[];
    Frame F; F.lds = (LAS unsigned char*)lds_raw; F.tid = threadIdx.x; F.lane = F.tid & 63; F.wave = __builtin_amdgcn_readfirstlane(F.tid >> 6); F.G = gridDim.x; F.bid = blockIdx.x;
    unsigned char* ws = args.ws;
    volatile LAS unsigned* MISC = (volatile LAS unsigned*)(F.lds + MISC_OFF);
    if (F.tid < 64) MISC[F.tid] = 0u;
    __syncthreads();
    XcdBarrier bar = xcd_barrier_post((unsigned*)(ws + WS_CTL) + CW_BAR, MISC + 8);

    phase_prologue(F, args);
    __syncthreads(); LAUNDER();
#pragma unroll 1
    for (int layer = 0; layer < 2; ++layer) {
        LAUNDER();
        const float* ropec = (const float*)(ws + WS_ROPEC); const float* ropes = (const float*)(ws + WS_ROPES);
        const bf16_t* WIN = (const bf16_t*)(ws + WS_WIN + layer * WIN_BYTES);
        const bf16_t* Hh = (const bf16_t*)(ws + WS_H);
        if (layer == 0) phase_prep(F, args, 0, args.in[0], nullptr, nullptr, args.in[1]); else phase_prep(F, args, 1, args.in[0], args.out, args.in[11], args.in[1] + 1024);
        GRID_BAR();
        run_proj(F, ws, WIN, Hh, ropec, ropes, 0, 20);
        GRID_BAR();
        phase_attn(F, args, (unsigned*)(ws + WS_CTL) + 8192 + 64 * layer);
        GRID_BAR();
        {
            const int half = F.G >> 1; const bool five = F.bid < half;
            const int nch = five ? COMB_X : 8 - COMB_X, ch0 = five ? F.bid * COMB_X : half * COMB_X + (F.bid - half) * (8 - COMB_X);
            if (F.G == 256) phase_comb_a(F, args, ch0, nch); else phase_comb_a(F, args, (T / 32) * F.bid / F.G, (T / 32) * (F.bid + 1) / F.G - (T / 32) * F.bid / F.G); }
        LAUNDER();
        run_proj(F, ws, WIN, Hh, ropec, ropes, 20, 9);
        GRID_BAR();
        phase_gla_pre(F, args, layer);
        GRID_BAR();
        phase_gla_scan(F, args);
        GRID_BAR();
        run_proj(F, ws, WIN, Hh, ropec, ropes, 29, 12);
        GRID_BAR();
        phase_comb_b(F, args, layer);
        GRID_BAR();
        { pg8::Gemm gm{(const bf16_t*)(ws + X_OF), (const bf16_t*)(ws + WS_WA + layer * 3 * MiB), T, 1024, 1536}; pg8::StaticOrder S; S.init(T, 1024, F.G, F.bid);
          EpiMerge E{(const bf16_t*)(ws + X_GA), (const bf16_t*)(ws + X_GB), (bf16_t*)(ws + WS_H)};
          pg8::gemm_phase<EpiMerge, pg8::StaticOrder, true, true>(F.lds, gm, S, E, F.wave); }
        GRID_BAR();
        { pg8::Gemm gm{(const bf16_t*)(ws + WS_H), (const bf16_t*)(ws + WS_WO + layer * 2 * MiB), T, 1024, 1024}; pg8::StaticOrder S; S.init(T, 1024, F.G, F.bid);
          EpiOut E{(bf16_t*)(ws + X_OUT), (float*)(ws + WS_ROWSS)};
          pg8::gemm_phase<EpiOut, pg8::StaticOrder, true, true>(F.lds, gm, S, E, F.wave); }
        GRID_BAR();
    }
    phase_prep(F, args, 2, args.out, args.out, args.in[11] + 1024, nullptr);
}

extern "C" void kernel_launch(void* const* d_in, const int* in_sizes, int n_in, void* d_out, int out_size, void* d_ws, size_t ws_size, hipStream_t stream) {
    static int grid = 0;
    if (grid == 0) {
        if (n_in != 12 || out_size != T * DM || ws_size < WS_END) { fprintf(stderr, "kernel_launch: unexpected shapes (n_in %d out %d ws %zu)\n", n_in, out_size, ws_size); grid = -1; return; }
        int dev = 0, cus = 0;
        if (hipGetDevice(&dev) != hipSuccess || hipDeviceGetAttribute(&cus, hipDeviceAttributeMultiprocessorCount, dev) != hipSuccess) { grid = -1; return; }
        if (hipFuncSetAttribute((const void*)hybrid_fwd, hipFuncAttributeMaxDynamicSharedMemorySize, LDS_BYTES) != hipSuccess) { grid = -1; return; }
        grid = cus;
    }
    if (grid < 0) return;
    if (hipMemsetAsync((char*)d_ws + WS_CTL, 0, CTL_ZERO_BYTES, stream) != hipSuccess) return;
    Args a{};
    for (int i = 0; i < 12; ++i) a.in[i] = (const float*)d_in[i];
    a.out = (float*)d_out; a.ws = (unsigned char*)d_ws; a.ph_lo = 0; a.ph_hi = 0;
    hipLaunchKernelGGL(hybrid_fwd, dim3(grid), dim3(NTHR), LDS_BYTES, stream, a);
}
```

```cpp
#include <hip/hip_runtime.h>
#include <cstdio>
#include <cstdint>
__device__ __forceinline__ int fresh_lane() { int l; asm volatile("v_mbcnt_lo_u32_b32 %0, -1, 0\n\tv_mbcnt_hi_u32_b32 %0, -1, %0" : "=v"(l)); return l; }
namespace pg8 {
#define PG8_LAS __attribute__((address_space(3)))
typedef unsigned short bf16_t;
typedef short bf16x8 __attribute__((ext_vector_type(8)));
typedef float f32x4 __attribute__((ext_vector_type(4)));
typedef unsigned u32x4 __attribute__((ext_vector_type(4)));
constexpr int BM = 256, BK = 64, HALF = 128, HTB = HALF * BK * 2  , STAGE_BYTES = 8 * HTB, NXCD = 8, WGM = 8;

__host__ __device__ __forceinline__ int lds_byte(int r, int c) { const int st = (r >> 4) * 2 + (c >> 5), rr = r & 15, cc = c & 31, ob = rr * 64 + cc * 2; return st * 1024 + (ob ^ (((ob >> 9) & 1) << 5)); }
__host__ __device__ __forceinline__ void stage_rc(int b, int& R, int& C) { const int st = b / 1024, sb = b % 1024, swz = sb ^ (((sb >> 9) & 1) << 5); R = (st >> 1) * 16 + swz / 64; C = (st & 1) * 32 + (swz % 64) / 2; }
__host__ __device__ __forceinline__ int perm32(int rho) { const int n = rho >> 4, i = rho & 15; return 8 * (i >> 2) + 4 * n + (i & 3); }

struct Unit { int pm, pn; };
struct Gemm { const bf16_t* A; const bf16_t* Bt; int M, N, K; };

struct StaticOrder {
    int nM, nN, nwg, G, c;
    __host__ __device__ void init(int M, int N, int G_, int c_) { nM = M / BM; nN = N / BM; nwg = nM * nN; G = G_; c = c_; }
    __host__ __device__ bool next(int i, Unit& u) const {
        const long L = (long)i * G + c; if (L >= nwg) return false;
        int wgid = (int)L; { const int q = nwg / NXCD, r = nwg % NXCD, xcd = wgid % NXCD, off = wgid / NXCD; wgid = (xcd < r ? xcd * (q + 1) : r * (q + 1) + (xcd - r) * q) + off; }
        const int nig = WGM * nN, gid = wgid / nig, fm = gid * WGM, gsz = (nM - fm) < WGM ? (nM - fm) : WGM;
        u.pm = fm + ((wgid % nig) % gsz); u.pn = (wgid % nig) / gsz; return true;
    }
    __device__ __forceinline__ void a_ready(const Unit&) const {}
    __device__ __forceinline__ void done(const Unit&) const {}
};


__device__ __forceinline__ unsigned cvt_pk_bf16(float lo, float hi) { unsigned r; asm volatile("v_cvt_pk_bf16_f32 %0, %1, %2" : "=v"(r) : "v"(lo), "v"(hi)); return r; }
template <class Epi, class Sched, bool ALIGN_EPI = false, bool SP2 = false>
__device__ __forceinline__ void gemm_phase(PG8_LAS unsigned char* lds, const Gemm g, const Sched& S, const Epi& E, int wave_id) {
    const int lane = fresh_lane(), wid = wave_id, tid = wid * 64 + lane, wr = wid >> 2, wc = wid & 3, fr = lane & 15, fq = lane >> 4;
    const int K = g.K, nt = K / BK;
    unsigned voffA[2], voffB[2];
#pragma unroll
    for (int i = 0; i < 2; ++i) { int R, C; stage_rc(tid * 16 + i * 8192, R, C); const int Rb = Epi::PERM ? ((R & ~31) + perm32(R & 31)) : R;
        voffA[i] = (unsigned)(R * K + C) * 2u; voffB[i] = (unsigned)(Rb * K + C) * 2u; }
    const size_t kstep = (size_t)(BK * 2);
    const size_t hstep = (size_t)HALF * K * 2;
    const size_t tstep = 2 * hstep;
    const unsigned ldsw = (unsigned)wid * 1024u;
    const int aoff = lds_byte(wr * 64 + fr, fq * 8), boff = lds_byte(wc * 32 + fr, fq * 8);
#define PG8_SA(b, h) (((b) * 2 + (h)) * HTB)
#define PG8_SB(b, h) ((4 + (b) * 2 + (h)) * HTB)
#define PG8_STAGE(bufoff, gbase, voff) do { _Pragma("unroll") for (int _i = 0; _i < 2; ++_i) \
        __builtin_amdgcn_global_load_lds((const unsigned*)((const char*)(gbase) + (voff)[_i]), (PG8_LAS unsigned*)(lds + (bufoff) + ldsw + _i * 8192), 16, 0, 0); } while (0)
#define PG8_LDA(dst, b, h) do { _Pragma("unroll") for (int m = 0; m < 4; ++m) _Pragma("unroll") for (int k = 0; k < 2; ++k) dst[m][k] = *(const PG8_LAS bf16x8*)(lds + PG8_SA(b, h) + aoff + m * 2048 + k * 1024); } while (0)
#define PG8_LDB(dst, b, h) do { _Pragma("unroll") for (int n = 0; n < 2; ++n) _Pragma("unroll") for (int k = 0; k < 2; ++k) dst[n][k] = *(const PG8_LAS bf16x8*)(lds + PG8_SB(b, h) + boff + n * 2048 + k * 1024); } while (0)
#define PG8_MMA(ai, bj, At, Bt) do { __builtin_amdgcn_s_setprio(1); _Pragma("unroll") for (int m = 0; m < 4; ++m) _Pragma("unroll") for (int n = 0; n < 2; ++n) _Pragma("unroll") for (int k = 0; k < 2; ++k) \
        acc[ai][bj][m][n] = __builtin_amdgcn_mfma_f32_16x16x32_bf16(Bt[n][k], At[m][k], acc[ai][bj][m][n], 0, 0, 0); __builtin_amdgcn_s_setprio(0); } while (0)
#define PG8_WAIT_V(n) asm volatile("s_waitcnt vmcnt(" #n ")" ::: "memory")
#define PG8_WAIT_L(n) asm volatile("s_waitcnt lgkmcnt(" #n ")" ::: "memory")
#define PG8_BAR __builtin_amdgcn_s_barrier()
#define PG8_SCHED __builtin_amdgcn_sched_barrier(0)
    Unit cur, nxt; int ui = 0;
    if (!S.next(0, cur)) return;
    f32x4 acc[2][2][4][2];
#pragma unroll
    for (int a = 0; a < 2; ++a)
#pragma unroll
        for (int b = 0; b < 2; ++b)
#pragma unroll
            for (int m = 0; m < 4; ++m)
#pragma unroll
                for (int n = 0; n < 2; ++n) acc[a][b][m][n] = (f32x4){0.f, 0.f, 0.f, 0.f};
    bf16x8 At[4][2], B0[2][2], B1[2][2];
    const char* cA = (const char*)g.A + (size_t)cur.pm * tstep; const char* cB = (const char*)g.Bt + (size_t)cur.pn * tstep;
    S.a_ready(cur);
    if constexpr (SP2) {
        PG8_STAGE(PG8_SB(0, 0), cB, voffB); PG8_STAGE(PG8_SB(0, 1), cB + hstep, voffB); PG8_STAGE(PG8_SA(0, 0), cA, voffA); PG8_STAGE(PG8_SA(0, 1), cA + hstep, voffA);
        if (wr == 1) PG8_BAR;
        PG8_WAIT_V(2); PG8_BAR;
        PG8_STAGE(PG8_SB(1, 0), cB + kstep, voffB); PG8_STAGE(PG8_SA(1, 0), cA + kstep, voffA); PG8_STAGE(PG8_SB(1, 1), cB + hstep + kstep, voffB);
        PG8_WAIT_V(6); PG8_BAR;
    } else {
        PG8_STAGE(PG8_SB(0, 0), cB, voffB); PG8_STAGE(PG8_SA(0, 0), cA, voffA); PG8_STAGE(PG8_SB(0, 1), cB + hstep, voffB); PG8_STAGE(PG8_SA(0, 1), cA + hstep, voffA);
        if (wr == 1) PG8_BAR;
        PG8_WAIT_V(4); PG8_BAR;
        PG8_STAGE(PG8_SB(1, 0), cB + kstep, voffB); PG8_STAGE(PG8_SA(1, 0), cA + kstep, voffA); PG8_STAGE(PG8_SB(1, 1), cB + hstep + kstep, voffB);
        PG8_WAIT_V(6); PG8_BAR;
    }
    for (;;) {
        const bool has_next = S.next(ui + 1, nxt);
        const char* nA = has_next ? (const char*)g.A + (size_t)nxt.pm * tstep : cA; const char* nB = has_next ? (const char*)g.Bt + (size_t)nxt.pn * tstep : cB;
        for (int t = 0; t < nt; t += 2) {
            if constexpr (Epi::MIDT > 0) { if (t == Epi::MIDT) E.mid(acc, cur, wr, wc, fr, fq); }
            const bool last = (t == nt - 2);
            const char* a1 = cA + (size_t)(t + 1) * kstep;
            const char* a2 = last ? nA : cA + (size_t)(t + 2) * kstep; const char* b2 = last ? nB : cB + (size_t)(t + 2) * kstep;
            const char* a3 = a2 + kstep; const char* b3 = b2 + kstep;
            if (last && has_next) S.a_ready(nxt);
            if constexpr (SP2) {
            PG8_LDB(B0, 0, 0); PG8_LDB(B1, 0, 1); PG8_SCHED; PG8_LDA(At, 0, 0); PG8_STAGE(PG8_SA(1, 1), a1 + hstep, voffA);
            PG8_WAIT_V(8); PG8_WAIT_L(0); PG8_BAR; PG8_MMA(0, 0, At, B0); PG8_MMA(0, 1, At, B1); PG8_BAR; PG8_SCHED;
            PG8_LDA(At, 0, 1); PG8_STAGE(PG8_SB(0, 0), b2, voffB); PG8_STAGE(PG8_SB(0, 1), b2 + hstep, voffB); PG8_STAGE(PG8_SA(0, 0), a2, voffA);
            PG8_WAIT_V(8); PG8_WAIT_L(0); PG8_BAR; PG8_MMA(1, 0, At, B0); PG8_MMA(1, 1, At, B1); PG8_BAR; PG8_SCHED;
            PG8_LDB(B0, 1, 0); PG8_LDB(B1, 1, 1); PG8_SCHED; PG8_LDA(At, 1, 0); PG8_STAGE(PG8_SA(0, 1), a2 + hstep, voffA);
            PG8_WAIT_V(8); PG8_WAIT_L(0); PG8_BAR; PG8_MMA(0, 0, At, B0); PG8_MMA(0, 1, At, B1); PG8_BAR; PG8_SCHED;
            PG8_LDA(At, 1, 1); PG8_STAGE(PG8_SB(1, 0), b3, voffB); PG8_STAGE(PG8_SB(1, 1), b3 + hstep, voffB); PG8_STAGE(PG8_SA(1, 0), a3, voffA);
            PG8_WAIT_V(8); PG8_WAIT_L(0); PG8_BAR; PG8_MMA(1, 0, At, B0); PG8_MMA(1, 1, At, B1); PG8_BAR; PG8_SCHED;
            } else {
            PG8_LDB(B0, 0, 0); PG8_SCHED; PG8_LDA(At, 0, 0); PG8_STAGE(PG8_SA(1, 1), a1 + hstep, voffA);
            PG8_WAIT_L(8); PG8_BAR; PG8_WAIT_L(0); PG8_MMA(0, 0, At, B0); PG8_BAR; PG8_SCHED;
            PG8_LDB(B1, 0, 1); PG8_STAGE(PG8_SB(0, 0), b2, voffB);
            PG8_BAR; PG8_WAIT_L(0); PG8_MMA(0, 1, At, B1); PG8_BAR;
            PG8_LDA(At, 0, 1); PG8_STAGE(PG8_SA(0, 0), a2, voffA);
            PG8_BAR; PG8_WAIT_L(0); PG8_MMA(1, 0, At, B0); PG8_BAR; PG8_SCHED;
            PG8_STAGE(PG8_SB(0, 1), b2 + hstep, voffB);
            PG8_WAIT_V(6); PG8_BAR; PG8_MMA(1, 1, At, B1); PG8_BAR;
            PG8_LDB(B0, 1, 0); PG8_SCHED; PG8_LDA(At, 1, 0); PG8_STAGE(PG8_SA(0, 1), a2 + hstep, voffA);
            PG8_WAIT_L(8); PG8_BAR; PG8_WAIT_L(0); PG8_MMA(0, 0, At, B0); PG8_BAR; PG8_SCHED;
            PG8_LDB(B1, 1, 1); PG8_STAGE(PG8_SB(1, 0), b3, voffB);
            PG8_BAR; PG8_WAIT_L(0); PG8_MMA(0, 1, At, B1); PG8_BAR;
            PG8_LDA(At, 1, 1); PG8_STAGE(PG8_SA(1, 0), a3, voffA);
            PG8_BAR; PG8_WAIT_L(0); PG8_MMA(1, 0, At, B0); PG8_BAR; PG8_SCHED;
            PG8_STAGE(PG8_SB(1, 1), b3 + hstep, voffB);
            PG8_WAIT_V(6); PG8_BAR; PG8_MMA(1, 1, At, B1); PG8_BAR;
            }
        }
        if constexpr (ALIGN_EPI) { if (wr == 0) PG8_BAR; }
        if constexpr (!Epi::AFTER_DRAIN) { E(acc, cur, wr, wc, fr, fq); S.done(cur); }
        if (!has_next) break;
#pragma unroll
        for (int a = 0; a < 2; ++a)
#pragma unroll
            for (int b = 0; b < 2; ++b)
#pragma unroll
                for (int m = 0; m < 4; ++m)
#pragma unroll
                    for (int n = 0; n < 2; ++n) acc[a][b][m][n] = (f32x4){0.f, 0.f, 0.f, 0.f};
        cur = nxt; cA = nA; cB = nB; ++ui;
        if constexpr (ALIGN_EPI) { if (wr == 1) PG8_BAR; }
    }
    PG8_WAIT_V(0);
    if constexpr (!ALIGN_EPI) { if (wr == 0) PG8_BAR; }
    PG8_BAR;
    if constexpr (Epi::AFTER_DRAIN) { E.fused(acc, cur, wr, wc, fr, fq, lds, wid, lane); S.done(cur); }
#undef PG8_SA
#undef PG8_SB
#undef PG8_STAGE
#undef PG8_LDA
#undef PG8_LDB
#undef PG8_MMA
#undef PG8_WAIT_V
#undef PG8_WAIT_L
#undef PG8_BAR
#undef PG8_SCHED
}
}

#define LAS __attribute__((address_space(3)))
typedef unsigned short bf16_t;
typedef short bf16x8 __attribute__((ext_vector_type(8)));
typedef short s16x4 __attribute__((ext_vector_type(4)));
typedef float f32x4 __attribute__((ext_vector_type(4)));
typedef float f32x2 __attribute__((ext_vector_type(2)));
typedef unsigned u32x4 __attribute__((ext_vector_type(4)));
typedef unsigned u32x2 __attribute__((ext_vector_type(2)));

constexpr int NWAVES = 8, NTHR = 512;
constexpr int T = 32768, DM = 1024, SEQ = 4096, NB = 8;
constexpr int IN_DIM = 10272;
constexpr int NWIN_TILES = 41, NWIN = NWIN_TILES * 256;
constexpr float NORM_EPS = 1e-6f;
constexpr float QSCALE = 0.08838834764831845f;

constexpr size_t MiB = 1u << 20;
constexpr size_t WS_CTL = 0;
constexpr size_t WS_WIN = 1 * MiB;
constexpr size_t WIN_BYTES = (size_t)NWIN * 1024 * 2;
constexpr size_t WS_WA = 42 * MiB;
constexpr size_t WS_WB = 44 * MiB;
constexpr size_t WS_WO = 48 * MiB;
constexpr size_t WS_ROPEC = 52 * MiB, WS_ROPES = WS_ROPEC + 256 * 1024;
constexpr size_t WS_LSE = 53 * MiB;
constexpr size_t WS_LR = 55 * MiB;
constexpr size_t WS_ROWSS = 59 * MiB;
constexpr size_t WS_H = 62 * MiB;
constexpr size_t WS_X = 126 * MiB;
constexpr size_t X_QO = WS_X + 0 * MiB, X_KA = WS_X + 96 * MiB, X_VA = WS_X + 192 * MiB, X_ZA = WS_X + 288 * MiB;
constexpr size_t X_GQ = WS_X + 96 * MiB, X_GK = WS_X + 128 * MiB, X_GVL = WS_X + 160 * MiB, X_GVH = WS_X + 352 * MiB, X_BF = WS_X + 0 * MiB, X_BB = WS_X + 32 * MiB;
constexpr size_t X_OF = WS_X + 192 * MiB, X_OB = WS_X + 288 * MiB;
constexpr int OF_LD = 1536, OF_C0 = 512;
constexpr size_t X_ZB = WS_X + 0 * MiB, X_GA = WS_X + 64 * MiB, X_GB = WS_X + 128 * MiB, X_OUT = WS_X + 0 * MiB;
constexpr size_t WS_END = WS_X + 384 * MiB;

constexpr int LDS_BYTES = 147456;

__device__ __forceinline__ float bf2f(unsigned v) { return __uint_as_float(v << 16); }
__device__ __forceinline__ float bflo(unsigned w) { return __uint_as_float(w << 16); }
__device__ __forceinline__ float bfhi(unsigned w) { return __uint_as_float(w & 0xffff0000u); }
typedef __bf16 bf16x2_t __attribute__((ext_vector_type(2)));
__device__ __forceinline__ unsigned pk2(float lo, float hi) { f32x2 v = {lo, hi}; bf16x2_t b = __builtin_convertvector(v, bf16x2_t); return __builtin_bit_cast(unsigned, b); }
template <int M> __device__ __forceinline__ float xsum(float v) {
    if constexpr (M < 32) return v + __builtin_bit_cast(float, __builtin_amdgcn_ds_swizzle(__builtin_bit_cast(int, v), (M << 10) | 0x1F));
    else { const unsigned u = __builtin_bit_cast(unsigned, v); auto r = __builtin_amdgcn_permlane32_swap(u, u, false, false); return __builtin_bit_cast(float, r[0]) + __builtin_bit_cast(float, r[1]); }
}
template <int M> __device__ __forceinline__ float xmax(float v) {
    if constexpr (M < 32) return fmaxf(v, __builtin_bit_cast(float, __builtin_amdgcn_ds_swizzle(__builtin_bit_cast(int, v), (M << 10) | 0x1F)));
    else { const unsigned u = __builtin_bit_cast(unsigned, v); auto r = __builtin_amdgcn_permlane32_swap(u, u, false, false); return fmaxf(__builtin_bit_cast(float, r[0]), __builtin_bit_cast(float, r[1])); }
}
__device__ __forceinline__ float wave_sum(float v) { v += __shfl_xor(v, 1); v += __shfl_xor(v, 2); v += __shfl_xor(v, 4); v += __shfl_xor(v, 8); v += __shfl_xor(v, 16); v += __shfl_xor(v, 32); return v; }
__device__ __forceinline__ float sigmoidf_(float x) { return __builtin_amdgcn_rcpf(1.0f + __builtin_amdgcn_exp2f(-1.4426950408889634f * x)); }
__device__ __forceinline__ float siluf_(float x) { return x * sigmoidf_(x); }

struct EpiProj {
    static constexpr bool PERM = true, AFTER_DRAIN = false; static constexpr int MIDT = 0;
    int tau0; unsigned char* ws; const float* ropec; const float* ropes;
    __device__ __forceinline__ void operator()(const f32x4 (&acc)[2][2][4][2], const pg8::Unit& u, int wr, int wc, int fr, int fq) const {
        const int tau = tau0 + u.pn;
        int mode = 0, ldc = 512, colt = 0, dsh = 0; bf16_t* base = nullptr;
        if (tau < 18) { const int g = tau / 6, t = (tau % 6) >> 1, half = tau & 1; colt = half * 256; dsh = 2 * g;
                        base = (bf16_t*)(ws + (t == 0 ? X_QO : (t == 1 ? X_KA : X_VA)) + (size_t)g * 32 * MiB); mode = t < 2 ? 3 : 0; }
        else if (tau < 20) { base = (bf16_t*)(ws + X_ZA); colt = (tau - 18) * 256; }
        else if (tau < 22) { base = (bf16_t*)(ws + X_GQ); colt = (tau - 20) * 256; }
        else if (tau < 24) { base = (bf16_t*)(ws + X_GK); colt = (tau - 22) * 256; }
        else if (tau < 28) { base = (bf16_t*)(ws + (tau < 26 ? X_GVL : X_GVH)); colt = ((tau - 24) & 1) * 256; }
        else if (tau == 28) { mode = 4; }
        else if (tau < 33) { base = (bf16_t*)(ws + X_ZB); ldc = 1024; colt = (tau - 29) * 256; }
        else { mode = 5; }
        const int row0 = u.pm * 256 + wr * 64 + fr;
        if (mode == 5) {
            bf16_t* Rb = (bf16_t*)(ws + X_GA); bf16_t* Gb = (bf16_t*)(ws + X_GB); const int tix = ((wr * 4 + wc) * 4 + fq) * 16 + fr;
#pragma unroll
            for (int ai = 0; ai < 2; ++ai)
#pragma unroll
                for (int m = 0; m < 4; ++m) { const size_t off = ((((size_t)u.pm * 8 + (tau - 33)) * 8 + (ai * 4 + m)) * 512 + tix) * 8;
                    float r[8], g[8];
#pragma unroll
                    for (int j = 0; j < 8; ++j) { const float av = acc[ai][0][m][j >> 2][j & 3], bv = acc[ai][1][m][j >> 2][j & 3];
                        const float ea = __builtin_amdgcn_exp2f(-1.4426950408889634f * av), eb = fminf(__builtin_amdgcn_exp2f(-1.4426950408889634f * bv), 1e30f);
                        r[j] = (1.0f + eb) * __builtin_amdgcn_rcpf(1.0f + ea); g[j] = __builtin_amdgcn_rcpf(1.0f + eb); }
                    u32x4 wr_, wg_; wr_.x = pk2(r[0], r[1]); wr_.y = pk2(r[2], r[3]); wr_.z = pk2(r[4], r[5]); wr_.w = pk2(r[6], r[7]);
                    wg_.x = pk2(g[0], g[1]); wg_.y = pk2(g[2], g[3]); wg_.z = pk2(g[4], g[5]); wg_.w = pk2(g[6], g[7]);
                    __builtin_nontemporal_store(wr_, (u32x4*)(Rb + off)); __builtin_nontemporal_store(wg_, (u32x4*)(Gb + off)); }
            return;
        }
        if (mode == 4) {
            if (wc == 0) { float* LR = (float*)(ws + WS_LR);
#pragma unroll
                for (int ai = 0; ai < 2; ++ai)
#pragma unroll
                    for (int m = 0; m < 4; ++m) { float* rp = LR + (size_t)(row0 + ai * 128 + m * 16) * 32 + 8 * fq;
                        *(f32x4*)(rp) = acc[ai][0][m][0]; *(f32x4*)(rp + 4) = acc[ai][0][m][1]; } }
            return;
        }
        const int col0 = colt + wc * 32 + 8 * fq;
#pragma unroll
        for (int ai = 0; ai < 2; ++ai) {
            float csv[4], snv[4];
            if (mode == 3) { const float invr = __builtin_amdgcn_exp2f(-(float)(4 * wc + fq) * (18.931568569324174f / 16.0f)) * 0.15915494309189535f;
#pragma unroll
                for (int m = 0; m < 4; ++m) { const float pos = (float)((row0 + ai * 128 + m * 16) & (SEQ - 1)); const float xr = __builtin_amdgcn_fractf(pos * invr); csv[m] = __builtin_amdgcn_cosf(xr); snv[m] = __builtin_amdgcn_sinf(xr); } }
#pragma unroll
            for (int m = 0; m < 4; ++m) { const int row = row0 + ai * 128 + m * 16;
                const int srow = (row & ~(SEQ - 1)) | (((row & ((1 << dsh) - 1)) << (12 - dsh)) | ((row & (SEQ - 1)) >> dsh));
                bf16_t* rowp = base + (size_t)srow * ldc + col0;
                const float cs = csv[m], sn = snv[m];
#pragma unroll
                for (int bj = 0; bj < 2; ++bj) { f32x4 v0 = acc[ai][bj][m][0], v1 = acc[ai][bj][m][1];
                    if (mode == 1) {
#pragma unroll
                        for (int j = 0; j < 4; ++j) { v0[j] = v0[j] * sigmoidf_(v0[j]); v1[j] = v1[j] * sigmoidf_(v1[j]); } }
                    else if (mode == 2) {
#pragma unroll
                        for (int j = 0; j < 4; ++j) { v0[j] = sigmoidf_(v0[j]); v1[j] = sigmoidf_(v1[j]); } }
                    else if (mode == 3) { const float a0 = v0[0], a1 = v0[1]; v0[0] = a0 * cs - a1 * sn; v0[1] = a1 * cs + a0 * sn; }
                    u32x4 w; w.x = pk2(v0[0], v0[1]); w.y = pk2(v0[2], v0[3]); w.z = pk2(v1[0], v1[1]); w.w = pk2(v1[2], v1[3]);
                    __builtin_nontemporal_store(w, (u32x4*)(rowp + bj * 128)); } } }
    }
};
struct EpiMerge {
    static constexpr bool PERM = true, AFTER_DRAIN = false; static constexpr int MIDT = 8;
    const bf16_t* GA; const bf16_t* GB; bf16_t* O;
    __device__ __forceinline__ void mid(f32x4 (&acc)[2][2][4][2], const pg8::Unit& u, int wr, int wc, int fr, int fq) const {
        int row0 = u.pm * 256 + wr * 64 + fr; const int col0 = u.pn * 256 + wc * 32 + 8 * fq; int tix = ((wr * 4 + wc) * 4 + fq) * 16 + fr;
#pragma unroll
        for (int ai = 0; ai < 2; ++ai) {
            asm volatile("" : "+v"(row0), "+v"(tix));
            u32x4 g[4][2];
#pragma unroll
            for (int m = 0; m < 4; ++m)
#pragma unroll
                for (int bj = 0; bj < 2; ++bj) g[m][bj] = *(const u32x4*)((const unsigned char*)GA + (unsigned)((((u.pm * 8 + (2 * u.pn + bj)) * 8 + (ai * 4 + m)) * 512 + tix) * 16));
#pragma unroll
            for (int m = 0; m < 4; ++m)
#pragma unroll
                for (int bj = 0; bj < 2; ++bj) { const u32x4 a = g[m][bj]; f32x4& v0 = acc[ai][bj][m][0]; f32x4& v1 = acc[ai][bj][m][1];
                    v0[0] *= bflo(a.x); v0[1] *= bfhi(a.x); v0[2] *= bflo(a.y); v0[3] *= bfhi(a.y); v1[0] *= bflo(a.z); v1[1] *= bfhi(a.z); v1[2] *= bflo(a.w); v1[3] *= bfhi(a.w); }
            asm volatile("" ::: "memory"); }
    }
    __device__ __forceinline__ void operator()(const f32x4 (&acc)[2][2][4][2], const pg8::Unit& u, int wr, int wc, int fr, int fq) const {
        int row0 = u.pm * 256 + wr * 64 + fr; const int col0 = u.pn * 256 + wc * 32 + 8 * fq; int tix = ((wr * 4 + wc) * 4 + fq) * 16 + fr;
#pragma unroll
        for (int ai = 0; ai < 2; ++ai) {
            asm volatile("" : "+v"(row0), "+v"(tix));
            u32x4 g[4][2];
#pragma unroll
            for (int m = 0; m < 4; ++m)
#pragma unroll
                for (int bj = 0; bj < 2; ++bj) g[m][bj] = *(const u32x4*)((const unsigned char*)GB + (unsigned)((((u.pm * 8 + (2 * u.pn + bj)) * 8 + (ai * 4 + m)) * 512 + tix) * 16));
#pragma unroll
            for (int m = 0; m < 4; ++m) { const size_t off = (size_t)(row0 + ai * 128 + m * 16) * 1024 + col0;
#pragma unroll
                for (int bj = 0; bj < 2; ++bj) { const u32x4 gg = g[m][bj]; const f32x4 v0 = acc[ai][bj][m][0], v1 = acc[ai][bj][m][1];
                    u32x4 w; w.x = pk2(v0[0] * bflo(gg.x), v0[1] * bfhi(gg.x)); w.y = pk2(v0[2] * bflo(gg.y), v0[3] * bfhi(gg.y)); w.z = pk2(v1[0] * bflo(gg.z), v1[1] * bfhi(gg.z)); w.w = pk2(v1[2] * bflo(gg.w), v1[3] * bfhi(gg.w));
                    *(u32x4*)(O + off + bj * 128) = w; } }
            asm volatile("" ::: "memory"); }
    }
};
struct EpiOut {
    static constexpr bool PERM = true, AFTER_DRAIN = false; static constexpr int MIDT = 0;
    bf16_t* O; float* rowss;
    __device__ __forceinline__ void operator()(const f32x4 (&acc)[2][2][4][2], const pg8::Unit& u, int wr, int wc, int fr, int fq) const {
        const int row0 = u.pm * 256 + wr * 64 + fr, col0 = u.pn * 256 + wc * 32 + 8 * fq;
#pragma unroll
        for (int ai = 0; ai < 2; ++ai)
#pragma unroll
            for (int m = 0; m < 4; ++m) { const int row = row0 + ai * 128 + m * 16; const size_t off = (size_t)row * 1024 + col0; float s = 0.f;
#pragma unroll
                for (int bj = 0; bj < 2; ++bj) { const f32x4 v0 = acc[ai][bj][m][0], v1 = acc[ai][bj][m][1];
                    s += (v0[0] * v0[0] + v0[1] * v0[1]) + (v0[2] * v0[2] + v0[3] * v0[3]) + (v1[0] * v1[0] + v1[1] * v1[1]) + (v1[2] * v1[2] + v1[3] * v1[3]);
                    u32x4 w; w.x = pk2(v0[0], v0[1]); w.y = pk2(v0[2], v0[3]); w.z = pk2(v1[0], v1[1]); w.w = pk2(v1[2], v1[3]);
                    *(u32x4*)(O + off + bj * 128) = w; }
                s += __shfl_xor(s, 16); s += __shfl_xor(s, 32);
                if (fq == 0) rowss[(size_t)row * 16 + u.pn * 4 + wc] = s; }
    }
};

struct Args { const float* in[12]; float* out; unsigned char* ws; int ph_lo, ph_hi; };

struct Frame { LAS unsigned char* lds; int tid, lane, wave, G, bid; };

__device__ __forceinline__ int win_src(int np, float& sc) {
    sc = 1.f; const int tau = np >> 8, c = np & 255;
    if (tau < 18) { const int g = np / 1536, rem = np % 1536, t = rem / 512, hc = rem % 512, h = hc >> 7, d = hc & 127;
        int ds = d; if (t < 2) { const int grp = d >> 3, e = d & 7; ds = e < 2 ? e * 16 + grp : 32 + grp * 6 + (e - 2); }
        if (t == 0) sc = QSCALE;
        return g * 1536 + t * 512 + h * 128 + ds; }
    if (tau < 20) return 4608 + (np - 18 * 256);
    if (tau < 22) { sc = QSCALE; return 5120 + (np - 20 * 256); }
    if (tau < 24) return 5632 + (np - 22 * 256);
    if (tau < 28) return 6144 + (np - 24 * 256);
    if (tau == 28) return c < 32 ? 10240 + c : -1;
    if (tau < 33) return 7168 + (np - 29 * 256);
    { const int i = tau - 33; return c < 128 ? 8192 + 128 * i + c : 9216 + 128 * i + (c - 128); }
}
template <bool IS_WIN> __device__ __forceinline__ void transpose_item(const float* W, int K, int Nsrc, int Ndst, bf16_t* WT, LAS float* scr, int item, int lane, int ldd = 0, int koff = 0) {
    if (ldd == 0) ldd = K;
    const int nblk = Ndst / 32, kb = item / nblk, nb = item % nblk, k0 = 64 * kb, n0 = 32 * nb;
    const int np = n0 + (lane & 31); float sc = 1.f; int src = np; if (IS_WIN) src = win_src(np, sc);
#pragma unroll 8
    for (int i = 0; i < 32; ++i) { const int kk = 2 * i + (lane >> 5); float v = 0.f; if (src >= 0) v = W[(size_t)(k0 + kk) * Nsrc + src] * sc; scr[kk * 33 + (lane & 31)] = v; }
    asm volatile("s_waitcnt lgkmcnt(0)" ::: "memory");
    const int c = lane & 7;
#pragma unroll
    for (int j = 0; j < 4; ++j) { const int n = (lane >> 3) + 8 * j; const LAS float* s = scr + (8 * c) * 33 + n;
        u32x4 o; o.x = pk2(s[0 * 33], s[1 * 33]); o.y = pk2(s[2 * 33], s[3 * 33]); o.z = pk2(s[4 * 33], s[5 * 33]); o.w = pk2(s[6 * 33], s[7 * 33]);
        *(u32x4*)(WT + (size_t)(n0 + n) * ldd + koff + k0 + 8 * c) = o; }
    asm volatile("s_waitcnt lgkmcnt(0)" ::: "memory");
}
__device__ __forceinline__ void phase_prologue(const Frame& F, const Args& a) {
    LAS float* scr = (LAS float*)(F.lds + F.wave * 16384);
    const int gw = F.bid * NWAVES + F.wave, NGW = F.G * NWAVES;
    constexpr int I_WIN = 16 * (NWIN / 32), I_WA = 8 * 32, I_WB = 16 * 32, I_WO = 16 * 32, I_L = I_WIN + I_WA + I_WB + I_WO;
    for (int it = gw; it < 2 * I_L; it += NGW) {
        const int l = it / I_L; int r = it % I_L;
        if (r < I_WIN) { transpose_item<true>(a.in[2] + (size_t)l * 1024 * IN_DIM, 1024, IN_DIM, NWIN, (bf16_t*)(a.ws + WS_WIN + l * WIN_BYTES), scr, r, F.lane); continue; } r -= I_WIN;
        if (r < I_WA) { transpose_item<false>(a.in[8] + (size_t)l * 512 * 1024, 512, 1024, 1024, (bf16_t*)(a.ws + WS_WA + l * 3 * MiB), scr, r, F.lane, 1536, 0); continue; } r -= I_WA;
        if (r < I_WB) { transpose_item<false>(a.in[9] + (size_t)l * 1024 * 1024, 1024, 1024, 1024, (bf16_t*)(a.ws + WS_WA + l * 3 * MiB), scr, r, F.lane, 1536, 512); continue; } r -= I_WB;
        transpose_item<false>(a.in[10] + (size_t)l * 1024 * 1024, 1024, 1024, 1024, (bf16_t*)(a.ws + WS_WO + l * 2 * MiB), scr, r, F.lane);
    }
    float* rc = (float*)(a.ws + WS_ROPEC); float* rs = (float*)(a.ws + WS_ROPES);
    for (int e = F.bid * NTHR + F.tid; e < SEQ * 16; e += F.G * NTHR) { const int pos = e >> 4, i = e & 15;
        const float inv = (float)pow(500000.0, -(double)(2 * i) / 32.0); const float ang = (float)pos * inv;
        rc[e] = (float)cos((double)ang); rs[e] = (float)sin((double)ang); }
}

__device__ __forceinline__ void phase_prep(const Frame& F, const Args& a, int mode, const float* xprev, float* xout, const float* wpost, const float* wpre) {
    const int gw = F.bid * NWAVES + F.wave, NGW = F.G * NWAVES;
    const bf16_t* OUT = (const bf16_t*)(a.ws + X_OUT); const float* rowss = (const float*)(a.ws + WS_ROWSS); bf16_t* H = (bf16_t*)(a.ws + WS_H);
    f32x4 wpo[4], wpr[4];
#pragma unroll
    for (int j = 0; j < 4; ++j) { wpo[j] = (mode != 0) ? *((const f32x4*)wpost + F.lane + 64 * j) : (f32x4){0.f, 0.f, 0.f, 0.f}; wpr[j] = (mode != 2) ? *((const f32x4*)wpre + F.lane + 64 * j) : (f32x4){0.f, 0.f, 0.f, 0.f}; }
    for (int row0 = gw; row0 < T; row0 += 2 * NGW) {
        f32x4 v[2][4]; u32x2 ov[2][4]; float ssv[2];
#pragma unroll
        for (int rr = 0; rr < 2; ++rr) { const int row = row0 + rr * NGW; const f32x4* xr = (const f32x4*)(xprev + (size_t)row * DM) + F.lane;
#pragma unroll
            for (int j = 0; j < 4; ++j) v[rr][j] = __builtin_nontemporal_load(xr + 64 * j);
            if (mode != 0) { ssv[rr] = rowss[(size_t)row * 16 + (F.lane & 15)]; const u32x2* orow = (const u32x2*)(OUT + (size_t)row * DM) + F.lane;
#pragma unroll
                for (int j = 0; j < 4; ++j) ov[rr][j] = __builtin_nontemporal_load(orow + 64 * j); } }
#pragma unroll
        for (int rr = 0; rr < 2; ++rr) { const int row = row0 + rr * NGW;
            if (mode != 0) {
                float ss = ssv[rr];
                ss += __shfl_xor(ss, 1); ss += __shfl_xor(ss, 2); ss += __shfl_xor(ss, 4); ss += __shfl_xor(ss, 8);
                const float rstd = __builtin_amdgcn_rsqf(ss * (1.0f / DM) + NORM_EPS);
#pragma unroll
                for (int j = 0; j < 4; ++j) { const u32x2 o = ov[rr][j]; const f32x4 w = wpo[j];
                    v[rr][j][0] += bflo(o.x) * rstd * w[0]; v[rr][j][1] += bfhi(o.x) * rstd * w[1]; v[rr][j][2] += bflo(o.y) * rstd * w[2]; v[rr][j][3] += bfhi(o.y) * rstd * w[3]; }
                f32x4* xo = (f32x4*)(xout + (size_t)row * DM) + F.lane;
#pragma unroll
                for (int j = 0; j < 4; ++j) __builtin_nontemporal_store(v[rr][j], xo + 64 * j);
            }
            if (mode != 2) {
                float s = 0.f;
#pragma unroll
                for (int j = 0; j < 4; ++j) s += (v[rr][j][0] * v[rr][j][0] + v[rr][j][1] * v[rr][j][1]) + (v[rr][j][2] * v[rr][j][2] + v[rr][j][3] * v[rr][j][3]);
                const float rstd = __builtin_amdgcn_rsqf(wave_sum(s) * (1.0f / DM) + NORM_EPS);
                u32x2* ho = (u32x2*)(H + (size_t)row * DM) + F.lane;
#pragma unroll
                for (int j = 0; j < 4; ++j) { const f32x4 w = wpr[j]; u32x2 o;
                    o.x = pk2(v[rr][j][0] * rstd * w[0], v[rr][j][1] * rstd * w[1]); o.y = pk2(v[rr][j][2] * rstd * w[2], v[rr][j][3] * rstd * w[3]); ho[64 * j] = o; }
            }
        }
    }
}

#define LDS_BARRIER() do { asm volatile("s_waitcnt lgkmcnt(0)" ::: "memory"); __builtin_amdgcn_s_barrier(); asm volatile("" ::: "memory"); } while (0)
constexpr int GP_Q = 0, GP_K = 65536, GP_LR = 131072;
__device__ __forceinline__ void phase_gla_pre(const Frame& F, const Args& a, int layer) {
    const int tid = F.tid, dir = tid >> 8, c2 = (tid & 255) * 2;
    LAS unsigned char* lds = F.lds;
    const float* LR = (const float*)(a.ws + WS_LR);
    bf16_t* GQ = (bf16_t*)(a.ws + X_GQ); bf16_t* GK = (bf16_t*)(a.ws + X_GK);
    bf16_t* QDo = dir ? GQ : (bf16_t*)(a.ws + X_BF); bf16_t* KIo = dir ? GK : (bf16_t*)(a.ws + X_BB);
    float* DEC = (float*)(a.ws + WS_ROWSS);
    const float* Wup = (dir ? a.in[5] : a.in[3]) + (size_t)layer * 16 * 512; const float* bias = (dir ? a.in[6] : a.in[4]) + (size_t)layer * 512;
    f32x2 w[16];
#pragma unroll
    for (int i = 0; i < 16; ++i) w[i] = *(const f32x2*)(Wup + i * 512 + c2);
    const f32x2 bz = *(const f32x2*)(bias + c2);
    for (int item = F.bid; item < NB * 64; item += F.G) {
        const size_t tok0 = (size_t)item * 64;
        __syncthreads();
#pragma unroll
        for (int i = 0; i < 8; ++i) { const int c = tid + 512 * i, r = c >> 6, ch = c & 63;
            *(LAS u32x4*)(lds + GP_Q + r * 1024 + ch * 16) = __builtin_nontemporal_load((const u32x4*)(GQ + (tok0 + r) * 512 + ch * 8));
            *(LAS u32x4*)(lds + GP_K + r * 1024 + ch * 16) = __builtin_nontemporal_load((const u32x4*)(GK + (tok0 + r) * 512 + ch * 8)); }
        *(LAS f32x4*)(lds + GP_LR + 16 * tid) = *(const f32x4*)(LR + tok0 * 32 + 4 * tid);
        __syncthreads();
        f32x2 accum = {0.f, 0.f};
#pragma unroll 4
        for (int s0 = 0; s0 < 64; ++s0) { const int t = dir ? 63 - s0 : s0;
            const LAS f32x4* lr4 = (const LAS f32x4*)(lds + GP_LR + t * 128 + dir * 64);
            f32x2 xa = bz, xb = {0.f, 0.f}, xc = {0.f, 0.f}, xd = {0.f, 0.f};
            { const f32x4 l0 = lr4[0], l1 = lr4[1], l2 = lr4[2], l3 = lr4[3];
              xa += w[0] * l0[0]; xb += w[4] * l1[0]; xc += w[8] * l2[0]; xd += w[12] * l3[0];
              xa += w[1] * l0[1]; xb += w[5] * l1[1]; xc += w[9] * l2[1]; xd += w[13] * l3[1];
              xa += w[2] * l0[2]; xb += w[6] * l1[2]; xc += w[10] * l2[2]; xd += w[14] * l3[2];
              xa += w[3] * l0[3]; xb += w[7] * l1[3]; xc += w[11] * l2[3]; xd += w[15] * l3[3]; }
            const f32x2 x = (xa + xb) + (xc + xd);
            const float ls0 = fminf(x[0], 0.f) - 0.6931471805599453f * __builtin_amdgcn_logf(1.0f + __builtin_amdgcn_exp2f(-1.4426950408889634f * fabsf(x[0])));
            const float ls1 = fminf(x[1], 0.f) - 0.6931471805599453f * __builtin_amdgcn_logf(1.0f + __builtin_amdgcn_exp2f(-1.4426950408889634f * fabsf(x[1])));
            accum[0] += ls0 * (1.0f / 16.0f); accum[1] += ls1 * (1.0f / 16.0f);
            const float e0 = __builtin_amdgcn_exp2f(1.4426950408889634f * accum[0]), e1 = __builtin_amdgcn_exp2f(1.4426950408889634f * accum[1]);
            const float i0 = __builtin_amdgcn_rcpf(e0), i1 = __builtin_amdgcn_rcpf(e1);
            const unsigned qw = *(const LAS unsigned*)(lds + GP_Q + t * 1024 + c2 * 2), kw = *(const LAS unsigned*)(lds + GP_K + t * 1024 + c2 * 2);
            *(unsigned*)(QDo + (tok0 + t) * 512 + c2) = pk2(bflo(qw) * e0, bfhi(qw) * e1);
            *(unsigned*)(KIo + (tok0 + t) * 512 + c2) = pk2(bflo(kw) * i0, bfhi(kw) * i1);
        }
        *(f32x2*)(DEC + ((size_t)dir * NB * 64 + item) * 512 + c2) = (f32x2){__builtin_amdgcn_exp2f(1.4426950408889634f * accum[0]), __builtin_amdgcn_exp2f(1.4426950408889634f * accum[1])};
    }
}

constexpr int GS_STR = 272, GS_KSTR = 288, GS_VSTR = 160;
constexpr int GS_QD = 0, GS_KI = 64 * GS_STR, GS_V = GS_KI + 64 * GS_KSTR, GS_DEC = GS_V + 64 * GS_VSTR, GS_BUF = GS_DEC + 512;
constexpr int GS_ST = 2 * GS_BUF, GS_STB = 64 * GS_STR;
__device__ __forceinline__ s16x4 trread(const LAS unsigned char* p) { return __builtin_bit_cast(s16x4, __builtin_amdgcn_ds_read_tr16_b64_v4i16((LAS s16x4*)p)); }
__device__ __forceinline__ bf16x8 cat8(s16x4 lo, s16x4 hi) { return (bf16x8){lo[0], lo[1], lo[2], lo[3], hi[0], hi[1], hi[2], hi[3]}; }
__device__ __forceinline__ bf16x8 pack8(const f32x4& a, const f32x4& b) { u32x4 w; w.x = pk2(a[0], a[1]); w.y = pk2(a[2], a[3]); w.z = pk2(b[0], b[1]); w.w = pk2(b[2], b[3]); return __builtin_bit_cast(bf16x8, w); }

#define GS_LANE_VARS() const int lane = lane0, fr = lane & 15, fq = lane >> 4; (void)fr; (void)fq
#define GS_LOAD_CHUNK(ch) do { const int ch_ = (ch); const unsigned char* q_ = qdb + (size_t)ch_ * 65536 + lqk; const unsigned char* k_ = kib + (size_t)ch_ * 65536 + lqk; const unsigned char* v_ = gvb + (size_t)ch_ * 65536 + lv; \
        pq[0] = *(const u32x4*)(q_); pq[1] = *(const u32x4*)(q_ + 128); pq[2] = *(const u32x4*)(q_ + 8192); pq[3] = *(const u32x4*)(q_ + 8192 + 128); \
        pk[0] = *(const u32x4*)(k_); pk[1] = *(const u32x4*)(k_ + 128); pk[2] = *(const u32x4*)(k_ + 8192); pk[3] = *(const u32x4*)(k_ + 8192 + 128); \
        pv[0] = __builtin_nontemporal_load((const u32x4*)(v_)); pv[1] = __builtin_nontemporal_load((const u32x4*)(v_ + 8192)); \
        if (lane < 32) pdec = *(const float*)(decb + (size_t)ch_ * 2048 + (32 * sw + lane) * 4); } while (0)
#define GS_STAGE(bufi) do { LAS unsigned char* nl_ = F.lds + (bufi) * GS_BUF; LAS unsigned char* p_ = nl_ + GS_QD + ra * GS_STR + ci; LAS unsigned char* k2_ = nl_ + GS_KI + ra * GS_KSTR + ci; LAS unsigned char* v2_ = nl_ + GS_V + ra * GS_VSTR + ci; \
        *(LAS u32x4*)(p_) = pq[0]; *(LAS u32x4*)(p_ + 128) = pq[1]; *(LAS u32x4*)(p_ + 8 * GS_STR) = pq[2]; *(LAS u32x4*)(p_ + 8 * GS_STR + 128) = pq[3]; \
        *(LAS u32x4*)(k2_) = pk[0]; *(LAS u32x4*)(k2_ + 128) = pk[1]; *(LAS u32x4*)(k2_ + 8 * GS_KSTR) = pk[2]; *(LAS u32x4*)(k2_ + 8 * GS_KSTR + 128) = pk[3]; \
        *(LAS u32x4*)(v2_) = pv[0]; *(LAS u32x4*)(v2_ + 8 * GS_VSTR) = pv[1]; if (lane < 32) *(LAS float*)(nl_ + GS_DEC + (32 * sw + lane) * 4) = pdec; } while (0)
#define GS_STAGE_VARS() const int ra = 16 * sw + (lane >> 3), ci = (lane & 7) * 16; const unsigned lqk = (unsigned)(ra * 1024 + ci), lv = lqk

__device__ __forceinline__ void phase_gla_scan(const Frame& F, const Args& a) {
    const int lane0 = F.lane, wid = F.wave;
    for (int u = F.bid; u < 256; u += F.G) {
        const int slot = u >> 3, dvq = slot & 3, grp = (u & 7) * 8 + (slot >> 2), dir = grp & 1, h = (grp >> 1) & 3, b = grp >> 3;
        const unsigned char* qdb = a.ws + (dir ? X_GQ : X_BF) + ((size_t)b * SEQ * 512 + h * 128) * 2; const unsigned char* kib = a.ws + (dir ? X_GK : X_BB) + ((size_t)b * SEQ * 512 + h * 128) * 2;
        const unsigned char* gvb = a.ws + (h < 2 ? X_GVL : X_GVH) + ((size_t)b * SEQ * 512 + (h & 1) * 256 + dvq * 64) * 2;
        const unsigned char* decb = a.ws + WS_ROWSS + (((size_t)dir * NB * 64 + (size_t)b * 64) * 512 + h * 128) * 4;
        const int OLD = dir ? 1024 : OF_LD;
        unsigned char* ob = a.ws + (dir ? X_OB : X_OF) + ((size_t)b * SEQ * OLD + (dir ? 0 : OF_C0) + h * 256 + dvq * 64) * 2;
        __syncthreads();
        {   GS_LANE_VARS(); const int tid = wid * 64 + lane;
            LAS unsigned char* p = F.lds + GS_ST + (tid >> 3) * GS_STR + (tid & 7) * 16; *(LAS u32x4*)p = (u32x4){0u, 0u, 0u, 0u}; *(LAS u32x4*)(p + 128) = (u32x4){0u, 0u, 0u, 0u}; }
        if (wid < 4) {
            const int cb = wid;
            const int sA = dir ? 1 : 0, sB = 1 - sA;
            const bool both = dir ? (cb <= 1) : (cb >= 2);
            float mk[2][4];
            {   GS_LANE_VARS(); const int sD = both ? sB : sA, c = 16 * cb + fr;
#pragma unroll
                for (int jj = 0; jj < 2; ++jj)
#pragma unroll
                    for (int r = 0; r < 4; ++r) { const int j = 32 * sD + 16 * jj + 4 * fq + r; mk[jj][r] = (dir ? (j > c) : (j <= c)) ? 1.f : 0.f; } }
            u32x2 ow[4] = {{0u, 0u}, {0u, 0u}, {0u, 0u}, {0u, 0u}}; unsigned char* oc = ob;
            __syncthreads();
            for (int step = 0; step < 64; ++step) {
                GS_LANE_VARS();
                const int chunk = dir ? 63 - step : step;
                const LAS unsigned char* lds = F.lds + (step & 1) * GS_BUF;
                const LAS unsigned char* stR = F.lds + GS_ST + (step & 1) * GS_STB;
                bf16x8 qb[4], stf[4][4], kaA[2][4], kaB[2][4], viA[4], viB[4];
#pragma unroll
                for (int ks = 0; ks < 4; ++ks) qb[ks] = *(const LAS bf16x8*)(lds + GS_QD + (16 * cb + fr) * GS_STR + (32 * ks + 8 * fq) * 2);
#pragma unroll
                for (int jj = 0; jj < 2; ++jj)
#pragma unroll
                    for (int ks = 0; ks < 4; ++ks) kaA[jj][ks] = *(const LAS bf16x8*)(lds + GS_KI + (32 * sA + 16 * jj + fr) * GS_KSTR + (32 * ks + 8 * fq) * 2);
                if (both) {
#pragma unroll
                    for (int jj = 0; jj < 2; ++jj)
#pragma unroll
                        for (int ks = 0; ks < 4; ++ks) kaB[jj][ks] = *(const LAS bf16x8*)(lds + GS_KI + (32 * sB + 16 * jj + fr) * GS_KSTR + (32 * ks + 8 * fq) * 2);
                }
#pragma unroll
                for (int t = 0; t < 4; ++t)
#pragma unroll
                    for (int ks = 0; ks < 4; ++ks) stf[t][ks] = *(const LAS bf16x8*)(stR + (16 * t + fr) * GS_STR + (32 * ks + 8 * fq) * 2);
                const LAS unsigned char* vb = lds + GS_V + (4 * fq + (fr >> 2)) * GS_VSTR + (4 * (fr & 3)) * 2;
#pragma unroll
                for (int t = 0; t < 4; ++t) viA[t] = cat8(trread(vb + (32 * sA) * GS_VSTR + 32 * t), trread(vb + (32 * sA + 16) * GS_VSTR + 32 * t));
                if (both) {
#pragma unroll
                    for (int t = 0; t < 4; ++t) viB[t] = cat8(trread(vb + (32 * sB) * GS_VSTR + 32 * t), trread(vb + (32 * sB + 16) * GS_VSTR + 32 * t));
                }
                if (step > 0) { const unsigned lo = (unsigned)((16 * cb + fr) * OLD + 4 * fq) * 2u;
#pragma unroll
                    for (int t = 0; t < 4; ++t) __builtin_nontemporal_store(ow[t], (u32x2*)(oc + lo + 32 * t)); }
                f32x4 atA[2] = {(f32x4){0.f, 0.f, 0.f, 0.f}, (f32x4){0.f, 0.f, 0.f, 0.f}}, atB[2] = {(f32x4){0.f, 0.f, 0.f, 0.f}, (f32x4){0.f, 0.f, 0.f, 0.f}};
#pragma unroll
                for (int ks = 0; ks < 4; ++ks)
#pragma unroll
                    for (int jj = 0; jj < 2; ++jj) atA[jj] = __builtin_amdgcn_mfma_f32_16x16x32_bf16(kaA[jj][ks], qb[ks], atA[jj], 0, 0, 0);
                if (both) {
#pragma unroll
                    for (int ks = 0; ks < 4; ++ks)
#pragma unroll
                        for (int jj = 0; jj < 2; ++jj) atB[jj] = __builtin_amdgcn_mfma_f32_16x16x32_bf16(kaB[jj][ks], qb[ks], atB[jj], 0, 0, 0);
                }
                f32x4 oT[4];
#pragma unroll
                for (int t = 0; t < 4; ++t) oT[t] = (f32x4){0.f, 0.f, 0.f, 0.f};
#pragma unroll
                for (int ks = 0; ks < 4; ++ks)
#pragma unroll
                    for (int t = 0; t < 4; ++t) oT[t] = __builtin_amdgcn_mfma_f32_16x16x32_bf16(stf[t][ks], qb[ks], oT[t], 0, 0, 0);
                if (both) {
#pragma unroll
                    for (int jj = 0; jj < 2; ++jj)
#pragma unroll
                        for (int r = 0; r < 4; ++r) atB[jj][r] *= mk[jj][r];
                    const bf16x8 pfA = pack8(atA[0], atA[1]), pfB = pack8(atB[0], atB[1]);
#pragma unroll
                    for (int t = 0; t < 4; ++t) oT[t] = __builtin_amdgcn_mfma_f32_16x16x32_bf16(viA[t], pfA, oT[t], 0, 0, 0);
#pragma unroll
                    for (int t = 0; t < 4; ++t) oT[t] = __builtin_amdgcn_mfma_f32_16x16x32_bf16(viB[t], pfB, oT[t], 0, 0, 0);
                } else {
#pragma unroll
                    for (int jj = 0; jj < 2; ++jj)
#pragma unroll
                        for (int r = 0; r < 4; ++r) atA[jj][r] *= mk[jj][r];
                    const bf16x8 pfA = pack8(atA[0], atA[1]);
#pragma unroll
                    for (int t = 0; t < 4; ++t) oT[t] = __builtin_amdgcn_mfma_f32_16x16x32_bf16(viA[t], pfA, oT[t], 0, 0, 0);
                }
#pragma unroll
                for (int t = 0; t < 4; ++t) { ow[t].x = pk2(oT[t][0], oT[t][1]); ow[t].y = pk2(oT[t][2], oT[t][3]); }
                oc = ob + (size_t)chunk * 64 * OLD * 2;
                LDS_BARRIER();
            }
            {   GS_LANE_VARS(); const unsigned lo = (unsigned)((16 * cb + fr) * OLD + 4 * fq) * 2u;
#pragma unroll
                for (int t = 0; t < 4; ++t) *(u32x2*)(oc + lo + 32 * t) = ow[t]; }
        } else {
            const int sw = wid - 4;
            u32x4 pq[4], pk[4], pv[2]; float pdec = 0.f;
            {   GS_LANE_VARS(); GS_STAGE_VARS(); GS_LOAD_CHUNK(dir ? 63 : 0); GS_STAGE(0); GS_LOAD_CHUNK(dir ? 62 : 1); }
            f32x4 S[2][4];
#pragma unroll
            for (int d = 0; d < 2; ++d)
#pragma unroll
                for (int t = 0; t < 4; ++t) S[d][t] = (f32x4){0.f, 0.f, 0.f, 0.f};
            __syncthreads();
            for (int step = 0; step < 64; ++step) {
                GS_LANE_VARS();
                const LAS unsigned char* lds = F.lds + (step & 1) * GS_BUF;
                LAS unsigned char* stW = F.lds + GS_ST + ((step + 1) & 1) * GS_STB;
                bf16x8 kef[2][2], vi[4][2];
                const LAS unsigned char* vb = lds + GS_V + (4 * fq + (fr >> 2)) * GS_VSTR + (4 * (fr & 3)) * 2;
#pragma unroll
                for (int t = 0; t < 4; ++t) { vi[t][0] = cat8(trread(vb + 32 * t), trread(vb + 16 * GS_VSTR + 32 * t)); vi[t][1] = cat8(trread(vb + 32 * GS_VSTR + 32 * t), trread(vb + 48 * GS_VSTR + 32 * t)); }
#pragma unroll
                for (int d = 0; d < 2; ++d) { const LAS unsigned char* kb = lds + GS_KI + (4 * fq + (fr >> 2)) * GS_KSTR + (32 * sw + 16 * d + 4 * (fr & 3)) * 2;
                    kef[d][0] = cat8(trread(kb), trread(kb + 16 * GS_KSTR)); kef[d][1] = cat8(trread(kb + 32 * GS_KSTR), trread(kb + 48 * GS_KSTR)); }
                f32x4 dcv[2];
#pragma unroll
                for (int d = 0; d < 2; ++d) dcv[d] = *(const LAS f32x4*)(lds + GS_DEC + (32 * sw + 16 * d + 4 * fq) * 4);
#pragma unroll
                for (int sidx = 0; sidx < 2; ++sidx)
#pragma unroll
                    for (int d = 0; d < 2; ++d)
#pragma unroll
                        for (int t = 0; t < 4; ++t) S[d][t] = __builtin_amdgcn_mfma_f32_16x16x32_bf16(kef[d][sidx], vi[t][sidx], S[d][t], 0, 0, 0);
#pragma unroll
                for (int d = 0; d < 2; ++d)
#pragma unroll
                    for (int t = 0; t < 4; ++t) { S[d][t] = S[d][t] * dcv[d]; u32x2 w; w.x = pk2(S[d][t][0], S[d][t][1]); w.y = pk2(S[d][t][2], S[d][t][3]);
                        *(LAS u32x2*)(stW + (16 * t + fr) * GS_STR + (32 * sw + 16 * d + 4 * fq) * 2) = w; }
                {   GS_STAGE_VARS();
                    if (step < 63) GS_STAGE((step + 1) & 1);
                    if (step < 62) GS_LOAD_CHUNK(dir ? 61 - step : step + 2); }
                LDS_BARRIER();
            }
        }
    }
}

__device__ __forceinline__ void phase_comb_b(const Frame& F, const Args& a, int layer) {
    const int gw = F.bid * NWAVES + F.wave, NGW = F.G * NWAVES;
    bf16_t* OF = (bf16_t*)(a.ws + X_OF); const bf16_t* OB = (const bf16_t*)(a.ws + X_OB); const bf16_t* ZB = (const bf16_t*)(a.ws + X_ZB);
    const float* wn = a.in[7] + (size_t)layer * 256 + 8 * (F.lane & 31);
    const f32x4 w0 = *(const f32x4*)wn, w1 = *(const f32x4*)(wn + 4);
    for (int tok0 = gw; tok0 < T; tok0 += 2 * NGW) {
        u32x4 f[4], bq[4], z[4];
#pragma unroll
        for (int q = 0; q < 4; ++q) { const int tok = tok0 + (q >> 1) * NGW, hh = q & 1; const size_t off = (size_t)tok * 1024 + hh * 512 + 8 * F.lane, offf = (size_t)tok * OF_LD + OF_C0 + hh * 512 + 8 * F.lane;
            f[q] = __builtin_nontemporal_load((const u32x4*)(OF + offf)); bq[q] = __builtin_nontemporal_load((const u32x4*)(OB + off)); z[q] = __builtin_nontemporal_load((const u32x4*)(ZB + off)); }
#pragma unroll
        for (int q = 0; q < 4; ++q) { const int tok = tok0 + (q >> 1) * NGW, hh = q & 1; const size_t offf = (size_t)tok * OF_LD + OF_C0 + hh * 512 + 8 * F.lane;
            float o[8];
            o[0] = bflo(f[q].x) + bflo(bq[q].x); o[1] = bfhi(f[q].x) + bfhi(bq[q].x); o[2] = bflo(f[q].y) + bflo(bq[q].y); o[3] = bfhi(f[q].y) + bfhi(bq[q].y);
            o[4] = bflo(f[q].z) + bflo(bq[q].z); o[5] = bfhi(f[q].z) + bfhi(bq[q].z); o[6] = bflo(f[q].w) + bflo(bq[q].w); o[7] = bfhi(f[q].w) + bfhi(bq[q].w);
            float ss = (o[0] * o[0] + o[1] * o[1]) + (o[2] * o[2] + o[3] * o[3]) + (o[4] * o[4] + o[5] * o[5]) + (o[6] * o[6] + o[7] * o[7]);
            ss += __shfl_xor(ss, 1); ss += __shfl_xor(ss, 2); ss += __shfl_xor(ss, 4); ss += __shfl_xor(ss, 8); ss += __shfl_xor(ss, 16);
            const float rstd = __builtin_amdgcn_rsqf(ss * (1.0f / 256.0f) + NORM_EPS);
            u32x4 y;
            y.x = pk2(o[0] * rstd * w0[0] * siluf_(bflo(z[q].x)), o[1] * rstd * w0[1] * siluf_(bfhi(z[q].x))); y.y = pk2(o[2] * rstd * w0[2] * siluf_(bflo(z[q].y)), o[3] * rstd * w0[3] * siluf_(bfhi(z[q].y)));
            y.z = pk2(o[4] * rstd * w1[0] * siluf_(bflo(z[q].z)), o[5] * rstd * w1[1] * siluf_(bfhi(z[q].z))); y.w = pk2(o[6] * rstd * w1[2] * siluf_(bflo(z[q].w)), o[7] * rstd * w1[3] * siluf_(bfhi(z[q].w)));
            *(u32x4*)(OF + offf) = y; }
    }
}

__device__ __forceinline__ void phase_comb_a(const Frame& F, const Args& a, int ch0, int nch) {
    const float* LSE = (const float*)(a.ws + WS_LSE); const bf16_t* ZA = (const bf16_t*)(a.ws + X_ZA); bf16_t* YA = (bf16_t*)(a.ws + X_OF);
    const int head = F.lane >> 4;
    for (int ch = ch0; ch < ch0 + nch; ++ch) {
#pragma unroll 1
        for (int trip = 0; trip < 2; ++trip) {
            const int tokb = ch * 32 + F.wave + 16 * trip;
            float l0[2], l1[2], l2[2]; u32x4 a0[2], a1[2], a2[2], z[2];
#pragma unroll
            for (int rr = 0; rr < 2; ++rr) { const int tok = tokb + 8 * rr; const size_t off = (size_t)tok * 512 + 8 * F.lane;
                const int sq = tok & (SEQ - 1), bb = tok & ~(SEQ - 1); const int t1 = bb | ((sq & 3) << 10) | (sq >> 2), t2 = bb | ((sq & 15) << 8) | (sq >> 4);
                const size_t off1 = (size_t)t1 * 512 + 8 * F.lane, off2 = (size_t)t2 * 512 + 8 * F.lane;
                l0[rr] = LSE[(size_t)tok * 4 + head]; l1[rr] = LSE[(size_t)T * 4 + (size_t)t1 * 4 + head]; l2[rr] = LSE[(size_t)2 * T * 4 + (size_t)t2 * 4 + head];
                a0[rr] = __builtin_nontemporal_load((const u32x4*)((const bf16_t*)(a.ws + X_QO) + off)); a1[rr] = __builtin_nontemporal_load((const u32x4*)((const bf16_t*)(a.ws + X_QO + 32 * MiB) + off1)); a2[rr] = __builtin_nontemporal_load((const u32x4*)((const bf16_t*)(a.ws + X_QO + 64 * MiB) + off2));
                z[rr] = __builtin_nontemporal_load((const u32x4*)(ZA + off)); }
#pragma unroll
            for (int rr = 0; rr < 2; ++rr) { const int tok = tokb + 8 * rr;
                const float mx = fmaxf(l0[rr], fmaxf(l1[rr], l2[rr]));
                float w0 = __builtin_amdgcn_exp2f(1.4426950408889634f * (l0[rr] - mx)), w1 = __builtin_amdgcn_exp2f(1.4426950408889634f * (l1[rr] - mx)), w2 = __builtin_amdgcn_exp2f(1.4426950408889634f * (l2[rr] - mx));
                const float inv = __builtin_amdgcn_rcpf(w0 + w1 + w2); w0 *= inv; w1 *= inv; w2 *= inv;
                const u32x4 p = a0[rr], q = a1[rr], r = a2[rr], zz = z[rr];
                u32x4 y;
                y.x = pk2((w0 * bflo(p.x) + w1 * bflo(q.x) + w2 * bflo(r.x)) * siluf_(bflo(zz.x)), (w0 * bfhi(p.x) + w1 * bfhi(q.x) + w2 * bfhi(r.x)) * siluf_(bfhi(zz.x)));
                y.y = pk2((w0 * bflo(p.y) + w1 * bflo(q.y) + w2 * bflo(r.y)) * siluf_(bflo(zz.y)), (w0 * bfhi(p.y) + w1 * bfhi(q.y) + w2 * bfhi(r.y)) * siluf_(bfhi(zz.y)));
                y.z = pk2((w0 * bflo(p.z) + w1 * bflo(q.z) + w2 * bflo(r.z)) * siluf_(bflo(zz.z)), (w0 * bfhi(p.z) + w1 * bfhi(q.z) + w2 * bfhi(r.z)) * siluf_(bfhi(zz.z)));
                y.w = pk2((w0 * bflo(p.w) + w1 * bflo(q.w) + w2 * bflo(r.w)) * siluf_(bflo(zz.w)), (w0 * bfhi(p.w) + w1 * bfhi(q.w) + w2 * bfhi(r.w)) * siluf_(bfhi(zz.w)));
                *(u32x4*)(YA + (size_t)tok * OF_LD + 8 * F.lane) = y; }
        }
    }
}

constexpr int AT_STR = 272, AT_VSTR = 288, AT_K = 0, AT_V = 256 * AT_STR;
__device__ __forceinline__ void phase_attn(const Frame& F, const Args& a, unsigned* qctr) {
    const int tid = F.tid, lane = F.lane, wid = F.wave, fr = lane & 15, fq = lane >> 4;
    LAS unsigned char* lds = F.lds;
    constexpr int NU = 3072, NRUN = NU / 4;
    u32x4 pk[8], pv[8];
    auto geom = [&](int ug, int& g, int& d, int& L, int& r, int& jj, int& h, int& b) { g = ug >> 10; const int u = ug & 1023; d = (g == 0) ? 1 : (g == 1 ? 4 : 16); L = SEQ / d; const int upc = L / 128;
        const int cls = u & 31; r = cls / upc; jj = cls % upc; h = (u >> 5) & 3; b = u >> 7; };
    auto prefetch = [&](int ug, bool reuse) {
        int g, d, L, r, jj, h, b; geom(ug, g, d, L, r, jj, h, b);
        const bf16_t* KA = (const bf16_t*)(a.ws + X_KA + (size_t)g * 32 * MiB); const bf16_t* VA = (const bf16_t*)(a.ws + X_VA + (size_t)g * 32 * MiB);
        const int tk0 = 128 * jj - 64; const size_t tokb = (size_t)b * SEQ + (size_t)r * L;
        if (!reuse) {
#pragma unroll
            for (int i = 0; i < 4; ++i) { const int c = tid + 512 * i, row = c >> 4, ch = c & 15, tk = tk0 + row; const int tkc = tk < 0 ? 0 : (tk >= L ? L - 1 : tk);
                const size_t go = (tokb + (size_t)tkc) * 512 + h * 128 + ch * 8; pk[i] = *(const u32x4*)(KA + go); pv[i] = *(const u32x4*)(VA + go); } }
#pragma unroll
        for (int i = 4; i < 8; ++i) { const int c = tid + 512 * i, row = c >> 4, ch = c & 15, tk = tk0 + row; const int tkc = tk < 0 ? 0 : (tk >= L ? L - 1 : tk);
            const size_t go = (tokb + (size_t)tkc) * 512 + h * 128 + ch * 8; pk[i] = *(const u32x4*)(KA + go); pv[i] = *(const u32x4*)(VA + go); }
    };
    volatile LAS unsigned* qslot = (volatile LAS unsigned*)(F.lds + LDS_BYTES - 256 + 64);
    int R = F.bid;
    if (R < NRUN) prefetch(4 * R, false);
    while (R < NRUN) {
      int Rn = NRUN;
#pragma unroll 1
      for (int k = 0; k < 4; ++k) {
        const int ug = 4 * R + k;
        int g, d, L, r, jj, h, b; geom(ug, g, d, L, r, jj, h, b);
        const bool reuse = (k > 0) && (jj > 0);
        bf16_t* QO = (bf16_t*)(a.ws + X_QO + (size_t)g * 32 * MiB); float* LSEg = (float*)(a.ws + WS_LSE) + (size_t)g * T * 4;
        const int t0 = 128 * jj, tk0 = t0 - 64;
        const size_t tokb = (size_t)b * SEQ + (size_t)r * L;
        LDS_BARRIER();
        if (k == 3) Rn = (int)*qslot;
        if (!reuse) {
#pragma unroll
            for (int i = 0; i < 4; ++i) { const int c = tid + 512 * i, slot = (tk0 + (c >> 4)) & 255, ch = c & 15;
                *(LAS u32x4*)(lds + AT_K + slot * AT_STR + ch * 16) = pk[i]; *(LAS u32x4*)(lds + AT_V + slot * AT_VSTR + ch * 16) = pv[i]; } }
#pragma unroll
        for (int i = 4; i < 8; ++i) { const int c = tid + 512 * i, slot = (tk0 + (c >> 4)) & 255, ch = c & 15;
            *(LAS u32x4*)(lds + AT_K + slot * AT_STR + ch * 16) = pk[i]; *(LAS u32x4*)(lds + AT_V + slot * AT_VSTR + ch * 16) = pv[i]; }
        const int tq = t0 + 16 * wid + fr; const size_t qoff = (tokb + (size_t)tq) * 512 + h * 128;
        bf16x8 qf[4];
#pragma unroll
        for (int ks = 0; ks < 4; ++ks) qf[ks] = *(const bf16x8*)(QO + qoff + 32 * ks + 8 * fq);
        if (k < 3) { int g2, d2, L2, r2, jj2, h2, b2; geom(ug + 1, g2, d2, L2, r2, jj2, h2, b2); prefetch(ug + 1, jj2 > 0); }
        else if (Rn < NRUN) prefetch(4 * Rn, false);
        LDS_BARRIER();
        unsigned pulled = (unsigned)NRUN; if (k == 0 && tid == 0) pulled = (unsigned)F.G + __hip_atomic_fetch_add(qctr, 1u, __ATOMIC_RELAXED, __HIP_MEMORY_SCOPE_AGENT);
        f32x4 s[10]; float m = -1e30f;
        const LAS unsigned char* kbase = lds + AT_K + fr * AT_STR + (8 * fq) * 2;
        const int ktile0 = tk0 + 16 * wid;
        bf16x8 kfa[8], kfb[8];
#define LOADK(dst, kt0) do { _Pragma("unroll") for (int q_ = 0; q_ < 8; ++q_) { const int kt_ = (kt0) + (q_ >> 2); if (kt_ < 9) dst[q_] = *(const LAS bf16x8*)(kbase + ((ktile0 + 16 * kt_) & 255) * AT_STR + (q_ & 3) * 64); } } while (0)
#define MMAK(src, kt0) do { _Pragma("unroll") for (int q_ = 0; q_ < 8; ++q_) { const int kt_ = (kt0) + (q_ >> 2); if (kt_ < 9) s[kt_] = __builtin_amdgcn_mfma_f32_16x16x32_bf16(src[q_], qf[q_ & 3], s[kt_], 0, 0, 0); } } while (0)
#pragma unroll
        for (int kt = 0; kt < 10; ++kt) s[kt] = (f32x4){0.f, 0.f, 0.f, 0.f};
        LOADK(kfa, 0); __builtin_amdgcn_sched_barrier(0);
        LOADK(kfb, 2); __builtin_amdgcn_sched_barrier(0); MMAK(kfa, 0); __builtin_amdgcn_sched_barrier(0);
        LOADK(kfa, 4); __builtin_amdgcn_sched_barrier(0); MMAK(kfb, 2); __builtin_amdgcn_sched_barrier(0);
        LOADK(kfb, 6); __builtin_amdgcn_sched_barrier(0); MMAK(kfa, 4); __builtin_amdgcn_sched_barrier(0);
        LOADK(kfa, 8); __builtin_amdgcn_sched_barrier(0); MMAK(kfb, 6); __builtin_amdgcn_sched_barrier(0);
        MMAK(kfa, 8);
#undef LOADK
#undef MMAK
#pragma unroll
        for (int kt = 0; kt < 9; ++kt)
#pragma unroll
            for (int rg = 0; rg < 4; ++rg) { const int diff = 16 * kt + 4 * fq + rg - 64 - fr, tk = tk0 + 16 * wid + 16 * kt + 4 * fq + rg;
                const bool valid = (diff >= -64) && (diff <= 64) && (tk >= 0) && (tk < L);
                if (!valid) s[kt][rg] = -1e30f; m = fmaxf(m, s[kt][rg]); }
        m = fmaxf(m, __shfl_xor(m, 16)); m = fmaxf(m, __shfl_xor(m, 32));
        float l = 0.f;
#pragma unroll
        for (int kt = 0; kt < 9; ++kt)
#pragma unroll
            for (int rg = 0; rg < 4; ++rg) { const float p = __builtin_amdgcn_exp2f(1.4426950408889634f * (s[kt][rg] - m)); s[kt][rg] = p; l += p; }
        l += __shfl_xor(l, 16); l += __shfl_xor(l, 32);
        bf16x8 pf[5];
#pragma unroll
        for (int sidx = 0; sidx < 5; ++sidx) pf[sidx] = pack8(s[2 * sidx], s[2 * sidx + 1]);
        const float invl = __builtin_amdgcn_rcpf(l);
        int vr[10];
#pragma unroll
        for (int sidx = 0; sidx < 5; ++sidx) { const int r1 = tk0 + 16 * wid + 32 * sidx + 4 * fq + (fr >> 2), r2 = r1 + 16; vr[2 * sidx] = (r1 & 255) * AT_VSTR; vr[2 * sidx + 1] = (r2 & 255) * AT_VSTR; }
        const LAS unsigned char* vbase = lds + AT_V + (4 * (fr & 3)) * 2;
        bf16x8 vfa[5], vfb[5];
#define LOADV(dst, t) do { _Pragma("unroll") for (int q_ = 0; q_ < 5; ++q_) dst[q_] = cat8(trread(vbase + vr[2 * q_] + (t) * 32), trread(vbase + vr[2 * q_ + 1] + (t) * 32)); } while (0)
#define MMAV(src, t) do { f32x4 o_ = {0.f, 0.f, 0.f, 0.f}; _Pragma("unroll") for (int q_ = 0; q_ < 5; ++q_) o_ = __builtin_amdgcn_mfma_f32_16x16x32_bf16(src[q_], pf[q_], o_, 0, 0, 0); \
            u32x2 w_; w_.x = pk2(o_[0] * invl, o_[1] * invl); w_.y = pk2(o_[2] * invl, o_[3] * invl); *(u32x2*)(QO + qoff + 16 * (t) + 4 * fq) = w_; } while (0)
        LOADV(vfa, 0); __builtin_amdgcn_sched_barrier(0);
        LOADV(vfb, 1); __builtin_amdgcn_sched_barrier(0); MMAV(vfa, 0); __builtin_amdgcn_sched_barrier(0);
        LOADV(vfa, 2); __builtin_amdgcn_sched_barrier(0); MMAV(vfb, 1); __builtin_amdgcn_sched_barrier(0);
        LOADV(vfb, 3); __builtin_amdgcn_sched_barrier(0); MMAV(vfa, 2); __builtin_amdgcn_sched_barrier(0);
        LOADV(vfa, 4); __builtin_amdgcn_sched_barrier(0); MMAV(vfb, 3); __builtin_amdgcn_sched_barrier(0);
        LOADV(vfb, 5); __builtin_amdgcn_sched_barrier(0); MMAV(vfa, 4); __builtin_amdgcn_sched_barrier(0);
        LOADV(vfa, 6); __builtin_amdgcn_sched_barrier(0); MMAV(vfb, 5); __builtin_amdgcn_sched_barrier(0);
        LOADV(vfb, 7); __builtin_amdgcn_sched_barrier(0); MMAV(vfa, 6); __builtin_amdgcn_sched_barrier(0);
        MMAV(vfb, 7);
#undef LOADV
#undef MMAV
        if (fq == 0) LSEg[(tokb + (size_t)tq) * 4 + h] = m + 0.6931471805599453f * __builtin_amdgcn_logf(l);
        if (k == 0 && tid == 0) *qslot = pulled;
      }
      R = Rn;
    }
}

__device__ __forceinline__ void run_proj(const Frame& F, unsigned char* ws, const bf16_t* WIN, const bf16_t* Hh, const float* ropec, const float* ropes, int tau0, int ntiles) {
    pg8::Gemm gm{Hh, WIN + (size_t)tau0 * 256 * 1024, T, ntiles * 256, 1024}; pg8::StaticOrder S; S.init(T, ntiles * 256, F.G, F.bid);
    EpiProj E{tau0, ws, ropec, ropes};
    pg8::gemm_phase<EpiProj, pg8::StaticOrder, true, true>(F.lds, gm, S, E, F.wave);
}

#define XB_TMO      128
#define XB_XCNT(j)  (256  + 64 * (j))
#define XB_XSUB(j)  (1280 + 64 * (j))
#define XB_XGEN(j)  (2304 + 64 * (j))
#define XB_TOP      3328
#define XB_TOPGEN   3392
#define XCD_BAR_WORDS 3456
#define XB_SPIN_CAP (1u << 18)

__device__ __forceinline__ unsigned xb_ld(unsigned* p)              { return __hip_atomic_load(p, __ATOMIC_RELAXED, __HIP_MEMORY_SCOPE_AGENT); }
__device__ __forceinline__ unsigned xb_add(unsigned* p, unsigned v) { return __hip_atomic_fetch_add(p, v, __ATOMIC_RELAXED, __HIP_MEMORY_SCOPE_AGENT); }
__device__ __forceinline__ unsigned xb_xcc_id() { return (unsigned)__builtin_amdgcn_s_getreg((3 << 11) | 20) & 0xFu; }
#define XB_SPIN(cond, bar) do { unsigned _sp = 0; while (cond) { __builtin_amdgcn_s_sleep(1); \
    if ((++_sp & 255u) == 0u) { if (xb_ld(&(bar)[XB_TMO])) break; if (_sp > XB_SPIN_CAP) { atomicAdd(&(bar)[XB_TMO], 1u); break; } } } } while (0)

struct XcdBarrier {
    unsigned* bar; unsigned x;
    volatile LAS unsigned* st;
};

__device__ __forceinline__ XcdBarrier xcd_barrier_post(unsigned* bar, volatile LAS unsigned* st) {
    XcdBarrier b; b.bar = bar; b.x = xb_xcc_id(); b.st = st;
    if (threadIdx.x == 0) (void)xb_add(&bar[XB_XCNT(b.x)], 1u);
    return b;
}
__device__ __forceinline__ void xcd_barrier_complete(unsigned* bar, unsigned x, unsigned& nloc, unsigned& nx) {
    const unsigned G = gridDim.x * gridDim.y * gridDim.z;
    unsigned sum, cnt, mine, sp = 0u;
    for (;;) {
        sum = 0u; cnt = 0u; mine = 0u;
#pragma unroll
        for (unsigned j = 0; j < 16; ++j) { const unsigned c = xb_ld(&bar[XB_XCNT(j)]); sum += c; cnt += (c > 0u) ? 1u : 0u; mine = (j == x) ? c : mine; }
        if (sum == G) break;
        __builtin_amdgcn_s_sleep(1);
        if ((++sp & 255u) == 0u) { if (xb_ld(&bar[XB_TMO])) break; if (sp > XB_SPIN_CAP) { atomicAdd(&bar[XB_TMO], 1u); break; } }
    }
    nloc = mine > 0u ? mine : 1u; nx = cnt > 0u ? cnt : 1u;
}

__device__ __forceinline__ void xcd_barrier(const XcdBarrier& b, const bool leader_thread) {
    asm volatile("s_waitcnt vmcnt(0)" ::: "memory");
    __syncthreads();
    if (leader_thread) {
        unsigned* bar = b.bar;
        __builtin_amdgcn_s_waitcnt(0);
        unsigned nloc = b.st[0], nx = b.st[1];
        if (nloc == 0u) { xcd_barrier_complete(bar, b.x, nloc, nx); b.st[0] = nloc; b.st[1] = nx; }
        const unsigned old = xb_add(&bar[XB_XSUB(b.x)], 1u);
        const unsigned gen = old / nloc;
        if (old + 1u == (gen + 1u) * nloc) {
            __builtin_amdgcn_fence(__ATOMIC_RELEASE, "agent");
            asm volatile("s_waitcnt vmcnt(0)" ::: "memory");
            const unsigned og = xb_add(&bar[XB_TOP], 1u);
            const unsigned tg = og / nx;
            if (og + 1u == (tg + 1u) * nx) xb_add(&bar[XB_TOPGEN], 1u);
            else XB_SPIN(xb_ld(&bar[XB_TOPGEN]) == tg, bar);
            __builtin_amdgcn_fence(__ATOMIC_ACQUIRE, "agent");
            xb_add(&bar[XB_XGEN(b.x)], 1u);
            asm volatile("s_waitcnt vmcnt(0)" ::: "memory");
        } else {
            XB_SPIN(xb_ld(&bar[XB_XGEN(b.x)]) == gen, bar);
            __builtin_amdgcn_fence(__ATOMIC_ACQUIRE, "agent");
            asm volatile("s_waitcnt vmcnt(0)" ::: "memory");
        }
    }
    __syncthreads();
}

constexpr int COMB_X = 2;
constexpr int CW_BAR = 4096;
constexpr size_t CTL_ZERO_BYTES = 64 * 1024;
constexpr int MISC_OFF = LDS_BYTES - 256;

#define LAUNDER() do { asm volatile("" : "+s"(F.wave), "+s"(F.bid), "+s"(F.G)); F.lane = fresh_lane(); F.tid = F.wave * 64 + F.lane; asm volatile("" : "+s"(ws)); } while (0)
#define GRID_BAR() do { XcdBarrier bb_ = bar; asm volatile("" : "+s"(bb_.bar), "+s"(bb_.x)); xcd_barrier(bb_, (F.wave * 64 + fresh_lane()) == 0); LAUNDER(); } while (0)

__global__ void __launch_bounds__(NTHR, 2) hybrid_fwd(Args args) {
    extern __shared__ __attribute__((aligned(16))) unsigned char lds_raw[];
    Frame F; F.lds = (LAS unsigned char*)lds_raw; F.tid = threadIdx.x; F.lane = F.tid & 63; F.wave = __builtin_amdgcn_readfirstlane(F.tid >> 6); F.G = gridDim.x; F.bid = blockIdx.x;
    unsigned char* ws = args.ws;
    volatile LAS unsigned* MISC = (volatile LAS unsigned*)(F.lds + MISC_OFF);
    if (F.tid < 64) MISC[F.tid] = 0u;
    __syncthreads();
    XcdBarrier bar = xcd_barrier_post((unsigned*)(ws + WS_CTL) + CW_BAR, MISC + 8);

    phase_prologue(F, args);
    __syncthreads(); LAUNDER();
#pragma unroll 1
    for (int layer = 0; layer < 2; ++layer) {
        LAUNDER();
        const float* ropec = (const float*)(ws + WS_ROPEC); const float* ropes = (const float*)(ws + WS_ROPES);
        const bf16_t* WIN = (const bf16_t*)(ws + WS_WIN + layer * WIN_BYTES);
        const bf16_t* Hh = (const bf16_t*)(ws + WS_H);
        if (layer == 0) phase_prep(F, args, 0, args.in[0], nullptr, nullptr, args.in[1]); else phase_prep(F, args, 1, args.in[0], args.out, args.in[11], args.in[1] + 1024);
        GRID_BAR();
        run_proj(F, ws, WIN, Hh, ropec, ropes, 0, 20);
        GRID_BAR();
        phase_attn(F, args, (unsigned*)(ws + WS_CTL) + 8192 + 64 * layer);
        GRID_BAR();
        {
            const int half = F.G >> 1; const bool five = F.bid < half;
            const int nch = five ? COMB_X : 8 - COMB_X, ch0 = five ? F.bid * COMB_X : half * COMB_X + (F.bid - half) * (8 - COMB_X);
            if (F.G == 256) phase_comb_a(F, args, ch0, nch); else phase_comb_a(F, args, (T / 32) * F.bid / F.G, (T / 32) * (F.bid + 1) / F.G - (T / 32) * F.bid / F.G); }
        LAUNDER();
        run_proj(F, ws, WIN, Hh, ropec, ropes, 20, 9);
        GRID_BAR();
        phase_gla_pre(F, args, layer);
        GRID_BAR();
        phase_gla_scan(F, args);
        GRID_BAR();
        run_proj(F, ws, WIN, Hh, ropec, ropes, 29, 12);
        GRID_BAR();
        phase_comb_b(F, args, layer);
        GRID_BAR();
        { pg8::Gemm gm{(const bf16_t*)(ws + X_OF), (const bf16_t*)(ws + WS_WA + layer * 3 * MiB), T, 1024, 1536}; pg8::StaticOrder S; S.init(T, 1024, F.G, F.bid);
          EpiMerge E{(const bf16_t*)(ws + X_GA), (const bf16_t*)(ws + X_GB), (bf16_t*)(ws + WS_H)};
          pg8::gemm_phase<EpiMerge, pg8::StaticOrder, true, true>(F.lds, gm, S, E, F.wave); }
        GRID_BAR();
        { pg8::Gemm gm{(const bf16_t*)(ws + WS_H), (const bf16_t*)(ws + WS_WO + layer * 2 * MiB), T, 1024, 1024}; pg8::StaticOrder S; S.init(T, 1024, F.G, F.bid);
          EpiOut E{(bf16_t*)(ws + X_OUT), (float*)(ws + WS_ROWSS)};
          pg8::gemm_phase<EpiOut, pg8::StaticOrder, true, true>(F.lds, gm, S, E, F.wave); }
        GRID_BAR();
    }
    phase_prep(F, args, 2, args.out, args.out, args.in[11] + 1024, nullptr);
}

extern "C" void kernel_launch(void* const* d_in, const int* in_sizes, int n_in, void* d_out, int out_size, void* d_ws, size_t ws_size, hipStream_t stream) {
    static int grid = 0;
    if (grid == 0) {
        if (n_in != 12 || out_size != T * DM || ws_size < WS_END) { fprintf(stderr, "kernel_launch: unexpected shapes (n_in %d out %d ws %zu)\n", n_in, out_size, ws_size); grid = -1; return; }
        int dev = 0, cus = 0;
        if (hipGetDevice(&dev) != hipSuccess || hipDeviceGetAttribute(&cus, hipDeviceAttributeMultiprocessorCount, dev) != hipSuccess) { grid = -1; return; }
        if (hipFuncSetAttribute((const void*)hybrid_fwd, hipFuncAttributeMaxDynamicSharedMemorySize, LDS_BYTES) != hipSuccess) { grid = -1; return; }
        grid = cus;
    }
    if (grid < 0) return;
    if (hipMemsetAsync((char*)d_ws + WS_CTL, 0, CTL_ZERO_BYTES, stream) != hipSuccess) return;
    Args a{};
    for (int i = 0; i < 12; ++i) a.in[i] = (const float*)d_in[i];
    a.out = (float*)d_out; a.ws = (unsigned char*)d_ws; a.ph_lo = 0; a.ph_hi = 0;
    hipLaunchKernelGGL(hybrid_fwd, dim3(grid), dim3(NTHR), LDS_BYTES, stream, a);
}
```

```cpp
#include <hip/hip_runtime.h>
#include <cstdio>
#include <cstdint>
__device__ __forceinline__ int fresh_lane() { int l; asm volatile("v_mbcnt_lo_u32_b32 %0, -1, 0\n\tv_mbcnt_hi_u32_b32 %0, -1, %0" : "=v"(l)); return l; }
namespace pg8 {
#define PG8_LAS __attribute__((address_space(3)))
typedef unsigned short bf16_t;
typedef short bf16x8 __attribute__((ext_vector_type(8)));
typedef float f32x4 __attribute__((ext_vector_type(4)));
typedef unsigned u32x4 __attribute__((ext_vector_type(4)));
constexpr int BM = 256, BK = 64, HALF = 128, HTB = HALF * BK * 2  , STAGE_BYTES = 8 * HTB, NXCD = 8, WGM = 8;

__host__ __device__ __forceinline__ int lds_byte(int r, int c) { const int st = (r >> 4) * 2 + (c >> 5), rr = r & 15, cc = c & 31, ob = rr * 64 + cc * 2; return st * 1024 + (ob ^ (((ob >> 9) & 1) << 5)); }
__host__ __device__ __forceinline__ void stage_rc(int b, int& R, int& C) { const int st = b / 1024, sb = b % 1024, swz = sb ^ (((sb >> 9) & 1) << 5); R = (st >> 1) * 16 + swz / 64; C = (st & 1) * 32 + (swz % 64) / 2; }
__host__ __device__ __forceinline__ int perm32(int rho) { const int n = rho >> 4, i = rho & 15; return 8 * (i >> 2) + 4 * n + (i & 3); }

struct Unit { int pm, pn; };
struct Gemm { const bf16_t* A; const bf16_t* Bt; int M, N, K; };

struct StaticOrder {
    int nM, nN, nwg, G, c;
    __host__ __device__ void init(int M, int N, int G_, int c_) { nM = M / BM; nN = N / BM; nwg = nM * nN; G = G_; c = c_; }
    __host__ __device__ bool next(int i, Unit& u) const {
        const long L = (long)i * G + c; if (L >= nwg) return false;
        int wgid = (int)L; { const int q = nwg / NXCD, r = nwg % NXCD, xcd = wgid % NXCD, off = wgid / NXCD; wgid = (xcd < r ? xcd * (q + 1) : r * (q + 1) + (xcd - r) * q) + off; }
        const int nig = WGM * nN, gid = wgid / nig, fm = gid * WGM, gsz = (nM - fm) < WGM ? (nM - fm) : WGM;
        u.pm = fm + ((wgid % nig) % gsz); u.pn = (wgid % nig) / gsz; return true;
    }
    __device__ __forceinline__ void a_ready(const Unit&) const {}
    __device__ __forceinline__ void done(const Unit&) const {}
};


__device__ __forceinline__ unsigned cvt_pk_bf16(float lo, float hi) { unsigned r; asm volatile("v_cvt_pk_bf16_f32 %0, %1, %2" : "=v"(r) : "v"(lo), "v"(hi)); return r; }
template <class Epi, class Sched, bool ALIGN_EPI = false, bool SP2 = false>
__device__ __forceinline__ void gemm_phase(PG8_LAS unsigned char* lds, const Gemm g, const Sched& S, const Epi& E, int wave_id) {
    const int lane = fresh_lane(), wid = wave_id, tid = wid * 64 + lane, wr = wid >> 2, wc = wid & 3, fr = lane & 15, fq = lane >> 4;
    const int K = g.K, nt = K / BK;
    unsigned voffA[2], voffB[2];
#pragma unroll
    for (int i = 0; i < 2; ++i) { int R, C; stage_rc(tid * 16 + i * 8192, R, C); const int Rb = Epi::PERM ? ((R & ~31) + perm32(R & 31)) : R;
        voffA[i] = (unsigned)(R * K + C) * 2u; voffB[i] = (unsigned)(Rb * K + C) * 2u; }
    const size_t kstep = (size_t)(BK * 2);
    const size_t hstep = (size_t)HALF * K * 2;
    const size_t tstep = 2 * hstep;
    const unsigned ldsw = (unsigned)wid * 1024u;
    const int aoff = lds_byte(wr * 64 + fr, fq * 8), boff = lds_byte(wc * 32 + fr, fq * 8);
#define PG8_SA(b, h) (((b) * 2 + (h)) * HTB)
#define PG8_SB(b, h) ((4 + (b) * 2 + (h)) * HTB)
#define PG8_STAGE(bufoff, gbase, voff) do { _Pragma("unroll") for (int _i = 0; _i < 2; ++_i) \
        __builtin_amdgcn_global_load_lds((const unsigned*)((const char*)(gbase) + (voff)[_i]), (PG8_LAS unsigned*)(lds + (bufoff) + ldsw + _i * 8192), 16, 0, 0); } while (0)
#define PG8_LDA(dst, b, h) do { _Pragma("unroll") for (int m = 0; m < 4; ++m) _Pragma("unroll") for (int k = 0; k < 2; ++k) dst[m][k] = *(const PG8_LAS bf16x8*)(lds + PG8_SA(b, h) + aoff + m * 2048 + k * 1024); } while (0)
#define PG8_LDB(dst, b, h) do { _Pragma("unroll") for (int n = 0; n < 2; ++n) _Pragma("unroll") for (int k = 0; k < 2; ++k) dst[n][k] = *(const PG8_LAS bf16x8*)(lds + PG8_SB(b, h) + boff + n * 2048 + k * 1024); } while (0)
#define PG8_MMA(ai, bj, At, Bt) do { __builtin_amdgcn_s_setprio(1); _Pragma("unroll") for (int m = 0; m < 4; ++m) _Pragma("unroll") for (int n = 0; n < 2; ++n) _Pragma("unroll") for (int k = 0; k < 2; ++k) \
        acc[ai][bj][m][n] = __builtin_amdgcn_mfma_f32_16x16x32_bf16(Bt[n][k], At[m][k], acc[ai][bj][m][n], 0, 0, 0); __builtin_amdgcn_s_setprio(0); } while (0)
#define PG8_WAIT_V(n) asm volatile("s_waitcnt vmcnt(" #n ")" ::: "memory")
#define PG8_WAIT_L(n) asm volatile("s_waitcnt lgkmcnt(" #n ")" ::: "memory")
#define PG8_BAR __builtin_amdgcn_s_barrier()
#define PG8_SCHED __builtin_amdgcn_sched_barrier(0)
    Unit cur, nxt; int ui = 0;
    if (!S.next(0, cur)) return;
    f32x4 acc[2][2][4][2];
#pragma unroll
    for (int a = 0; a < 2; ++a)
#pragma unroll
        for (int b = 0; b < 2; ++b)
#pragma unroll
            for (int m = 0; m < 4; ++m)
#pragma unroll
                for (int n = 0; n < 2; ++n) acc[a][b][m][n] = (f32x4){0.f, 0.f, 0.f, 0.f};
    bf16x8 At[4][2], B0[2][2], B1[2][2];
    const char* cA = (const char*)g.A + (size_t)cur.pm * tstep; const char* cB = (const char*)g.Bt + (size_t)cur.pn * tstep;
    S.a_ready(cur);
    if constexpr (SP2) {
        PG8_STAGE(PG8_SB(0, 0), cB, voffB); PG8_STAGE(PG8_SB(0, 1), cB + hstep, voffB); PG8_STAGE(PG8_SA(0, 0), cA, voffA); PG8_STAGE(PG8_SA(0, 1), cA + hstep, voffA);
        if (wr == 1) PG8_BAR;
        PG8_WAIT_V(2); PG8_BAR;
        PG8_STAGE(PG8_SB(1, 0), cB + kstep, voffB); PG8_STAGE(PG8_SA(1, 0), cA + kstep, voffA); PG8_STAGE(PG8_SB(1, 1), cB + hstep + kstep, voffB);
        PG8_WAIT_V(6); PG8_BAR;
    } else {
        PG8_STAGE(PG8_SB(0, 0), cB, voffB); PG8_STAGE(PG8_SA(0, 0), cA, voffA); PG8_STAGE(PG8_SB(0, 1), cB + hstep, voffB); PG8_STAGE(PG8_SA(0, 1), cA + hstep, voffA);
        if (wr == 1) PG8_BAR;
        PG8_WAIT_V(4); PG8_BAR;
        PG8_STAGE(PG8_SB(1, 0), cB + kstep, voffB); PG8_STAGE(PG8_SA(1, 0), cA + kstep, voffA); PG8_STAGE(PG8_SB(1, 1), cB + hstep + kstep, voffB);
        PG8_WAIT_V(6); PG8_BAR;
    }
    for (;;) {
        const bool has_next = S.next(ui + 1, nxt);
        const char* nA = has_next ? (const char*)g.A + (size_t)nxt.pm * tstep : cA; const char* nB = has_next ? (const char*)g.Bt + (size_t)nxt.pn * tstep : cB;
        for (int t = 0; t < nt; t += 2) {
            if constexpr (Epi::MIDT > 0) { if (t == Epi::MIDT) E.mid(acc, cur, wr, wc, fr, fq); }
            const bool last = (t == nt - 2);
            const char* a1 = cA + (size_t)(t + 1) * kstep;
            const char* a2 = last ? nA : cA + (size_t)(t + 2) * kstep; const char* b2 = last ? nB : cB + (size_t)(t + 2) * kstep;
            const char* a3 = a2 + kstep; const char* b3 = b2 + kstep;
            if (last && has_next) S.a_ready(nxt);
            if constexpr (SP2) {
            PG8_LDB(B0, 0, 0); PG8_LDB(B1, 0, 1); PG8_SCHED; PG8_LDA(At, 0, 0); PG8_STAGE(PG8_SA(1, 1), a1 + hstep, voffA);
            PG8_WAIT_V(8); PG8_WAIT_L(0); PG8_BAR; PG8_MMA(0, 0, At, B0); PG8_MMA(0, 1, At, B1); PG8_BAR; PG8_SCHED;
            PG8_LDA(At, 0, 1); PG8_STAGE(PG8_SB(0, 0), b2, voffB); PG8_STAGE(PG8_SB(0, 1), b2 + hstep, voffB); PG8_STAGE(PG8_SA(0, 0), a2, voffA);
            PG8_WAIT_V(8); PG8_WAIT_L(0); PG8_BAR; PG8_MMA(1, 0, At, B0); PG8_MMA(1, 1, At, B1); PG8_BAR; PG8_SCHED;
            PG8_LDB(B0, 1, 0); PG8_LDB(B1, 1, 1); PG8_SCHED; PG8_LDA(At, 1, 0); PG8_STAGE(PG8_SA(0, 1), a2 + hstep, voffA);
            PG8_WAIT_V(8); PG8_WAIT_L(0); PG8_BAR; PG8_MMA(0, 0, At, B0); PG8_MMA(0, 1, At, B1); PG8_BAR; PG8_SCHED;
            PG8_LDA(At, 1, 1); PG8_STAGE(PG8_SB(1, 0), b3, voffB); PG8_STAGE(PG8_SB(1, 1), b3 + hstep, voffB); PG8_STAGE(PG8_SA(1, 0), a3, voffA);
            PG8_WAIT_V(8); PG8_WAIT_L(0); PG8_BAR; PG8_MMA(1, 0, At, B0); PG8_MMA(1, 1, At, B1); PG8_BAR; PG8_SCHED;
            } else {
            PG8_LDB(B0, 0, 0); PG8_SCHED; PG8_LDA(At, 0, 0); PG8_STAGE(PG8_SA(1, 1), a1 + hstep, voffA);
            PG8_WAIT_L(8); PG8_BAR; PG8_WAIT_L(0); PG8_MMA(0, 0, At, B0); PG8_BAR; PG8_SCHED;
            PG8_LDB(B1, 0, 1); PG8_STAGE(PG8_SB(0, 0), b2, voffB);
            PG8_BAR; PG8_WAIT_L(0); PG8_MMA(0, 1, At, B1); PG8_BAR;
            PG8_LDA(At, 0, 1); PG8_STAGE(PG8_SA(0, 0), a2, voffA);
            PG8_BAR; PG8_WAIT_L(0); PG8_MMA(1, 0, At, B0); PG8_BAR; PG8_SCHED;
            PG8_STAGE(PG8_SB(0, 1), b2 + hstep, voffB);
            PG8_WAIT_V(6); PG8_BAR; PG8_MMA(1, 1, At, B1); PG8_BAR;
            PG8_LDB(B0, 1, 0); PG8_SCHED; PG8_LDA(At, 1, 0); PG8_STAGE(PG8_SA(0, 1), a2 + hstep, voffA);
            PG8_WAIT_L(8); PG8_BAR; PG8_WAIT_L(0); PG8_MMA(0, 0, At, B0); PG8_BAR; PG8_SCHED;
            PG8_LDB(B1, 1, 1); PG8_STAGE(PG8_SB(1, 0), b3, voffB);
            PG8_BAR; PG8_WAIT_L(0); PG8_MMA(0, 1, At, B1); PG8_BAR;
            PG8_LDA(At, 1, 1); PG8_STAGE(PG8_SA(1, 0), a3, voffA);
            PG8_BAR; PG8_WAIT_L(0); PG8_MMA(1, 0, At, B0); PG8_BAR; PG8_SCHED;
            PG8_STAGE(PG8_SB(1, 1), b3 + hstep, voffB);
            PG8_WAIT_V(6); PG8_BAR; PG8_MMA(1, 1, At, B1); PG8_BAR;
            }
        }
        if constexpr (ALIGN_EPI) { if (wr == 0) PG8_BAR; }
        if constexpr (!Epi::AFTER_DRAIN) { E(acc, cur, wr, wc, fr, fq); S.done(cur); }
        if (!has_next) break;
#pragma unroll
        for (int a = 0; a < 2; ++a)
#pragma unroll
            for (int b = 0; b < 2; ++b)
#pragma unroll
                for (int m = 0; m < 4; ++m)
#pragma unroll
                    for (int n = 0; n < 2; ++n) acc[a][b][m][n] = (f32x4){0.f, 0.f, 0.f, 0.f};
        cur = nxt; cA = nA; cB = nB; ++ui;
        if constexpr (ALIGN_EPI) { if (wr == 1) PG8_BAR; }
    }
    PG8_WAIT_V(0);
    if constexpr (!ALIGN_EPI) { if (wr == 0) PG8_BAR; }
    PG8_BAR;
    if constexpr (Epi::AFTER_DRAIN) { E.fused(acc, cur, wr, wc, fr, fq, lds, wid, lane); S.done(cur); }
#undef PG8_SA
#undef PG8_SB
#undef PG8_STAGE
#undef PG8_LDA
#undef PG8_LDB
#undef PG8_MMA
#undef PG8_WAIT_V
#undef PG8_WAIT_L
#undef PG8_BAR
#undef PG8_SCHED
}
}

#define LAS __attribute__((address_space(3)))
typedef unsigned short bf16_t;
typedef short bf16x8 __attribute__((ext_vector_type(8)));
typedef short s16x4 __attribute__((ext_vector_type(4)));
typedef float f32x4 __attribute__((ext_vector_type(4)));
typedef float f32x2 __attribute__((ext_vector_type(2)));
typedef unsigned u32x4 __attribute__((ext_vector_type(4)));
typedef unsigned u32x2 __attribute__((ext_vector_type(2)));

constexpr int NWAVES = 8, NTHR = 512;
constexpr int T = 32768, DM = 1024, SEQ = 4096, NB = 8;
constexpr int IN_DIM = 10272;
constexpr int NWIN_TILES = 41, NWIN = NWIN_TILES * 256;
constexpr float NORM_EPS = 1e-6f;
constexpr float QSCALE = 0.08838834764831845f;

constexpr size_t MiB = 1u << 20;
constexpr size_t WS_CTL = 0;
constexpr size_t WS_WIN = 1 * MiB;
constexpr size_t WIN_BYTES = (size_t)NWIN * 1024 * 2;
constexpr size_t WS_WA = 42 * MiB;
constexpr size_t WS_WB = 44 * MiB;
constexpr size_t WS_WO = 48 * MiB;
constexpr size_t WS_ROPEC = 52 * MiB, WS_ROPES = WS_ROPEC + 256 * 1024;
constexpr size_t WS_LSE = 53 * MiB;
constexpr size_t WS_LR = 55 * MiB;
constexpr size_t WS_ROWSS = 59 * MiB;
constexpr size_t WS_H = 62 * MiB;
constexpr size_t WS_X = 126 * MiB;
constexpr size_t X_QO = WS_X + 0 * MiB, X_KA = WS_X + 96 * MiB, X_VA = WS_X + 192 * MiB, X_ZA = WS_X + 288 * MiB;
constexpr size_t X_GQ = WS_X + 96 * MiB, X_GK = WS_X + 128 * MiB, X_GVL = WS_X + 160 * MiB, X_GVH = WS_X + 352 * MiB, X_BF = WS_X + 0 * MiB, X_BB = WS_X + 32 * MiB;
constexpr size_t X_OF = WS_X + 192 * MiB, X_OB = WS_X + 288 * MiB;
constexpr int OF_LD = 1536, OF_C0 = 512;
constexpr size_t X_ZB = WS_X + 0 * MiB, X_GA = WS_X + 64 * MiB, X_GB = WS_X + 128 * MiB, X_OUT = WS_X + 0 * MiB;
constexpr size_t WS_END = WS_X + 384 * MiB;

constexpr int LDS_BYTES = 147456;

__device__ __forceinline__ float bf2f(unsigned v) { return __uint_as_float(v << 16); }
__device__ __forceinline__ float bflo(unsigned w) { return __uint_as_float(w << 16); }
__device__ __forceinline__ float bfhi(unsigned w) { return __uint_as_float(w & 0xffff0000u); }
typedef __bf16 bf16x2_t __attribute__((ext_vector_type(2)));
__device__ __forceinline__ unsigned pk2(float lo, float hi) { f32x2 v = {lo, hi}; bf16x2_t b = __builtin_convertvector(v, bf16x2_t); return __builtin_bit_cast(unsigned, b); }
template <int M> __device__ __forceinline__ float xsum(float v) {
    if constexpr (M < 32) return v + __builtin_bit_cast(float, __builtin_amdgcn_ds_swizzle(__builtin_bit_cast(int, v), (M << 10) | 0x1F));
    else { const unsigned u = __builtin_bit_cast(unsigned, v); auto r = __builtin_amdgcn_permlane32_swap(u, u, false, false); return __builtin_bit_cast(float, r[0]) + __builtin_bit_cast(float, r[1]); }
}
template <int M> __device__ __forceinline__ float xmax(float v) {
    if constexpr (M < 32) return fmaxf(v, __builtin_bit_cast(float, __builtin_amdgcn_ds_swizzle(__builtin_bit_cast(int, v), (M << 10) | 0x1F)));
    else { const unsigned u = __builtin_bit_cast(unsigned, v); auto r = __builtin_amdgcn_permlane32_swap(u, u, false, false); return fmaxf(__builtin_bit_cast(float, r[0]), __builtin_bit_cast(float, r[1])); }
}
__device__ __forceinline__ float wave_sum(float v) { v += __shfl_xor(v, 1); v += __shfl_xor(v, 2); v += __shfl_xor(v, 4); v += __shfl_xor(v, 8); v += __shfl_xor(v, 16); v += __shfl_xor(v, 32); return v; }
__device__ __forceinline__ float sigmoidf_(float x) { return __builtin_amdgcn_rcpf(1.0f + __builtin_amdgcn_exp2f(-1.4426950408889634f * x)); }
__device__ __forceinline__ float siluf_(float x) { return x * sigmoidf_(x); }

struct EpiProj {
    static constexpr bool PERM = true, AFTER_DRAIN = false; static constexpr int MIDT = 0;
    int tau0; unsigned char* ws; const float* ropec; const float* ropes;
    __device__ __forceinline__ void operator()(const f32x4 (&acc)[2][2][4][2], const pg8::Unit& u, int wr, int wc, int fr, int fq) const {
        const int tau = tau0 + u.pn;
        int mode = 0, ldc = 512, colt = 0, dsh = 0; bf16_t* base = nullptr;
        if (tau < 18) { const int g = tau / 6, t = (tau % 6) >> 1, half = tau & 1; colt = half * 256; dsh = 2 * g;
                        base = (bf16_t*)(ws + (t == 0 ? X_QO : (t == 1 ? X_KA : X_VA)) + (size_t)g * 32 * MiB); mode = t < 2 ? 3 : 0; }
        else if (tau < 20) { base = (bf16_t*)(ws + X_ZA); colt = (tau - 18) * 256; }
        else if (tau < 22) { base = (bf16_t*)(ws + X_GQ); colt = (tau - 20) * 256; }
        else if (tau < 24) { base = (bf16_t*)(ws + X_GK); colt = (tau - 22) * 256; }
        else if (tau < 28) { base = (bf16_t*)(ws + (tau < 26 ? X_GVL : X_GVH)); colt = ((tau - 24) & 1) * 256; }
        else if (tau == 28) { mode = 4; }
        else if (tau < 33) { base = (bf16_t*)(ws + X_ZB); ldc = 1024; colt = (tau - 29) * 256; }
        else { mode = 5; }
        const int row0 = u.pm * 256 + wr * 64 + fr;
        if (mode == 5) {
            bf16_t* Rb = (bf16_t*)(ws + X_GA); bf16_t* Gb = (bf16_t*)(ws + X_GB); const int tix = ((wr * 4 + wc) * 4 + fq) * 16 + fr;
#pragma unroll
            for (int ai = 0; ai < 2; ++ai)
#pragma unroll
                for (int m = 0; m < 4; ++m) { const size_t off = ((((size_t)u.pm * 8 + (tau - 33)) * 8 + (ai * 4 + m)) * 512 + tix) * 8;
                    float r[8], g[8];
#pragma unroll
                    for (int j = 0; j < 8; ++j) { const float av = acc[ai][0][m][j >> 2][j & 3], bv = acc[ai][1][m][j >> 2][j & 3];
                        const float ea = __builtin_amdgcn_exp2f(-1.4426950408889634f * av), eb = fminf(__builtin_amdgcn_exp2f(-1.4426950408889634f * bv), 1e30f);
                        r[j] = (1.0f + eb) * __builtin_amdgcn_rcpf(1.0f + ea); g[j] = __builtin_amdgcn_rcpf(1.0f + eb); }
                    u32x4 wr_, wg_; wr_.x = pk2(r[0], r[1]); wr_.y = pk2(r[2], r[3]); wr_.z = pk2(r[4], r[5]); wr_.w = pk2(r[6], r[7]);
                    wg_.x = pk2(g[0], g[1]); wg_.y = pk2(g[2], g[3]); wg_.z = pk2(g[4], g[5]); wg_.w = pk2(g[6], g[7]);
                    __builtin_nontemporal_store(wr_, (u32x4*)(Rb + off)); __builtin_nontemporal_store(wg_, (u32x4*)(Gb + off)); }
            return;
        }
        if (mode == 4) {
            if (wc == 0) { float* LR = (float*)(ws + WS_LR);
#pragma unroll
                for (int ai = 0; ai < 2; ++ai)
#pragma unroll
                    for (int m = 0; m < 4; ++m) { float* rp = LR + (size_t)(row0 + ai * 128 + m * 16) * 32 + 8 * fq;
                        *(f32x4*)(rp) = acc[ai][0][m][0]; *(f32x4*)(rp + 4) = acc[ai][0][m][1]; } }
            return;
        }
        const int col0 = colt + wc * 32 + 8 * fq;
#pragma unroll
        for (int ai = 0; ai < 2; ++ai) {
            float csv[4], snv[4];
            if (mode == 3) { const float invr = __builtin_amdgcn_exp2f(-(float)(4 * wc + fq) * (18.931568569324174f / 16.0f)) * 0.15915494309189535f;
#pragma unroll
                for (int m = 0; m < 4; ++m) { const float pos = (float)((row0 + ai * 128 + m * 16) & (SEQ - 1)); const float xr = __builtin_amdgcn_fractf(pos * invr); csv[m] = __builtin_amdgcn_cosf(xr); snv[m] = __builtin_amdgcn_sinf(xr); } }
#pragma unroll
            for (int m = 0; m < 4; ++m) { const int row = row0 + ai * 128 + m * 16;
                const int srow = (row & ~(SEQ - 1)) | (((row & ((1 << dsh) - 1)) << (12 - dsh)) | ((row & (SEQ - 1)) >> dsh));
                bf16_t* rowp = base + (size_t)srow * ldc + col0;
                const float cs = csv[m], sn = snv[m];
#pragma unroll
                for (int bj = 0; bj < 2; ++bj) { f32x4 v0 = acc[ai][bj][m][0], v1 = acc[ai][bj][m][1];
                    if (mode == 1) {
#pragma unroll
                        for (int j = 0; j < 4; ++j) { v0[j] = v0[j] * sigmoidf_(v0[j]); v1[j] = v1[j] * sigmoidf_(v1[j]); } }
                    else if (mode == 2) {
#pragma unroll
                        for (int j = 0; j < 4; ++j) { v0[j] = sigmoidf_(v0[j]); v1[j] = sigmoidf_(v1[j]); } }
                    else if (mode == 3) { const float a0 = v0[0], a1 = v0[1]; v0[0] = a0 * cs - a1 * sn; v0[1] = a1 * cs + a0 * sn; }
                    u32x4 w; w.x = pk2(v0[0], v0[1]); w.y = pk2(v0[2], v0[3]); w.z = pk2(v1[0], v1[1]); w.w = pk2(v1[2], v1[3]);
                    __builtin_nontemporal_store(w, (u32x4*)(rowp + bj * 128)); } } }
    }
};
struct EpiMerge {
    static constexpr bool PERM = true, AFTER_DRAIN = false; static constexpr int MIDT = 8;
    const bf16_t* GA; const bf16_t* GB; bf16_t* O;
    __device__ __forceinline__ void mid(f32x4 (&acc)[2][2][4][2], const pg8::Unit& u, int wr, int wc, int fr, int fq) const {
        int row0 = u.pm * 256 + wr * 64 + fr; const int col0 = u.pn * 256 + wc * 32 + 8 * fq; int tix = ((wr * 4 + wc) * 4 + fq) * 16 + fr;
#pragma unroll
        for (int ai = 0; ai < 2; ++ai) {
            asm volatile("" : "+v"(row0), "+v"(tix));
            u32x4 g[4][2];
#pragma unroll
            for (int m = 0; m < 4; ++m)
#pragma unroll
                for (int bj = 0; bj < 2; ++bj) g[m][bj] = __builtin_nontemporal_load((const u32x4*)((const unsigned char*)GA + (unsigned)((((u.pm * 8 + (2 * u.pn + bj)) * 8 + (ai * 4 + m)) * 512 + tix) * 16)));
#pragma unroll
            for (int m = 0; m < 4; ++m)
#pragma unroll
                for (int bj = 0; bj < 2; ++bj) { const u32x4 a = g[m][bj]; f32x4& v0 = acc[ai][bj][m][0]; f32x4& v1 = acc[ai][bj][m][1];
                    v0[0] *= bflo(a.x); v0[1] *= bfhi(a.x); v0[2] *= bflo(a.y); v0[3] *= bfhi(a.y); v1[0] *= bflo(a.z); v1[1] *= bfhi(a.z); v1[2] *= bflo(a.w); v1[3] *= bfhi(a.w); }
            asm volatile("" ::: "memory"); }
    }
    __device__ __forceinline__ void operator()(const f32x4 (&acc)[2][2][4][2], const pg8::Unit& u, int wr, int wc, int fr, int fq) const {
        int row0 = u.pm * 256 + wr * 64 + fr; const int col0 = u.pn * 256 + wc * 32 + 8 * fq; int tix = ((wr * 4 + wc) * 4 + fq) * 16 + fr;
#pragma unroll
        for (int ai = 0; ai < 2; ++ai) {
            asm volatile("" : "+v"(row0), "+v"(tix));
            u32x4 g[4][2];
#pragma unroll
            for (int m = 0; m < 4; ++m)
#pragma unroll
                for (int bj = 0; bj < 2; ++bj) g[m][bj] = __builtin_nontemporal_load((const u32x4*)((const unsigned char*)GB + (unsigned)((((u.pm * 8 + (2 * u.pn + bj)) * 8 + (ai * 4 + m)) * 512 + tix) * 16)));
#pragma unroll
            for (int m = 0; m < 4; ++m) { const size_t off = (size_t)(row0 + ai * 128 + m * 16) * 1024 + col0;
#pragma unroll
                for (int bj = 0; bj < 2; ++bj) { const u32x4 gg = g[m][bj]; const f32x4 v0 = acc[ai][bj][m][0], v1 = acc[ai][bj][m][1];
                    u32x4 w; w.x = pk2(v0[0] * bflo(gg.x), v0[1] * bfhi(gg.x)); w.y = pk2(v0[2] * bflo(gg.y), v0[3] * bfhi(gg.y)); w.z = pk2(v1[0] * bflo(gg.z), v1[1] * bfhi(gg.z)); w.w = pk2(v1[2] * bflo(gg.w), v1[3] * bfhi(gg.w));
                    *(u32x4*)(O + off + bj * 128) = w; } }
            asm volatile("" ::: "memory"); }
    }
};
struct EpiOut {
    static constexpr bool PERM = true, AFTER_DRAIN = false; static constexpr int MIDT = 0;
    bf16_t* O; float* rowss;
    __device__ __forceinline__ void operator()(const f32x4 (&acc)[2][2][4][2], const pg8::Unit& u, int wr, int wc, int fr, int fq) const {
        const int row0 = u.pm * 256 + wr * 64 + fr, col0 = u.pn * 256 + wc * 32 + 8 * fq;
#pragma unroll
        for (int ai = 0; ai < 2; ++ai)
#pragma unroll
            for (int m = 0; m < 4; ++m) { const int row = row0 + ai * 128 + m * 16; const size_t off = (size_t)row * 1024 + col0; float s = 0.f;
#pragma unroll
                for (int bj = 0; bj < 2; ++bj) { const f32x4 v0 = acc[ai][bj][m][0], v1 = acc[ai][bj][m][1];
                    s += (v0[0] * v0[0] + v0[1] * v0[1]) + (v0[2] * v0[2] + v0[3] * v0[3]) + (v1[0] * v1[0] + v1[1] * v1[1]) + (v1[2] * v1[2] + v1[3] * v1[3]);
                    u32x4 w; w.x = pk2(v0[0], v0[1]); w.y = pk2(v0[2], v0[3]); w.z = pk2(v1[0], v1[1]); w.w = pk2(v1[2], v1[3]);
                    *(u32x4*)(O + off + bj * 128) = w; }
                s += __shfl_xor(s, 16); s += __shfl_xor(s, 32);
                if (fq == 0) rowss[(size_t)row * 16 + u.pn * 4 + wc] = s; }
    }
};

struct Args { const float* in[12]; float* out; unsigned char* ws; int ph_lo, ph_hi; };

struct Frame { LAS unsigned char* lds; int tid, lane, wave, G, bid; };

__device__ __forceinline__ int win_src(int np, float& sc) {
    sc = 1.f; const int tau = np >> 8, c = np & 255;
    if (tau < 18) { const int g = np / 1536, rem = np % 1536, t = rem / 512, hc = rem % 512, h = hc >> 7, d = hc & 127;
        int ds = d; if (t < 2) { const int grp = d >> 3, e = d & 7; ds = e < 2 ? e * 16 + grp : 32 + grp * 6 + (e - 2); }
        if (t == 0) sc = QSCALE;
        return g * 1536 + t * 512 + h * 128 + ds; }
    if (tau < 20) return 4608 + (np - 18 * 256);
    if (tau < 22) { sc = QSCALE; return 5120 + (np - 20 * 256); }
    if (tau < 24) return 5632 + (np - 22 * 256);
    if (tau < 28) return 6144 + (np - 24 * 256);
    if (tau == 28) return c < 32 ? 10240 + c : -1;
    if (tau < 33) return 7168 + (np - 29 * 256);
    { const int i = tau - 33; return c < 128 ? 8192 + 128 * i + c : 9216 + 128 * i + (c - 128); }
}
template <bool IS_WIN> __device__ __forceinline__ void transpose_item(const float* W, int K, int Nsrc, int Ndst, bf16_t* WT, LAS float* scr, int item, int lane, int ldd = 0, int koff = 0) {
    if (ldd == 0) ldd = K;
    const int nblk = Ndst / 32, kb = item / nblk, nb = item % nblk, k0 = 64 * kb, n0 = 32 * nb;
    const int np = n0 + (lane & 31); float sc = 1.f; int src = np; if (IS_WIN) src = win_src(np, sc);
    float v[32];
    const float* wp = W + (size_t)(k0 + (lane >> 5)) * Nsrc + (src >= 0 ? src : 0);
#pragma unroll
    for (int i = 0; i < 32; ++i) v[i] = wp[(size_t)(2 * i) * Nsrc];
#pragma unroll
    for (int i = 0; i < 32; ++i) scr[(2 * i + (lane >> 5)) * 33 + (lane & 31)] = src >= 0 ? v[i] * sc : 0.f;
    asm volatile("s_waitcnt lgkmcnt(0)" ::: "memory");
    const int c = lane & 7;
#pragma unroll
    for (int j = 0; j < 4; ++j) { const int n = (lane >> 3) + 8 * j; const LAS float* s = scr + (8 * c) * 33 + n;
        u32x4 o; o.x = pk2(s[0 * 33], s[1 * 33]); o.y = pk2(s[2 * 33], s[3 * 33]); o.z = pk2(s[4 * 33], s[5 * 33]); o.w = pk2(s[6 * 33], s[7 * 33]);
        *(u32x4*)(WT + (size_t)(n0 + n) * ldd + koff + k0 + 8 * c) = o; }
    asm volatile("s_waitcnt lgkmcnt(0)" ::: "memory");
}
__device__ __forceinline__ void phase_prologue(const Frame& F, const Args& a) {
    LAS float* scr = (LAS float*)(F.lds + F.wave * 16384);
    const int gw = F.bid * NWAVES + F.wave, NGW = F.G * NWAVES;
    constexpr int I_WIN = 16 * (NWIN / 32), I_WA = 8 * 32, I_WB = 16 * 32, I_WO = 16 * 32, I_L = I_WIN + I_WA + I_WB + I_WO;
    for (int it = gw; it < 2 * I_L; it += NGW) {
        const int l = it / I_L; int r = it % I_L;
        if (r < I_WIN) { transpose_item<true>(a.in[2] + (size_t)l * 1024 * IN_DIM, 1024, IN_DIM, NWIN, (bf16_t*)(a.ws + WS_WIN + l * WIN_BYTES), scr, r, F.lane); continue; } r -= I_WIN;
        if (r < I_WA) { transpose_item<false>(a.in[8] + (size_t)l * 512 * 1024, 512, 1024, 1024, (bf16_t*)(a.ws + WS_WA + l * 3 * MiB), scr, r, F.lane, 1536, 0); continue; } r -= I_WA;
        if (r < I_WB) { transpose_item<false>(a.in[9] + (size_t)l * 1024 * 1024, 1024, 1024, 1024, (bf16_t*)(a.ws + WS_WA + l * 3 * MiB), scr, r, F.lane, 1536, 512); continue; } r -= I_WB;
        transpose_item<false>(a.in[10] + (size_t)l * 1024 * 1024, 1024, 1024, 1024, (bf16_t*)(a.ws + WS_WO + l * 2 * MiB), scr, r, F.lane);
    }
}

__device__ __forceinline__ void phase_prep(const Frame& F, const Args& a, int mode, const float* xprev, float* xout, const float* wpost, const float* wpre) {
    const int gw = F.bid * NWAVES + F.wave, NGW = F.G * NWAVES;
    const bf16_t* OUT = (const bf16_t*)(a.ws + X_OUT); const float* rowss = (const float*)(a.ws + WS_ROWSS); bf16_t* H = (bf16_t*)(a.ws + WS_H);
    f32x4 wpo[4], wpr[4];
#pragma unroll
    for (int j = 0; j < 4; ++j) { wpo[j] = (mode != 0) ? *((const f32x4*)wpost + F.lane + 64 * j) : (f32x4){0.f, 0.f, 0.f, 0.f}; wpr[j] = (mode != 2) ? *((const f32x4*)wpre + F.lane + 64 * j) : (f32x4){0.f, 0.f, 0.f, 0.f}; }
    constexpr int NR = 4;
    for (int row0 = gw; row0 < T; row0 += NR * NGW) {
        f32x4 v[NR][4]; u32x2 ov[NR][4]; float ssv[NR];
#pragma unroll
        for (int rr = 0; rr < NR; ++rr) { const int row = row0 + rr * NGW; const f32x4* xr = (const f32x4*)(xprev + (size_t)row * DM) + F.lane;
            if (mode == 2) {
                const u32x2* xb = (const u32x2*)((const unsigned char*)xprev + (size_t)row * (DM * 4) + DM * 2) + F.lane;
#pragma unroll
                for (int j = 0; j < 4; ++j) { const u32x2 t = __builtin_nontemporal_load(xb + 64 * j); v[rr][j] = (f32x4){bflo(t.x), bfhi(t.x), bflo(t.y), bfhi(t.y)}; }
            } else {
#pragma unroll
                for (int j = 0; j < 4; ++j) v[rr][j] = __builtin_nontemporal_load(xr + 64 * j);
            }
            if (mode != 0) { ssv[rr] = rowss[(size_t)row * 16 + (F.lane & 15)]; const u32x2* orow = (const u32x2*)(OUT + (size_t)row * DM) + F.lane;
#pragma unroll
                for (int j = 0; j < 4; ++j) ov[rr][j] = __builtin_nontemporal_load(orow + 64 * j); } }
#pragma unroll
        for (int rr = 0; rr < NR; ++rr) { const int row = row0 + rr * NGW;
            if (mode != 0) {
                float ss = ssv[rr];
                ss += __shfl_xor(ss, 1); ss += __shfl_xor(ss, 2); ss += __shfl_xor(ss, 4); ss += __shfl_xor(ss, 8);
                const float rstd = __builtin_amdgcn_rsqf(ss * (1.0f / DM) + NORM_EPS);
#pragma unroll
                for (int j = 0; j < 4; ++j) { const u32x2 o = ov[rr][j]; const f32x4 w = wpo[j];
                    v[rr][j][0] += bflo(o.x) * rstd * w[0]; v[rr][j][1] += bfhi(o.x) * rstd * w[1]; v[rr][j][2] += bflo(o.y) * rstd * w[2]; v[rr][j][3] += bfhi(o.y) * rstd * w[3]; }
                if (mode == 1) {
                    u32x2* xb = (u32x2*)((unsigned char*)xout + (size_t)row * (DM * 4) + DM * 2) + F.lane;
#pragma unroll
                    for (int j = 0; j < 4; ++j) { u32x2 t; t.x = pk2(v[rr][j][0], v[rr][j][1]); t.y = pk2(v[rr][j][2], v[rr][j][3]); __builtin_nontemporal_store(t, xb + 64 * j); }
                } else {
                    f32x4* xo = (f32x4*)(xout + (size_t)row * DM) + F.lane;
#pragma unroll
                    for (int j = 0; j < 4; ++j) __builtin_nontemporal_store(v[rr][j], xo + 64 * j);
                }
            }
            if (mode != 2) {
                float s = 0.f;
#pragma unroll
                for (int j = 0; j < 4; ++j) s += (v[rr][j][0] * v[rr][j][0] + v[rr][j][1] * v[rr][j][1]) + (v[rr][j][2] * v[rr][j][2] + v[rr][j][3] * v[rr][j][3]);
                const float rstd = __builtin_amdgcn_rsqf(wave_sum(s) * (1.0f / DM) + NORM_EPS);
                u32x2* ho = (u32x2*)(H + (size_t)row * DM) + F.lane;
#pragma unroll
                for (int j = 0; j < 4; ++j) { const f32x4 w = wpr[j]; u32x2 o;
                    o.x = pk2(v[rr][j][0] * rstd * w[0], v[rr][j][1] * rstd * w[1]); o.y = pk2(v[rr][j][2] * rstd * w[2], v[rr][j][3] * rstd * w[3]); ho[64 * j] = o; }
            }
        }
    }
}

#define LDS_BARRIER() do { asm volatile("s_waitcnt lgkmcnt(0)" ::: "memory"); __builtin_amdgcn_s_barrier(); asm volatile("" ::: "memory"); } while (0)
constexpr int GP_Q = 0, GP_K = 65536, GP_LR = 131072;
__device__ __forceinline__ void phase_gla_pre(const Frame& F, const Args& a, int layer) {
    const int tid = F.tid, dir = tid >> 8, c2 = (tid & 255) * 2;
    LAS unsigned char* lds = F.lds;
    const float* LR = (const float*)(a.ws + WS_LR);
    bf16_t* GQ = (bf16_t*)(a.ws + X_GQ); bf16_t* GK = (bf16_t*)(a.ws + X_GK);
    bf16_t* QDo = dir ? GQ : (bf16_t*)(a.ws + X_BF); bf16_t* KIo = dir ? GK : (bf16_t*)(a.ws + X_BB);
    float* DEC = (float*)(a.ws + WS_ROWSS);
    const float* Wup = (dir ? a.in[5] : a.in[3]) + (size_t)layer * 16 * 512; const float* bias = (dir ? a.in[6] : a.in[4]) + (size_t)layer * 512;
    f32x2 w[16];
#pragma unroll
    for (int i = 0; i < 16; ++i) w[i] = *(const f32x2*)(Wup + i * 512 + c2);
    const f32x2 bz = *(const f32x2*)(bias + c2);
    u32x4 nq[8], nk[8]; f32x4 nl;
#define GP_FETCH(it) do { const size_t t0_ = (size_t)(it) * 64; _Pragma("unroll") for (int i = 0; i < 8; ++i) { const int c = tid + 512 * i, r = c >> 6, ch = c & 63; \
            nq[i] = __builtin_nontemporal_load((const u32x4*)(GQ + (t0_ + r) * 512 + ch * 8)); nk[i] = __builtin_nontemporal_load((const u32x4*)(GK + (t0_ + r) * 512 + ch * 8)); } \
        nl = *(const f32x4*)(LR + t0_ * 32 + 4 * tid); } while (0)
    if (F.bid < NB * 64) GP_FETCH(F.bid);
    for (int item = F.bid; item < NB * 64; item += F.G) {
        const size_t tok0 = (size_t)item * 64;
        __syncthreads();
#pragma unroll
        for (int i = 0; i < 8; ++i) { const int c = tid + 512 * i, r = c >> 6, ch = c & 63;
            *(LAS u32x4*)(lds + GP_Q + r * 1024 + ch * 16) = nq[i]; *(LAS u32x4*)(lds + GP_K + r * 1024 + ch * 16) = nk[i]; }
        *(LAS f32x4*)(lds + GP_LR + 16 * tid) = nl;
        if (item + F.G < NB * 64) GP_FETCH(item + F.G);
        LDS_BARRIER();
        f32x2 accum = {0.f, 0.f};
#pragma unroll 4
        for (int s0 = 0; s0 < 64; ++s0) { const int t = dir ? 63 - s0 : s0;
            const LAS f32x4* lr4 = (const LAS f32x4*)(lds + GP_LR + t * 128 + dir * 64);
            f32x2 xa = bz, xb = {0.f, 0.f}, xc = {0.f, 0.f}, xd = {0.f, 0.f};
            { const f32x4 l0 = lr4[0], l1 = lr4[1], l2 = lr4[2], l3 = lr4[3];
              xa += w[0] * l0[0]; xb += w[4] * l1[0]; xc += w[8] * l2[0]; xd += w[12] * l3[0];
              xa += w[1] * l0[1]; xb += w[5] * l1[1]; xc += w[9] * l2[1]; xd += w[13] * l3[1];
              xa += w[2] * l0[2]; xb += w[6] * l1[2]; xc += w[10] * l2[2]; xd += w[14] * l3[2];
              xa += w[3] * l0[3]; xb += w[7] * l1[3]; xc += w[11] * l2[3]; xd += w[15] * l3[3]; }
            const f32x2 x = (xa + xb) + (xc + xd);
            const float ls0 = fminf(x[0], 0.f) - 0.6931471805599453f * __builtin_amdgcn_logf(1.0f + __builtin_amdgcn_exp2f(-1.4426950408889634f * fabsf(x[0])));
            const float ls1 = fminf(x[1], 0.f) - 0.6931471805599453f * __builtin_amdgcn_logf(1.0f + __builtin_amdgcn_exp2f(-1.4426950408889634f * fabsf(x[1])));
            accum[0] += ls0 * (1.0f / 16.0f); accum[1] += ls1 * (1.0f / 16.0f);
            const float e0 = __builtin_amdgcn_exp2f(1.4426950408889634f * accum[0]), e1 = __builtin_amdgcn_exp2f(1.4426950408889634f * accum[1]);
            const float i0 = __builtin_amdgcn_rcpf(e0), i1 = __builtin_amdgcn_rcpf(e1);
            const unsigned qw = *(const LAS unsigned*)(lds + GP_Q + t * 1024 + c2 * 2), kw = *(const LAS unsigned*)(lds + GP_K + t * 1024 + c2 * 2);
            *(unsigned*)(QDo + (tok0 + t) * 512 + c2) = pk2(bflo(qw) * e0, bfhi(qw) * e1);
            *(unsigned*)(KIo + (tok0 + t) * 512 + c2) = pk2(bflo(kw) * i0, bfhi(kw) * i1);
        }
        *(f32x2*)(DEC + ((size_t)dir * NB * 64 + item) * 512 + c2) = (f32x2){__builtin_amdgcn_exp2f(1.4426950408889634f * accum[0]), __builtin_amdgcn_exp2f(1.4426950408889634f * accum[1])};
    }
}

constexpr int GS_STR = 272, GS_KSTR = 288, GS_VSTR = 160;
constexpr int GS_QD = 0, GS_KI = 64 * GS_STR, GS_V = GS_KI + 64 * GS_KSTR, GS_DEC = GS_V + 64 * GS_VSTR, GS_BUF = GS_DEC + 512;
constexpr int GS_ST = 2 * GS_BUF, GS_STB = 64 * GS_STR;
__device__ __forceinline__ s16x4 trread(const LAS unsigned char* p) { return __builtin_bit_cast(s16x4, __builtin_amdgcn_ds_read_tr16_b64_v4i16((LAS s16x4*)p)); }
__device__ __forceinline__ bf16x8 cat8(s16x4 lo, s16x4 hi) { return (bf16x8){lo[0], lo[1], lo[2], lo[3], hi[0], hi[1], hi[2], hi[3]}; }
__device__ __forceinline__ bf16x8 pack8(const f32x4& a, const f32x4& b) { u32x4 w; w.x = pk2(a[0], a[1]); w.y = pk2(a[2], a[3]); w.z = pk2(b[0], b[1]); w.w = pk2(b[2], b[3]); return __builtin_bit_cast(bf16x8, w); }

#define GS_LANE_VARS() const int lane = lane0, fr = lane & 15, fq = lane >> 4; (void)fr; (void)fq
#define GS_LOAD_CHUNK(ch) do { const int ch_ = (ch); const unsigned char* k_ = kib + (size_t)ch_ * 65536 + lqk; const unsigned char* v_ = gvb + (size_t)ch_ * 65536 + lv; \
        pk[0] = *(const u32x4*)(k_); pk[1] = *(const u32x4*)(k_ + 128); pk[2] = *(const u32x4*)(k_ + 8192); pk[3] = *(const u32x4*)(k_ + 8192 + 128); \
        pv[0] = __builtin_nontemporal_load((const u32x4*)(v_)); pv[1] = __builtin_nontemporal_load((const u32x4*)(v_ + 8192)); \
        if (lane < 32) pdec = *(const float*)(decb + (size_t)ch_ * 2048 + (32 * sw + lane) * 4); } while (0)
#define GS_STAGE(bufi) do { LAS unsigned char* nl_ = F.lds + (bufi) * GS_BUF; LAS unsigned char* k2_ = nl_ + GS_KI + ra * GS_KSTR + ci; LAS unsigned char* v2_ = nl_ + GS_V + ra * GS_VSTR + ci; \
        *(LAS u32x4*)(k2_) = pk[0]; *(LAS u32x4*)(k2_ + 128) = pk[1]; *(LAS u32x4*)(k2_ + 8 * GS_KSTR) = pk[2]; *(LAS u32x4*)(k2_ + 8 * GS_KSTR + 128) = pk[3]; \
        *(LAS u32x4*)(v2_) = pv[0]; *(LAS u32x4*)(v2_ + 8 * GS_VSTR) = pv[1]; if (lane < 32) *(LAS float*)(nl_ + GS_DEC + (32 * sw + lane) * 4) = pdec; } while (0)
#define GS_STAGE_VARS() const int ra = 16 * sw + (lane >> 3), ci = (lane & 7) * 16; const unsigned lqk = (unsigned)(ra * 1024 + ci), lv = lqk

__device__ __forceinline__ void phase_gla_scan(const Frame& F, const Args& a) {
    const int lane0 = F.lane, wid = F.wave;
    for (int u = F.bid; u < 256; u += F.G) {
        const int slot = u >> 3, dvq = slot & 3, grp = (u & 7) * 8 + (slot >> 2), dir = grp & 1, h = (grp >> 1) & 3, b = grp >> 3;
        const unsigned char* qdb = a.ws + (dir ? X_GQ : X_BF) + ((size_t)b * SEQ * 512 + h * 128) * 2; const unsigned char* kib = a.ws + (dir ? X_GK : X_BB) + ((size_t)b * SEQ * 512 + h * 128) * 2;
        const unsigned char* gvb = a.ws + (h < 2 ? X_GVL : X_GVH) + ((size_t)b * SEQ * 512 + (h & 1) * 256 + dvq * 64) * 2;
        const unsigned char* decb = a.ws + WS_ROWSS + (((size_t)dir * NB * 64 + (size_t)b * 64) * 512 + h * 128) * 4;
        const int OLD = dir ? 1024 : OF_LD;
        unsigned char* ob = a.ws + (dir ? X_OB : X_OF) + ((size_t)b * SEQ * OLD + (dir ? 0 : OF_C0) + h * 256 + dvq * 64) * 2;
        __syncthreads();
        {   GS_LANE_VARS(); const int tid = wid * 64 + lane;
            LAS unsigned char* p = F.lds + GS_ST + (tid >> 3) * GS_STR + (tid & 7) * 16; *(LAS u32x4*)p = (u32x4){0u, 0u, 0u, 0u}; *(LAS u32x4*)(p + 128) = (u32x4){0u, 0u, 0u, 0u}; }
        if (wid < 4) {
            const int wix = ((wid & 1) << 1) | (wid >> 1); const int cb = dir ? wix : 3 - wix;
            const int sA = dir ? 1 : 0, sB = 1 - sA;
            const bool both = dir ? (cb <= 1) : (cb >= 2);
            float mk[2][4];
            {   GS_LANE_VARS(); const int sD = both ? sB : sA, c = 16 * cb + fr;
#pragma unroll
                for (int jj = 0; jj < 2; ++jj)
#pragma unroll
                    for (int r = 0; r < 4; ++r) { const int j = 32 * sD + 16 * jj + 4 * fq + r; mk[jj][r] = (dir ? (j > c) : (j <= c)) ? 1.f : 0.f; } }
            u32x2 ow[4] = {{0u, 0u}, {0u, 0u}, {0u, 0u}, {0u, 0u}}; unsigned char* oc = ob;
            bf16x8 qb[4];
            {   GS_LANE_VARS(); const unsigned char* qp = qdb + (size_t)(dir ? 63 : 0) * 65536 + (unsigned)((16 * cb + fr) * 1024 + 16 * fq);
#pragma unroll
                for (int ks = 0; ks < 4; ++ks) qb[ks] = *(const bf16x8*)(qp + 64 * ks); }
            __syncthreads();
            for (int step = 0; step < 64; ++step) {
                GS_LANE_VARS();
                const int chunk = dir ? 63 - step : step;
                const LAS unsigned char* lds = F.lds + (step & 1) * GS_BUF;
                const LAS unsigned char* stR = F.lds + GS_ST + (step & 1) * GS_STB;
                bf16x8 stf[4][4], kaA[2][4], kaB[2][4], viA[4], viB[4];
#pragma unroll
                for (int jj = 0; jj < 2; ++jj)
#pragma unroll
                    for (int ks = 0; ks < 4; ++ks) kaA[jj][ks] = *(const LAS bf16x8*)(lds + GS_KI + (32 * sA + 16 * jj + fr) * GS_KSTR + (32 * ks + 8 * fq) * 2);
                if (both) {
#pragma unroll
                    for (int jj = 0; jj < 2; ++jj)
#pragma unroll
                        for (int ks = 0; ks < 4; ++ks) kaB[jj][ks] = *(const LAS bf16x8*)(lds + GS_KI + (32 * sB + 16 * jj + fr) * GS_KSTR + (32 * ks + 8 * fq) * 2);
                }
#pragma unroll
                for (int t = 0; t < 4; ++t)
#pragma unroll
                    for (int ks = 0; ks < 4; ++ks) stf[t][ks] = *(const LAS bf16x8*)(stR + (16 * t + fr) * GS_STR + (32 * ks + 8 * fq) * 2);
                const LAS unsigned char* vb = lds + GS_V + (4 * fq + (fr >> 2)) * GS_VSTR + (4 * (fr & 3)) * 2;
#pragma unroll
                for (int t = 0; t < 4; ++t) viA[t] = cat8(trread(vb + (32 * sA) * GS_VSTR + 32 * t), trread(vb + (32 * sA + 16) * GS_VSTR + 32 * t));
                if (both) {
#pragma unroll
                    for (int t = 0; t < 4; ++t) viB[t] = cat8(trread(vb + (32 * sB) * GS_VSTR + 32 * t), trread(vb + (32 * sB + 16) * GS_VSTR + 32 * t));
                }
                if (step > 0) { const unsigned lo = (unsigned)((16 * cb + fr) * OLD + 4 * fq) * 2u;
#pragma unroll
                    for (int t = 0; t < 4; ++t) __builtin_nontemporal_store(ow[t], (u32x2*)(oc + lo + 32 * t)); }
                f32x4 atA[2] = {(f32x4){0.f, 0.f, 0.f, 0.f}, (f32x4){0.f, 0.f, 0.f, 0.f}}, atB[2] = {(f32x4){0.f, 0.f, 0.f, 0.f}, (f32x4){0.f, 0.f, 0.f, 0.f}};
#pragma unroll
                for (int ks = 0; ks < 4; ++ks)
#pragma unroll
                    for (int jj = 0; jj < 2; ++jj) atA[jj] = __builtin_amdgcn_mfma_f32_16x16x32_bf16(kaA[jj][ks], qb[ks], atA[jj], 0, 0, 0);
                if (both) {
#pragma unroll
                    for (int ks = 0; ks < 4; ++ks)
#pragma unroll
                        for (int jj = 0; jj < 2; ++jj) atB[jj] = __builtin_amdgcn_mfma_f32_16x16x32_bf16(kaB[jj][ks], qb[ks], atB[jj], 0, 0, 0);
                }
                f32x4 oT[4];
#pragma unroll
                for (int t = 0; t < 4; ++t) oT[t] = (f32x4){0.f, 0.f, 0.f, 0.f};
                {   const unsigned char* qpn = qdb + (size_t)(dir ? 62 - step : step + 1) * 65536 + (unsigned)((16 * cb + fr) * 1024 + 16 * fq);
#pragma unroll
                    for (int ks = 0; ks < 4; ++ks) {
#pragma unroll
                        for (int t = 0; t < 4; ++t) oT[t] = __builtin_amdgcn_mfma_f32_16x16x32_bf16(stf[t][ks], qb[ks], oT[t], 0, 0, 0);
                        if (step < 63) qb[ks] = *(const bf16x8*)(qpn + 64 * ks); } }
                if (both) {
#pragma unroll
                    for (int jj = 0; jj < 2; ++jj)
#pragma unroll
                        for (int r = 0; r < 4; ++r) atB[jj][r] *= mk[jj][r];
                    const bf16x8 pfA = pack8(atA[0], atA[1]), pfB = pack8(atB[0], atB[1]);
#pragma unroll
                    for (int t = 0; t < 4; ++t) oT[t] = __builtin_amdgcn_mfma_f32_16x16x32_bf16(viA[t], pfA, oT[t], 0, 0, 0);
#pragma unroll
                    for (int t = 0; t < 4; ++t) oT[t] = __builtin_amdgcn_mfma_f32_16x16x32_bf16(viB[t], pfB, oT[t], 0, 0, 0);
                } else {
#pragma unroll
                    for (int jj = 0; jj < 2; ++jj)
#pragma unroll
                        for (int r = 0; r < 4; ++r) atA[jj][r] *= mk[jj][r];
                    const bf16x8 pfA = pack8(atA[0], atA[1]);
#pragma unroll
                    for (int t = 0; t < 4; ++t) oT[t] = __builtin_amdgcn_mfma_f32_16x16x32_bf16(viA[t], pfA, oT[t], 0, 0, 0);
                }
#pragma unroll
                for (int t = 0; t < 4; ++t) { ow[t].x = pk2(oT[t][0], oT[t][1]); ow[t].y = pk2(oT[t][2], oT[t][3]); }
                oc = ob + (size_t)chunk * 64 * OLD * 2;
                LDS_BARRIER();
            }
            {   GS_LANE_VARS(); const unsigned lo = (unsigned)((16 * cb + fr) * OLD + 4 * fq) * 2u;
#pragma unroll
                for (int t = 0; t < 4; ++t) *(u32x2*)(oc + lo + 32 * t) = ow[t]; }
        } else {
            const int sw = wid - 4;
            u32x4 pk[4], pv[2]; float pdec = 0.f;
            {   GS_LANE_VARS(); GS_STAGE_VARS(); GS_LOAD_CHUNK(dir ? 63 : 0); GS_STAGE(0); GS_LOAD_CHUNK(dir ? 62 : 1); }
            f32x4 S[2][4];
#pragma unroll
            for (int d = 0; d < 2; ++d)
#pragma unroll
                for (int t = 0; t < 4; ++t) S[d][t] = (f32x4){0.f, 0.f, 0.f, 0.f};
            __syncthreads();
            for (int step = 0; step < 64; ++step) {
                GS_LANE_VARS();
                const LAS unsigned char* lds = F.lds + (step & 1) * GS_BUF;
                LAS unsigned char* stW = F.lds + GS_ST + ((step + 1) & 1) * GS_STB;
                bf16x8 kef[2][2], vi[4][2];
                const LAS unsigned char* vb = lds + GS_V + (4 * fq + (fr >> 2)) * GS_VSTR + (4 * (fr & 3)) * 2;
#pragma unroll
                for (int t = 0; t < 4; ++t) { vi[t][0] = cat8(trread(vb + 32 * t), trread(vb + 16 * GS_VSTR + 32 * t)); vi[t][1] = cat8(trread(vb + 32 * GS_VSTR + 32 * t), trread(vb + 48 * GS_VSTR + 32 * t)); }
#pragma unroll
                for (int d = 0; d < 2; ++d) { const LAS unsigned char* kb = lds + GS_KI + (4 * fq + (fr >> 2)) * GS_KSTR + (32 * sw + 16 * d + 4 * (fr & 3)) * 2;
                    kef[d][0] = cat8(trread(kb), trread(kb + 16 * GS_KSTR)); kef[d][1] = cat8(trread(kb + 32 * GS_KSTR), trread(kb + 48 * GS_KSTR)); }
                f32x4 dcv[2];
#pragma unroll
                for (int d = 0; d < 2; ++d) dcv[d] = *(const LAS f32x4*)(lds + GS_DEC + (32 * sw + 16 * d + 4 * fq) * 4);
#pragma unroll
                for (int sidx = 0; sidx < 2; ++sidx)
#pragma unroll
                    for (int d = 0; d < 2; ++d)
#pragma unroll
                        for (int t = 0; t < 4; ++t) S[d][t] = __builtin_amdgcn_mfma_f32_16x16x32_bf16(kef[d][sidx], vi[t][sidx], S[d][t], 0, 0, 0);
#pragma unroll
                for (int d = 0; d < 2; ++d)
#pragma unroll
                    for (int t = 0; t < 4; ++t) { S[d][t] = S[d][t] * dcv[d]; u32x2 w; w.x = pk2(S[d][t][0], S[d][t][1]); w.y = pk2(S[d][t][2], S[d][t][3]);
                        *(LAS u32x2*)(stW + (16 * t + fr) * GS_STR + (32 * sw + 16 * d + 4 * fq) * 2) = w; }
                {   GS_STAGE_VARS();
                    if (step < 63) GS_STAGE((step + 1) & 1);
                    if (step < 62) GS_LOAD_CHUNK(dir ? 61 - step : step + 2); }
                LDS_BARRIER();
            }
        }
    }
}

__device__ __forceinline__ void phase_comb_b(const Frame& F, const Args& a, int layer) {
    const int gw = F.bid * NWAVES + F.wave, NGW = F.G * NWAVES;
    bf16_t* OF = (bf16_t*)(a.ws + X_OF); const bf16_t* OB = (const bf16_t*)(a.ws + X_OB); const bf16_t* ZB = (const bf16_t*)(a.ws + X_ZB);
    const float* wn = a.in[7] + (size_t)layer * 256 + 8 * (F.lane & 31);
    const f32x4 w0 = *(const f32x4*)wn, w1 = *(const f32x4*)(wn + 4);
    for (int tok0 = gw; tok0 < T; tok0 += 2 * NGW) {
        u32x4 f[4], bq[4], z[4];
#pragma unroll
        for (int q = 0; q < 4; ++q) { const int tok = tok0 + (q >> 1) * NGW, hh = q & 1; const size_t off = (size_t)tok * 1024 + hh * 512 + 8 * F.lane, offf = (size_t)tok * OF_LD + OF_C0 + hh * 512 + 8 * F.lane;
            f[q] = __builtin_nontemporal_load((const u32x4*)(OF + offf)); bq[q] = __builtin_nontemporal_load((const u32x4*)(OB + off)); z[q] = __builtin_nontemporal_load((const u32x4*)(ZB + off)); }
#pragma unroll
        for (int q = 0; q < 4; ++q) { const int tok = tok0 + (q >> 1) * NGW, hh = q & 1; const size_t offf = (size_t)tok * OF_LD + OF_C0 + hh * 512 + 8 * F.lane;
            float o[8];
            o[0] = bflo(f[q].x) + bflo(bq[q].x); o[1] = bfhi(f[q].x) + bfhi(bq[q].x); o[2] = bflo(f[q].y) + bflo(bq[q].y); o[3] = bfhi(f[q].y) + bfhi(bq[q].y);
            o[4] = bflo(f[q].z) + bflo(bq[q].z); o[5] = bfhi(f[q].z) + bfhi(bq[q].z); o[6] = bflo(f[q].w) + bflo(bq[q].w); o[7] = bfhi(f[q].w) + bfhi(bq[q].w);
            float ss = (o[0] * o[0] + o[1] * o[1]) + (o[2] * o[2] + o[3] * o[3]) + (o[4] * o[4] + o[5] * o[5]) + (o[6] * o[6] + o[7] * o[7]);
            ss += __shfl_xor(ss, 1); ss += __shfl_xor(ss, 2); ss += __shfl_xor(ss, 4); ss += __shfl_xor(ss, 8); ss += __shfl_xor(ss, 16);
            const float rstd = __builtin_amdgcn_rsqf(ss * (1.0f / 256.0f) + NORM_EPS);
            u32x4 y;
            y.x = pk2(o[0] * rstd * w0[0] * siluf_(bflo(z[q].x)), o[1] * rstd * w0[1] * siluf_(bfhi(z[q].x))); y.y = pk2(o[2] * rstd * w0[2] * siluf_(bflo(z[q].y)), o[3] * rstd * w0[3] * siluf_(bfhi(z[q].y)));
            y.z = pk2(o[4] * rstd * w1[0] * siluf_(bflo(z[q].z)), o[5] * rstd * w1[1] * siluf_(bfhi(z[q].z))); y.w = pk2(o[6] * rstd * w1[2] * siluf_(bflo(z[q].w)), o[7] * rstd * w1[3] * siluf_(bfhi(z[q].w)));
            *(u32x4*)(OF + offf) = y; }
    }
}

__device__ __forceinline__ void phase_comb_a(const Frame& F, const Args& a, int ch0, int nch) {
    const float* LSE = (const float*)(a.ws + WS_LSE); const bf16_t* ZA = (const bf16_t*)(a.ws + X_ZA); bf16_t* YA = (bf16_t*)(a.ws + X_OF);
    const int head = F.lane >> 4;
    for (int ch = ch0; ch < ch0 + nch; ++ch) {
        {
            const int tokb = ch * 32 + F.wave;
            float l0[4], l1[4], l2[4]; u32x4 a0[4], a1[4], a2[4], z[4];
#pragma unroll
            for (int rr = 0; rr < 4; ++rr) { const int tok = tokb + 8 * rr; const size_t off = (size_t)tok * 512 + 8 * F.lane;
                const int sq = tok & (SEQ - 1), bb = tok & ~(SEQ - 1); const int t1 = bb | ((sq & 3) << 10) | (sq >> 2), t2 = bb | ((sq & 15) << 8) | (sq >> 4);
                const size_t off1 = (size_t)t1 * 512 + 8 * F.lane, off2 = (size_t)t2 * 512 + 8 * F.lane;
                l0[rr] = LSE[(size_t)tok * 4 + head]; l1[rr] = LSE[(size_t)T * 4 + (size_t)t1 * 4 + head]; l2[rr] = LSE[(size_t)2 * T * 4 + (size_t)t2 * 4 + head];
                a0[rr] = __builtin_nontemporal_load((const u32x4*)((const bf16_t*)(a.ws + X_QO) + off)); a1[rr] = __builtin_nontemporal_load((const u32x4*)((const bf16_t*)(a.ws + X_QO + 32 * MiB) + off1)); a2[rr] = __builtin_nontemporal_load((const u32x4*)((const bf16_t*)(a.ws + X_QO + 64 * MiB) + off2));
                z[rr] = __builtin_nontemporal_load((const u32x4*)(ZA + off)); }
#pragma unroll
            for (int rr = 0; rr < 4; ++rr) { const int tok = tokb + 8 * rr;
                const float mx = fmaxf(l0[rr], fmaxf(l1[rr], l2[rr]));
                float w0 = __builtin_amdgcn_exp2f(1.4426950408889634f * (l0[rr] - mx)), w1 = __builtin_amdgcn_exp2f(1.4426950408889634f * (l1[rr] - mx)), w2 = __builtin_amdgcn_exp2f(1.4426950408889634f * (l2[rr] - mx));
                const float inv = __builtin_amdgcn_rcpf(w0 + w1 + w2); w0 *= inv; w1 *= inv; w2 *= inv;
                const u32x4 p = a0[rr], q = a1[rr], r = a2[rr], zz = z[rr];
                u32x4 y;
                y.x = pk2((w0 * bflo(p.x) + w1 * bflo(q.x) + w2 * bflo(r.x)) * siluf_(bflo(zz.x)), (w0 * bfhi(p.x) + w1 * bfhi(q.x) + w2 * bfhi(r.x)) * siluf_(bfhi(zz.x)));
                y.y = pk2((w0 * bflo(p.y) + w1 * bflo(q.y) + w2 * bflo(r.y)) * siluf_(bflo(zz.y)), (w0 * bfhi(p.y) + w1 * bfhi(q.y) + w2 * bfhi(r.y)) * siluf_(bfhi(zz.y)));
                y.z = pk2((w0 * bflo(p.z) + w1 * bflo(q.z) + w2 * bflo(r.z)) * siluf_(bflo(zz.z)), (w0 * bfhi(p.z) + w1 * bfhi(q.z) + w2 * bfhi(r.z)) * siluf_(bfhi(zz.z)));
                y.w = pk2((w0 * bflo(p.w) + w1 * bflo(q.w) + w2 * bflo(r.w)) * siluf_(bflo(zz.w)), (w0 * bfhi(p.w) + w1 * bfhi(q.w) + w2 * bfhi(r.w)) * siluf_(bfhi(zz.w)));
                __builtin_nontemporal_store(y, (u32x4*)(YA + (size_t)tok * OF_LD + 8 * F.lane));   }
        }
    }
}

constexpr int AT_STR = 272, AT_VSTR = 288, AT_K = 0, AT_V = 256 * AT_STR;
__device__ __forceinline__ void phase_attn(const Frame& F, const Args& a, unsigned* qctr) {
    const int tid = F.tid, lane = F.lane, wid = F.wave, fr = lane & 15, fq = lane >> 4;
    LAS unsigned char* lds = F.lds;
    constexpr int NU = 3072, NRUN = NU / 4;
    u32x4 pk[8], pv[8];
    auto geom = [&](int ug, int& g, int& d, int& L, int& r, int& jj, int& h, int& b) { g = ug >> 10; const int u = ug & 1023; d = (g == 0) ? 1 : (g == 1 ? 4 : 16); L = SEQ / d; const int upc = L / 128;
        const int cls = u & 31; r = cls / upc; jj = cls % upc; h = (u >> 5) & 3; b = u >> 7; };
    auto prefetch = [&](int ug, bool reuse) {
        int g, d, L, r, jj, h, b; geom(ug, g, d, L, r, jj, h, b);
        const bf16_t* KA = (const bf16_t*)(a.ws + X_KA + (size_t)g * 32 * MiB); const bf16_t* VA = (const bf16_t*)(a.ws + X_VA + (size_t)g * 32 * MiB);
        const int tk0 = 128 * jj - 64; const size_t tokb = (size_t)b * SEQ + (size_t)r * L;
        if (!reuse) {
#pragma unroll
            for (int i = 0; i < 4; ++i) { const int c = tid + 512 * i, row = c >> 4, ch = c & 15, tk = tk0 + row; const int tkc = tk < 0 ? 0 : (tk >= L ? L - 1 : tk);
                const size_t go = (tokb + (size_t)tkc) * 512 + h * 128 + ch * 8; pk[i] = *(const u32x4*)(KA + go); pv[i] = *(const u32x4*)(VA + go); } }
#pragma unroll
        for (int i = 4; i < 8; ++i) { const int c = tid + 512 * i, row = c >> 4, ch = c & 15, tk = tk0 + row; const int tkc = tk < 0 ? 0 : (tk >= L ? L - 1 : tk);
            const size_t go = (tokb + (size_t)tkc) * 512 + h * 128 + ch * 8; pk[i] = *(const u32x4*)(KA + go); pv[i] = *(const u32x4*)(VA + go); }
    };
    bf16x8 qf[4];
    const unsigned qvoff = (unsigned)(fr * 1024 + fq * 16);
    auto loadq = [&](int ug) { int g, d, L, r, jj, h, b; geom(ug, g, d, L, r, jj, h, b);
        const unsigned char* Qg = a.ws + X_QO + (size_t)g * 32 * MiB + ((size_t)b * SEQ + (size_t)r * L + (size_t)(128 * jj + 16 * wid)) * 1024 + (size_t)h * 256;
#pragma unroll
        for (int ks = 0; ks < 4; ++ks) qf[ks] = *(const bf16x8*)(Qg + qvoff + 64 * ks); };
    volatile LAS unsigned* qslot = (volatile LAS unsigned*)(F.lds + LDS_BYTES - 256 + 64);
    int R = F.bid;
    if (R < NRUN) { prefetch(4 * R, false); loadq(4 * R); }
    while (R < NRUN) {
      int Rn = NRUN;
#pragma unroll 1
      for (int k = 0; k < 4; ++k) {
        const int ug = 4 * R + k;
        int g, d, L, r, jj, h, b; geom(ug, g, d, L, r, jj, h, b);
        const bool reuse = (k > 0) && (jj > 0);
        bf16_t* QO = (bf16_t*)(a.ws + X_QO + (size_t)g * 32 * MiB); float* LSEg = (float*)(a.ws + WS_LSE) + (size_t)g * T * 4;
        const int t0 = 128 * jj, tk0 = t0 - 64;
        const size_t tokb = (size_t)b * SEQ + (size_t)r * L;
        LDS_BARRIER();
        if (k == 3) Rn = __builtin_amdgcn_readfirstlane((int)*qslot);
        if (!reuse) {
#pragma unroll
            for (int i = 0; i < 4; ++i) { const int c = tid + 512 * i, slot = (tk0 + (c >> 4)) & 255, ch = c & 15;
                *(LAS u32x4*)(lds + AT_K + slot * AT_STR + ch * 16) = pk[i]; *(LAS u32x4*)(lds + AT_V + slot * AT_VSTR + ch * 16) = pv[i]; } }
#pragma unroll
        for (int i = 4; i < 8; ++i) { const int c = tid + 512 * i, slot = (tk0 + (c >> 4)) & 255, ch = c & 15;
            *(LAS u32x4*)(lds + AT_K + slot * AT_STR + ch * 16) = pk[i]; *(LAS u32x4*)(lds + AT_V + slot * AT_VSTR + ch * 16) = pv[i]; }
        const int tq = t0 + 16 * wid + fr; const size_t qoff = (tokb + (size_t)tq) * 512 + h * 128;
        if (k < 3) { int g2, d2, L2, r2, jj2, h2, b2; geom(ug + 1, g2, d2, L2, r2, jj2, h2, b2); prefetch(ug + 1, jj2 > 0); }
        else if (Rn < NRUN) prefetch(4 * Rn, false);
        LDS_BARRIER();
        unsigned pulled = 0u; if (k == 0 && tid == 0) pulled = __hip_atomic_fetch_add(qctr, 1u, __ATOMIC_RELAXED, __HIP_MEMORY_SCOPE_AGENT);
        f32x4 s[10]; float m = -1e30f;
        const LAS unsigned char* kbase = lds + AT_K + fr * AT_STR + (8 * fq) * 2;
        const int ktile0 = tk0 + 16 * wid;
        bf16x8 kfa[8], kfb[8];
#define LOADK(dst, kt0) do { _Pragma("unroll") for (int q_ = 0; q_ < 8; ++q_) { const int kt_ = (kt0) + (q_ >> 2); if (kt_ < 9) dst[q_] = *(const LAS bf16x8*)(kbase + ((ktile0 + 16 * kt_) & 255) * AT_STR + (q_ & 3) * 64); } } while (0)
#define MMAK(src, kt0) do { _Pragma("unroll") for (int q_ = 0; q_ < 8; ++q_) { const int kt_ = (kt0) + (q_ >> 2); if (kt_ < 9) s[kt_] = __builtin_amdgcn_mfma_f32_16x16x32_bf16(src[q_], qf[q_ & 3], s[kt_], 0, 0, 0); } } while (0)
#pragma unroll
        for (int kt = 0; kt < 10; ++kt) s[kt] = (f32x4){0.f, 0.f, 0.f, 0.f};
        LOADK(kfa, 0); __builtin_amdgcn_sched_barrier(0);
        LOADK(kfb, 2); __builtin_amdgcn_sched_barrier(0); MMAK(kfa, 0); __builtin_amdgcn_sched_barrier(0);
        LOADK(kfa, 4); __builtin_amdgcn_sched_barrier(0); MMAK(kfb, 2); __builtin_amdgcn_sched_barrier(0);
        LOADK(kfb, 6); __builtin_amdgcn_sched_barrier(0); MMAK(kfa, 4); __builtin_amdgcn_sched_barrier(0);
        LOADK(kfa, 8); __builtin_amdgcn_sched_barrier(0); MMAK(kfb, 6); __builtin_amdgcn_sched_barrier(0);
        MMAK(kfa, 8);
        if (k < 3) loadq(ug + 1); else if (Rn < NRUN) loadq(4 * Rn);
#undef LOADK
#undef MMAK
        {   const int kb = tk0 + 16 * wid;
#pragma unroll
            for (int rg = 0; rg < 4; ++rg) { const int j = 4 * fq + rg; if (j < fr) s[0][rg] = -1e30f; if (j > fr) s[8][rg] = -1e30f; }
            if (kb < 0 || kb + 144 > L) {
                asm volatile("" ::: "memory");
#pragma unroll
                for (int kt = 0; kt < 9; ++kt)
#pragma unroll
                    for (int rg = 0; rg < 4; ++rg) { const int tk = kb + 16 * kt + 4 * fq + rg; if (tk < 0 || tk >= L) s[kt][rg] = -1e30f; } }
#pragma unroll
            for (int kt = 0; kt < 9; ++kt)
#pragma unroll
                for (int rg = 0; rg < 4; ++rg) m = fmaxf(m, s[kt][rg]); }
        m = fmaxf(m, __shfl_xor(m, 16)); m = fmaxf(m, __shfl_xor(m, 32));
        float l = 0.f; const float mc = -1.4426950408889634f * m;
#pragma unroll
        for (int kt = 0; kt < 9; ++kt)
#pragma unroll
            for (int rg = 0; rg < 4; ++rg) { const float p = __builtin_amdgcn_exp2f(__builtin_fmaf(s[kt][rg], 1.4426950408889634f, mc)); s[kt][rg] = p; l += p; }
        l += __shfl_xor(l, 16); l += __shfl_xor(l, 32);
        bf16x8 pf[5];
#pragma unroll
        for (int sidx = 0; sidx < 5; ++sidx) pf[sidx] = pack8(s[2 * sidx], s[2 * sidx + 1]);
        const float invl = __builtin_amdgcn_rcpf(l);
        int vr[10];
#pragma unroll
        for (int sidx = 0; sidx < 5; ++sidx) { const int r1 = tk0 + 16 * wid + 32 * sidx + 4 * fq + (fr >> 2), r2 = r1 + 16; vr[2 * sidx] = (r1 & 255) * AT_VSTR; vr[2 * sidx + 1] = (r2 & 255) * AT_VSTR; }
        const LAS unsigned char* vbase = lds + AT_V + (4 * (fr & 3)) * 2;
        bf16x8 vfa[5], vfb[5];
#define LOADV(dst, t) do { _Pragma("unroll") for (int q_ = 0; q_ < 5; ++q_) dst[q_] = cat8(trread(vbase + vr[2 * q_] + (t) * 32), trread(vbase + vr[2 * q_ + 1] + (t) * 32)); } while (0)
#define MMAV(src, t) do { f32x4 o_ = {0.f, 0.f, 0.f, 0.f}; _Pragma("unroll") for (int q_ = 0; q_ < 5; ++q_) o_ = __builtin_amdgcn_mfma_f32_16x16x32_bf16(src[q_], pf[q_], o_, 0, 0, 0); \
            u32x2 w_; w_.x = pk2(o_[0] * invl, o_[1] * invl); w_.y = pk2(o_[2] * invl, o_[3] * invl); *(u32x2*)(QO + qoff + 16 * (t) + 4 * fq) = w_; } while (0)
        LOADV(vfa, 0); __builtin_amdgcn_sched_barrier(0);
        LOADV(vfb, 1); __builtin_amdgcn_sched_barrier(0); MMAV(vfa, 0); __builtin_amdgcn_sched_barrier(0);
        LOADV(vfa, 2); __builtin_amdgcn_sched_barrier(0); MMAV(vfb, 1); __builtin_amdgcn_sched_barrier(0);
        LOADV(vfb, 3); __builtin_amdgcn_sched_barrier(0); MMAV(vfa, 2); __builtin_amdgcn_sched_barrier(0);
        LOADV(vfa, 4); __builtin_amdgcn_sched_barrier(0); MMAV(vfb, 3); __builtin_amdgcn_sched_barrier(0);
        LOADV(vfb, 5); __builtin_amdgcn_sched_barrier(0); MMAV(vfa, 4); __builtin_amdgcn_sched_barrier(0);
        LOADV(vfa, 6); __builtin_amdgcn_sched_barrier(0); MMAV(vfb, 5); __builtin_amdgcn_sched_barrier(0);
        LOADV(vfb, 7); __builtin_amdgcn_sched_barrier(0); MMAV(vfa, 6); __builtin_amdgcn_sched_barrier(0);
        MMAV(vfb, 7);
#undef LOADV
#undef MMAV
        if (fq == 0) LSEg[(tokb + (size_t)tq) * 4 + h] = m + 0.6931471805599453f * __builtin_amdgcn_logf(l);
        if (k == 0 && tid == 0) *qslot = pulled + (unsigned)F.G;
      }
      R = Rn;
    }
}

__device__ __forceinline__ void run_proj(const Frame& F, unsigned char* ws, const bf16_t* WIN, const bf16_t* Hh, const float* ropec, const float* ropes, int tau0, int ntiles) {
    pg8::Gemm gm{Hh, WIN + (size_t)tau0 * 256 * 1024, T, ntiles * 256, 1024}; pg8::StaticOrder S; S.init(T, ntiles * 256, F.G, F.bid);
    EpiProj E{tau0, ws, ropec, ropes};
    pg8::gemm_phase<EpiProj, pg8::StaticOrder, true, true>(F.lds, gm, S, E, F.wave);
}

#define XB_TMO      128
#define XB_XCNT(j)  (256  + 64 * (j))
#define XB_XSUB(j)  (1280 + 64 * (j))
#define XB_XGEN(j)  (2304 + 64 * (j))
#define XB_TOP      3328
#define XB_TOPGEN   3392
#define XCD_BAR_WORDS 3456
#define XB_SPIN_CAP (1u << 18)

__device__ __forceinline__ unsigned xb_ld(unsigned* p)              { return __hip_atomic_load(p, __ATOMIC_RELAXED, __HIP_MEMORY_SCOPE_AGENT); }
__device__ __forceinline__ unsigned xb_add(unsigned* p, unsigned v) { return __hip_atomic_fetch_add(p, v, __ATOMIC_RELAXED, __HIP_MEMORY_SCOPE_AGENT); }
__device__ __forceinline__ unsigned xb_xcc_id() { return (unsigned)__builtin_amdgcn_s_getreg((3 << 11) | 20) & 0xFu; }
#define XB_SPIN(cond, bar) do { unsigned _sp = 0; while (cond) { __builtin_amdgcn_s_sleep(1); \
    if ((++_sp & 255u) == 0u) { if (xb_ld(&(bar)[XB_TMO])) break; if (_sp > XB_SPIN_CAP) { atomicAdd(&(bar)[XB_TMO], 1u); break; } } } } while (0)

struct XcdBarrier {
    unsigned* bar; unsigned x;
    volatile LAS unsigned* st;
};

__device__ __forceinline__ XcdBarrier xcd_barrier_post(unsigned* bar, volatile LAS unsigned* st) {
    XcdBarrier b; b.bar = bar; b.x = xb_xcc_id(); b.st = st;
    if (threadIdx.x == 0) (void)xb_add(&bar[XB_XCNT(b.x)], 1u);
    return b;
}
__device__ __forceinline__ void xcd_barrier_complete(unsigned* bar, unsigned x, unsigned& nloc, unsigned& nx) {
    const unsigned G = gridDim.x * gridDim.y * gridDim.z;
    unsigned sum, cnt, mine, sp = 0u;
    for (;;) {
        sum = 0u; cnt = 0u; mine = 0u;
#pragma unroll
        for (unsigned j = 0; j < 16; ++j) { const unsigned c = xb_ld(&bar[XB_XCNT(j)]); sum += c; cnt += (c > 0u) ? 1u : 0u; mine = (j == x) ? c : mine; }
        if (sum == G) break;
        __builtin_amdgcn_s_sleep(1);
        if ((++sp & 255u) == 0u) { if (xb_ld(&bar[XB_TMO])) break; if (sp > XB_SPIN_CAP) { atomicAdd(&bar[XB_TMO], 1u); break; } }
    }
    nloc = mine > 0u ? mine : 1u; nx = cnt > 0u ? cnt : 1u;
}

__device__ __forceinline__ void xcd_barrier(const XcdBarrier& b, const bool leader_thread) {
    asm volatile("s_waitcnt vmcnt(0)" ::: "memory");
    __syncthreads();
    if (leader_thread) {
        unsigned* bar = b.bar;
        __builtin_amdgcn_s_waitcnt(0);
        unsigned nloc = b.st[0], nx = b.st[1];
        if (nloc == 0u) { xcd_barrier_complete(bar, b.x, nloc, nx); b.st[0] = nloc; b.st[1] = nx; }
        const unsigned old = xb_add(&bar[XB_XSUB(b.x)], 1u);
        const unsigned gen = old / nloc;
        if (old + 1u == (gen + 1u) * nloc) {
            __builtin_amdgcn_fence(__ATOMIC_RELEASE, "agent");
            asm volatile("s_waitcnt vmcnt(0)" ::: "memory");
            const unsigned og = xb_add(&bar[XB_TOP], 1u);
            const unsigned tg = og / nx;
            if (og + 1u != (tg + 1u) * nx) XB_SPIN(xb_ld(&bar[XB_TOP]) < (tg + 1u) * nx, bar);
            __builtin_amdgcn_fence(__ATOMIC_ACQUIRE, "agent");
            xb_add(&bar[XB_XGEN(b.x)], 1u);
            asm volatile("s_waitcnt vmcnt(0)" ::: "memory");
        } else {
            XB_SPIN(xb_ld(&bar[XB_TOP]) < (gen + 1u) * nx, bar);
            __builtin_amdgcn_fence(__ATOMIC_ACQUIRE, "agent");
            asm volatile("s_waitcnt vmcnt(0)" ::: "memory");
        }
    }
    __syncthreads();
}

constexpr int COMB_X = 0;
constexpr int CW_BAR = 4096;
constexpr size_t CTL_ZERO_BYTES = 64 * 1024;
constexpr int MISC_OFF = LDS_BYTES - 256;

#define LAUNDER() do { asm volatile("" : "+s"(F.wave), "+s"(F.bid), "+s"(F.G)); F.lane = fresh_lane(); F.tid = F.wave * 64 + F.lane; asm volatile("" : "+s"(ws)); } while (0)
#define GRID_BAR() do { XcdBarrier bb_ = bar; asm volatile("" : "+s"(bb_.bar), "+s"(bb_.x)); xcd_barrier(bb_, (F.wave * 64 + fresh_lane()) == 0); LAUNDER(); } while (0)

__global__ void __launch_bounds__(NTHR, 2) hybrid_fwd(Args args) {
    extern __shared__ __attribute__((aligned(16))) unsigned char lds_raw[];
    Frame F; F.lds = (LAS unsigned char*)lds_raw; F.tid = threadIdx.x; F.lane = F.tid & 63; F.wave = __builtin_amdgcn_readfirstlane(F.tid >> 6); F.G = gridDim.x; F.bid = blockIdx.x;
    unsigned char* ws = args.ws;
    volatile LAS unsigned* MISC = (volatile LAS unsigned*)(F.lds + MISC_OFF);
    if (F.tid < 64) MISC[F.tid] = 0u;
    __syncthreads();
    XcdBarrier bar = xcd_barrier_post((unsigned*)(ws + WS_CTL) + CW_BAR, MISC + 8);

    phase_prologue(F, args);
    __syncthreads(); LAUNDER();
#pragma unroll 1
    for (int layer = 0; layer < 2; ++layer) {
        LAUNDER();
        const float* ropec = (const float*)(ws + WS_ROPEC); const float* ropes = (const float*)(ws + WS_ROPES);
        const bf16_t* WIN = (const bf16_t*)(ws + WS_WIN + layer * WIN_BYTES);
        const bf16_t* Hh = (const bf16_t*)(ws + WS_H);
        if (layer == 0) phase_prep(F, args, 0, args.in[0], nullptr, nullptr, args.in[1]); else phase_prep(F, args, 1, args.in[0], args.out, args.in[11], args.in[1] + 1024);
        GRID_BAR();
        run_proj(F, ws, WIN, Hh, ropec, ropes, 0, 20);
        GRID_BAR();
        phase_attn(F, args, (unsigned*)(ws + WS_CTL) + 8192 + 64 * layer);
        GRID_BAR();
        {
            const int half = F.G >> 1; const bool five = F.bid < half;
            const int nch = five ? COMB_X : 8 - COMB_X, ch0 = five ? F.bid * COMB_X : half * COMB_X + (F.bid - half) * (8 - COMB_X);
            if (F.G == 256) phase_comb_a(F, args, ch0, nch); else phase_comb_a(F, args, (T / 32) * F.bid / F.G, (T / 32) * (F.bid + 1) / F.G - (T / 32) * F.bid / F.G); }
        LAUNDER();
        run_proj(F, ws, WIN, Hh, ropec, ropes, 20, 9);
        GRID_BAR();
        phase_gla_pre(F, args, layer);
        GRID_BAR();
        phase_gla_scan(F, args);
        GRID_BAR();
        run_proj(F, ws, WIN, Hh, ropec, ropes, 29, 12);
        GRID_BAR();
        phase_comb_b(F, args, layer);
        GRID_BAR();
        { pg8::Gemm gm{(const bf16_t*)(ws + X_OF), (const bf16_t*)(ws + WS_WA + layer * 3 * MiB), T, 1024, 1536}; pg8::StaticOrder S; S.init(T, 1024, F.G, F.bid);
          EpiMerge E{(const bf16_t*)(ws + X_GA), (const bf16_t*)(ws + X_GB), (bf16_t*)(ws + WS_H)};
          pg8::gemm_phase<EpiMerge, pg8::StaticOrder, true, true>(F.lds, gm, S, E, F.wave); }
        GRID_BAR();
        { pg8::Gemm gm{(const bf16_t*)(ws + WS_H), (const bf16_t*)(ws + WS_WO + layer * 2 * MiB), T, 1024, 1024}; pg8::StaticOrder S; S.init(T, 1024, F.G, F.bid);
          EpiOut E{(bf16_t*)(ws + X_OUT), (float*)(ws + WS_ROWSS)};
          pg8::gemm_phase<EpiOut, pg8::StaticOrder, true, true>(F.lds, gm, S, E, F.wave); }
        GRID_BAR();
    }
    phase_prep(F, args, 2, args.out, args.out, args.in[11] + 1024, nullptr);
}

extern "C" void kernel_launch(void* const* d_in, const int* in_sizes, int n_in, void* d_out, int out_size, void* d_ws, size_t ws_size, hipStream_t stream) {
    static int grid = 0;
    if (grid == 0) {
        if (n_in != 12 || out_size != T * DM || ws_size < WS_END) { fprintf(stderr, "kernel_launch: unexpected shapes (n_in %d out %d ws %zu)\n", n_in, out_size, ws_size); grid = -1; return; }
        int dev = 0, cus = 0;
        if (hipGetDevice(&dev) != hipSuccess || hipDeviceGetAttribute(&cus, hipDeviceAttributeMultiprocessorCount, dev) != hipSuccess) { grid = -1; return; }
        if (hipFuncSetAttribute((const void*)hybrid_fwd, hipFuncAttributeMaxDynamicSharedMemorySize, LDS_BYTES) != hipSuccess) { grid = -1; return; }
        grid = cus;
    }
    if (grid < 0) return;
    if (hipMemsetAsync((char*)d_ws + WS_CTL, 0, CTL_ZERO_BYTES, stream) != hipSuccess) return;
    Args a{};
    for (int i = 0; i < 12; ++i) a.in[i] = (const float*)d_in[i];
    a.out = (float*)d_out; a.ws = (unsigned char*)d_ws; a.ph_lo = 0; a.ph_hi = 0;
    hipLaunchKernelGGL(hybrid_fwd, dim3(grid), dim3(NTHR), LDS_BYTES, stream, a);
}
```
